# Optimizing an MI355X kernel written in HIP

```python
import math
import jax, jax.numpy as jnp
from jax import lax
import numpy as np


D_MODEL = 2048
BATCH = 2
SEQ = 16384
DEPTH = 1

HEAD_DIM = 128
NSA_HEADS = 8
NSA_KV_GROUPS = 2
NSA_HPG = NSA_HEADS // NSA_KV_GROUPS
CMP_LEN = 32
CMP_STRIDE = 16
SEL_LEN = 64
SEL_TOPK = 16
WINDOW = 512
CMP_HIDDEN = 256
NSA_Q_BLOCK = 64
NSA_WIDTH = NSA_HEADS * HEAD_DIM
DIFF_HEADS = 4
DIFF_V_DIM = 2 * HEAD_DIM
DIFF_Q_BLOCK = 128
DIFF_WIDTH = DIFF_HEADS * DIFF_V_DIM
REL_BUCKETS = 32
REL_MAX_EXACT = 16
REL_MAX_DIST = 128
N_BIAS_HEADS = NSA_HEADS + DIFF_HEADS
D_FF = -(-8 * D_MODEL // (3 * 256)) * 256

EPS = 1e-6
NEG = -1e30
BIG = 1e30

SPLIT_SIZES = (
    NSA_HEADS * HEAD_DIM,
    NSA_KV_GROUPS * HEAD_DIM,
    NSA_KV_GROUPS * HEAD_DIM,
    NSA_KV_GROUPS * HEAD_DIM,
    NSA_KV_GROUPS * HEAD_DIM,
    NSA_KV_GROUPS * HEAD_DIM,
    NSA_KV_GROUPS * HEAD_DIM,
    NSA_HEADS * 3,
    DIFF_HEADS * 2 * HEAD_DIM,
    DIFF_HEADS * 2 * HEAD_DIM,
    DIFF_HEADS * DIFF_V_DIM,
    2 * D_MODEL,
)
D_IN_PROJ = int(sum(SPLIT_SIZES))
SPLIT_POINTS = tuple(int(v) for v in np.cumsum(SPLIT_SIZES)[:-1])

kernel_name = 'hybrid_nsa_diffattn_gated_block'


def rms_norm(x, g):
    xf = x.astype(jnp.float32)
    y = xf * lax.rsqrt(jnp.mean(xf * xf, axis=-1, keepdims=True) + EPS)
    return (y * g.astype(jnp.float32)).astype(x.dtype)


def masked_softmax(logits, mask):
    z = jnp.where(mask, logits, NEG)
    m = jnp.max(z, axis=-1, keepdims=True)
    e = jnp.where(mask, jnp.exp(z - m), 0.0)
    return e / jnp.maximum(jnp.sum(e, axis=-1, keepdims=True), 1e-30)


def t5_bucket(rel):
    n = jnp.maximum(rel, 0)
    nf = jnp.maximum(n, 1).astype(jnp.float32)
    large = REL_MAX_EXACT + (jnp.log(nf / REL_MAX_EXACT) / math.log(REL_MAX_DIST / REL_MAX_EXACT)
                             * (REL_BUCKETS - REL_MAX_EXACT)).astype(jnp.int32)
    large = jnp.minimum(large, REL_BUCKETS - 1)
    return jnp.where(n < REL_MAX_EXACT, n, large)


def compress_blocks(kv, pe, w1, w2):
    B, G, S, D = kv.shape
    halves = kv.reshape(B, G, S // CMP_STRIDE, CMP_STRIDE, D)
    nxt = jnp.pad(halves[:, :, 1:], ((0, 0), (0, 0), (0, 1), (0, 0), (0, 0)))
    blocks = jnp.concatenate([halves, nxt], axis=3) + pe
    hid = jax.nn.gelu(blocks.reshape(B, G, S // CMP_STRIDE, CMP_LEN * D) @ w1)
    return hid @ w2


def nsa_mixer(q, k_cmp, v_cmp, k_slc, v_slc, k_win, v_win, gates, table_nsa):
    B, G, P, S, D = q.shape
    scale = D ** -0.5
    n_cmp = S // CMP_STRIDE
    n_sel = S // SEL_LEN
    top_n = min(SEL_TOPK, n_sel)
    r_m = SEL_LEN // CMP_STRIDE
    r_n = CMP_LEN // CMP_STRIDE
    overlap = [sum(1 for m in range(r_m) for n in range(r_n) if m + n == s)
               for s in range(r_m + r_n - 1)]
    k_blk = k_slc.reshape(B, G, n_sel, SEL_LEN, D)
    v_blk = v_slc.reshape(B, G, n_sel, SEL_LEN, D)
    wpad = ((0, 0), (0, 0), (WINDOW, 0), (0, 0))
    k_wp = jnp.pad(k_win, wpad)
    v_wp = jnp.pad(v_win, wpad)
    c_end = jnp.arange(n_cmp, dtype=jnp.int32) * CMP_STRIDE + CMP_LEN - 1
    blk_ids = jnp.arange(n_sel, dtype=jnp.int32)
    sel_off = jnp.arange(SEL_LEN, dtype=jnp.int32)
    bi = jnp.arange(B)[:, None, None, None]
    gi = jnp.arange(G)[None, :, None, None]
    gi5 = gi[..., None]
    span = NSA_Q_BLOCK + WINDOW

    def block(i):
        t0 = i * NSA_Q_BLOCK
        tpos = t0 + jnp.arange(NSA_Q_BLOCK, dtype=jnp.int32)
        qb = lax.dynamic_slice_in_dim(q, t0, NSA_Q_BLOCK, axis=3)
        gb = lax.dynamic_slice_in_dim(gates, t0, NSA_Q_BLOCK, axis=3)
        rel_c = tpos[:, None] - c_end[None, :]
        bias_c = jnp.transpose(table_nsa[t5_bucket(rel_c)], (2, 3, 0, 1)).astype(jnp.float32)
        s_c = jnp.einsum('bgpqd,bgcd->bgpqc', qb, k_cmp).astype(jnp.float32) * scale + bias_c
        p_c = masked_softmax(s_c, rel_c >= 0)
        o_c = jnp.einsum('bgpqc,bgcd->bgpqd', p_c.astype(v_cmp.dtype), v_cmp)
        imp = jnp.pad(p_c.sum(axis=2), ((0, 0), (0, 0), (0, 0), (0, len(overlap) - 1)))
        p_slc = sum(w * imp[..., s: s + n_cmp: r_m] for s, w in enumerate(overlap))
        j_t = (tpos // SEL_LEN)[:, None]
        forced = (blk_ids == 0) | (blk_ids == j_t) | (blk_ids == j_t - 1)
        score = jnp.where(forced, BIG, jnp.where(blk_ids > j_t, NEG, p_slc))
        _, idx = lax.top_k(score, top_n)
        ks = k_blk[bi, gi, idx]
        vs = v_blk[bi, gi, idx]
        spos = idx[..., None] * SEL_LEN + sel_off
        rel_s = tpos[:, None, None] - spos
        bias_s = jnp.moveaxis(table_nsa[t5_bucket(rel_s), gi5], -1, 2).astype(jnp.float32)
        s_s = jnp.einsum('bgpqd,bgqnld->bgpqnl', qb, ks).astype(jnp.float32) * scale + bias_s
        m_sel = top_n * SEL_LEN
        p_s = masked_softmax(s_s.reshape(B, G, P, NSA_Q_BLOCK, m_sel),
                             (rel_s >= 0).reshape(B, G, 1, NSA_Q_BLOCK, m_sel))
        o_s = jnp.einsum('bgpqm,bgqmd->bgpqd', p_s.astype(vs.dtype),
                         vs.reshape(B, G, NSA_Q_BLOCK, m_sel, D))
        kwb = lax.dynamic_slice_in_dim(k_wp, t0, span, axis=2)
        vwb = lax.dynamic_slice_in_dim(v_wp, t0, span, axis=2)
        wpos = t0 - WINDOW + jnp.arange(span, dtype=jnp.int32)
        rel_w = tpos[:, None] - wpos[None, :]
        mask_w = (rel_w >= 0) & (rel_w < WINDOW) & (wpos[None, :] >= 0)
        bias_w = jnp.transpose(table_nsa[t5_bucket(rel_w)], (2, 3, 0, 1)).astype(jnp.float32)
        s_w = jnp.einsum('bgpqd,bgkd->bgpqk', qb, kwb).astype(jnp.float32) * scale + bias_w
        p_w = masked_softmax(s_w, mask_w)
        o_w = jnp.einsum('bgpqk,bgkd->bgpqd', p_w.astype(vwb.dtype), vwb)
        return gb[..., 0:1] * o_c + gb[..., 1:2] * o_s + gb[..., 2:3] * o_w

    out = lax.map(block, jnp.arange(S // NSA_Q_BLOCK, dtype=jnp.int32))
    return out.transpose(1, 0, 4, 2, 3, 5).reshape(B, S, G * P * D)


def diff_mixer(q1, q2, k1, k2, v, lam, table_diff):
    B, H, S, D = q1.shape
    scale = D ** -0.5
    kpos = jnp.arange(S, dtype=jnp.int32)

    def block(i):
        t0 = i * DIFF_Q_BLOCK
        tpos = t0 + jnp.arange(DIFF_Q_BLOCK, dtype=jnp.int32)
        rel = tpos[:, None] - kpos[None, :]
        mask = rel >= 0
        bias = jnp.transpose(table_diff[t5_bucket(rel)], (2, 0, 1)).astype(jnp.float32)
        q1b = lax.dynamic_slice_in_dim(q1, t0, DIFF_Q_BLOCK, axis=2)
        q2b = lax.dynamic_slice_in_dim(q2, t0, DIFF_Q_BLOCK, axis=2)
        a1 = masked_softmax(jnp.einsum('bhqd,bhkd->bhqk', q1b, k1).astype(jnp.float32) * scale + bias, mask)
        a2 = masked_softmax(jnp.einsum('bhqd,bhkd->bhqk', q2b, k2).astype(jnp.float32) * scale + bias, mask)
        a = a1 - lam * a2
        return jnp.einsum('bhqk,bhkd->bhqd', a.astype(v.dtype), v)

    out = lax.map(block, jnp.arange(S // DIFF_Q_BLOCK, dtype=jnp.int32))
    return out.transpose(1, 2, 0, 3, 4).reshape(B, H, S, v.shape[-1])


def setup_inputs(seed: int = 0) -> dict:
    key = jax.random.key(seed)
    ks = jax.random.split(key, 24)

    def nrm(k, shape, scale):
        return jax.random.normal(k, shape, jnp.float32) * scale

    kvin = CMP_LEN * HEAD_DIM
    return {
        'x': nrm(ks[0], (BATCH, SEQ, D_MODEL), 1.0),
        'norm_mix_g': 1.0 + nrm(ks[1], (DEPTH, D_MODEL), 0.02),
        'w_in': nrm(ks[2], (DEPTH, D_MODEL, D_IN_PROJ), D_MODEL ** -0.5),
        'cmp_pe_k': nrm(ks[3], (DEPTH, CMP_LEN, HEAD_DIM), 0.1),
        'cmp_pe_v': nrm(ks[4], (DEPTH, CMP_LEN, HEAD_DIM), 0.1),
        'cmp_w1_k': nrm(ks[5], (DEPTH, kvin, CMP_HIDDEN), kvin ** -0.5),
        'cmp_w2_k': nrm(ks[6], (DEPTH, CMP_HIDDEN, HEAD_DIM), CMP_HIDDEN ** -0.5),
        'cmp_w1_v': nrm(ks[7], (DEPTH, kvin, CMP_HIDDEN), kvin ** -0.5),
        'cmp_w2_v': nrm(ks[8], (DEPTH, CMP_HIDDEN, HEAD_DIM), CMP_HIDDEN ** -0.5),
        'diff_lq1': nrm(ks[9], (DEPTH, HEAD_DIM), 0.1),
        'diff_lk1': nrm(ks[10], (DEPTH, HEAD_DIM), 0.1),
        'diff_lq2': nrm(ks[11], (DEPTH, HEAD_DIM), 0.1),
        'diff_lk2': nrm(ks[12], (DEPTH, HEAD_DIM), 0.1),
        'diff_head_g': 1.0 + nrm(ks[13], (DEPTH, DIFF_HEADS, DIFF_V_DIM), 0.02),
        'w_up_nsa': nrm(ks[14], (DEPTH, NSA_WIDTH, D_MODEL), NSA_WIDTH ** -0.5),
        'w_up_diff': nrm(ks[15], (DEPTH, DIFF_WIDTH, D_MODEL), DIFF_WIDTH ** -0.5),
        'w_out': nrm(ks[16], (DEPTH, D_MODEL, D_MODEL), D_MODEL ** -0.5),
        'norm_ff_g': 1.0 + nrm(ks[17], (DEPTH, D_MODEL), 0.02),
        'w_ff_in': nrm(ks[18], (DEPTH, D_MODEL, 2 * D_FF), D_MODEL ** -0.5),
        'w_ff_out': nrm(ks[19], (DEPTH, D_FF, D_MODEL), D_FF ** -0.5),
        'rel_bias_table': nrm(ks[20], (REL_BUCKETS, N_BIAS_HEADS), 0.1),
        'norm_final_g': 1.0 + nrm(ks[21], (D_MODEL,), 0.02),
    }


def reference(x, norm_mix_g, w_in, cmp_pe_k, cmp_pe_v, cmp_w1_k, cmp_w2_k, cmp_w1_v, cmp_w2_v,
              diff_lq1, diff_lk1, diff_lq2, diff_lk2, diff_head_g, w_up_nsa, w_up_diff, w_out,
              norm_ff_g, w_ff_in, w_ff_out, rel_bias_table, norm_final_g):
    B, S, _ = x.shape
    G, P, HD = NSA_KV_GROUPS, NSA_HPG, HEAD_DIM
    table_nsa = rel_bias_table[:, :NSA_HEADS].reshape(REL_BUCKETS, G, P)
    table_diff = rel_bias_table[:, NSA_HEADS:]

    def groups(t, n):
        return t.reshape(B, S, n, -1).transpose(0, 2, 1, 3)

    for l in range(DEPTH):
        h = rms_norm(x, norm_mix_g[l])
        proj = h @ w_in[l]
        (q_n, kc, vc, ksl, vsl, kw, vw, g_n, q_d, k_d, v_d, g_m) = jnp.split(proj, SPLIT_POINTS, axis=-1)
        q_n = q_n.reshape(B, S, G, P, HD).transpose(0, 2, 3, 1, 4)
        k_cmp = compress_blocks(groups(kc, G), cmp_pe_k[l], cmp_w1_k[l], cmp_w2_k[l])
        v_cmp = compress_blocks(groups(vc, G), cmp_pe_v[l], cmp_w1_v[l], cmp_w2_v[l])
        nsa_gates = jax.nn.sigmoid(g_n.reshape(B, S, G, P, 3).transpose(0, 2, 3, 1, 4))
        o_nsa = nsa_mixer(q_n, k_cmp, v_cmp, groups(ksl, G), groups(vsl, G),
                          groups(kw, G), groups(vw, G), nsa_gates, table_nsa)
        q_d = q_d.reshape(B, S, DIFF_HEADS, 2, HD)
        k_d = k_d.reshape(B, S, DIFF_HEADS, 2, HD)
        q1 = q_d[:, :, :, 0].transpose(0, 2, 1, 3)
        q2 = q_d[:, :, :, 1].transpose(0, 2, 1, 3)
        k1 = k_d[:, :, :, 0].transpose(0, 2, 1, 3)
        k2 = k_d[:, :, :, 1].transpose(0, 2, 1, 3)
        lam_init = 0.8 - 0.6 * math.exp(-0.3 * l)
        lam = (jnp.exp(jnp.sum(diff_lq1[l].astype(jnp.float32) * diff_lk1[l].astype(jnp.float32)))
               - jnp.exp(jnp.sum(diff_lq2[l].astype(jnp.float32) * diff_lk2[l].astype(jnp.float32)))
               + lam_init)
        o_d = diff_mixer(q1, q2, k1, k2, groups(v_d, DIFF_HEADS), lam, table_diff)
        o_d = rms_norm(o_d, diff_head_g[l][:, None, :]) * (1.0 - lam_init)
        o_d = o_d.transpose(0, 2, 1, 3).reshape(B, S, DIFF_WIDTH)
        g_a, g_b = jnp.split(jax.nn.sigmoid(g_m), 2, axis=-1)
        mixed = (g_a * (o_nsa @ w_up_nsa[l]) + g_b * (o_d @ w_up_diff[l])) @ w_out[l]
        x = x + mixed
        h = rms_norm(x, norm_ff_g[l])
        a, b = jnp.split(h @ w_ff_in[l], 2, axis=-1)
        x = x + (jax.nn.silu(a) * b) @ w_ff_out[l]
    return rms_norm(x, norm_final_g)
```

```cpp
#include <hip/hip_runtime.h>
#include <hip/hip_cooperative_groups.h>
#include <cstdio>
#include <cstdint>
namespace cg = cooperative_groups;

#ifndef MK_N_LAUNCHES
#define MK_N_LAUNCHES 1
#endif
#define CMP_IN_P4 1
#define DUP_MASK 0x0

#define LAS __attribute__((address_space(3)))
typedef unsigned short bf16_t;
typedef short bf16x8 __attribute__((ext_vector_type(8)));
typedef short s16x4 __attribute__((ext_vector_type(4)));
typedef float f32x4 __attribute__((ext_vector_type(4)));
typedef float f32x16 __attribute__((ext_vector_type(16)));
typedef unsigned u32x4 __attribute__((ext_vector_type(4)));
typedef unsigned u32x2 __attribute__((ext_vector_type(2)));

constexpr int SEQ = 16384, NBATCH = 2, TOK = NBATCH * SEQ, DM = 2048, DFF = 5632, HD = 128;
constexpr int NPROJ_SRC = 9752, NPROJ = 9984;
constexpr int KCROWS = SEQ + 16;
constexpr float SM_SCALE = 0.08838834764831845f;
constexpr float RMS_EPS = 1e-6f;

constexpr size_t WS_WIN  = 1u << 20;
constexpr size_t WS_WFFI = WS_WIN  + (size_t)NPROJ * DM * 2;
constexpr size_t WS_WFFO = WS_WFFI + (size_t)2 * DFF * DM * 2;
constexpr size_t WS_WOUT = WS_WFFO + (size_t)DM * DFF * 2;
constexpr size_t WS_WUPN = WS_WOUT + (size_t)DM * DM * 2;
constexpr size_t WS_WUPD = WS_WUPN + (size_t)DM * 1024 * 2;
constexpr size_t WS_W1K  = WS_WUPD + (size_t)DM * 1024 * 2;
constexpr size_t WS_W1V  = WS_W1K + (size_t)256 * 4096 * 2;
constexpr size_t WS_W2K  = WS_W1V + (size_t)256 * 4096 * 2;
constexpr size_t WS_W2V  = WS_W2K + (size_t)256 * 256 * 2;
constexpr size_t WS_BK   = WS_W2V + (size_t)256 * 256 * 2;
constexpr size_t WS_BV   = WS_BK + 1024;
constexpr size_t WS_XN   = WS_BV + 1024;
constexpr size_t WS_QN   = WS_XN + (size_t)TOK * DM * 2;
constexpr size_t WS_KC   = WS_QN + (size_t)TOK * 1024 * 2;
constexpr size_t WS_VC   = WS_KC + (size_t)4 * KCROWS * 128 * 2;
constexpr size_t WS_KSL  = WS_VC + (size_t)4 * KCROWS * 128 * 2;
constexpr size_t WS_VSL  = WS_KSL + (size_t)4 * SEQ * 128 * 2;
constexpr size_t WS_KW   = WS_VSL + (size_t)4 * SEQ * 128 * 2;
constexpr size_t WS_VW   = WS_KW + (size_t)4 * SEQ * 128 * 2;
constexpr size_t WS_QD   = WS_VW + (size_t)4 * SEQ * 128 * 2;
constexpr size_t WS_KD   = WS_QD + (size_t)TOK * 1024 * 2;
constexpr size_t WS_VD   = WS_KD + (size_t)TOK * 1024 * 2;
constexpr size_t WS_GM   = WS_VD + (size_t)TOK * 1024 * 2;
constexpr size_t WS_GN   = WS_GM + (size_t)TOK * 4096 * 2;
constexpr size_t WS_HK   = WS_GN + (size_t)TOK * 24 * 4;
constexpr size_t WS_HV   = WS_HK + (size_t)4096 * 256 * 2;
constexpr size_t WS_KCMP = WS_HV + (size_t)4096 * 256 * 2;
constexpr size_t WS_VCMP = WS_KCMP + (size_t)4096 * 128 * 2;
constexpr size_t WS_SELM = WS_VCMP + (size_t)4096 * 128 * 2;
constexpr size_t WS_END  = WS_SELM + (size_t)4 * SEQ * 8 * 4;
constexpr size_t WS_O12  = WS_XN;
constexpr size_t WS_ONSA = WS_QD;
constexpr size_t WS_OD   = WS_KD;
constexpr size_t WS_MIX  = WS_XN;
constexpr size_t WS_HID  = WS_QN;
static_assert(WS_HID + (size_t)TOK * DFF * 2 <= WS_GM, "HID overlay");
static_assert(WS_END <= (size_t)1 << 30, "workspace");

constexpr int LDS_BYTES = 163840;

__device__ __forceinline__ unsigned cvtpk(float lo, float hi) { unsigned r; asm volatile("v_cvt_pk_bf16_f32 %0, %1, %2" : "=v"(r) : "v"(lo), "v"(hi)); return r; }
__device__ __forceinline__ float bf2f(unsigned short h) { return __uint_as_float((unsigned)h << 16); }
__device__ __forceinline__ float sigmoidf_(float x) { return __builtin_amdgcn_rcpf(1.f + __builtin_amdgcn_exp2f(-1.4426950408889634f * x)); }
__device__ __forceinline__ int lane_id() {
    unsigned l; asm volatile("v_mbcnt_lo_u32_b32 %0, -1, 0\n\tv_mbcnt_hi_u32_b32 %0, -1, %0" : "=v"(l)); return (int)(l & 63u); }
__device__ __forceinline__ float xor1_(float v) { return __int_as_float(__builtin_amdgcn_update_dpp(0, __float_as_int(v), 0xB1, 0xf, 0xf, false)); }
#define DPP_F(v, ctrl) __int_as_float(__builtin_amdgcn_update_dpp(0, __float_as_int(v), ctrl, 0xf, 0xf, false))
__device__ __forceinline__ float row16_sum(float v) {
    v += DPP_F(v, 0xB1); v += DPP_F(v, 0x4E); v += DPP_F(v, 0x141); v += DPP_F(v, 0x140); return v; }
__device__ __forceinline__ float wave_sum(float v) {
    v = row16_sum(v);
    { auto rr = __builtin_amdgcn_permlane16_swap(__float_as_uint(v), __float_as_uint(v), false, false); v = __uint_as_float(rr[0]) + __uint_as_float(rr[1]); }
    { auto rr = __builtin_amdgcn_permlane32_swap(__float_as_uint(v), __float_as_uint(v), false, false); v = __uint_as_float(rr[0]) + __uint_as_float(rr[1]); }
    return v;
}

namespace pg8 {
constexpr int BM = 256, BK = 64, HALF = 128, HTB = HALF * BK * 2, STAGE_BYTES = 8 * HTB, NXCD = 8, WGM = 8;
__host__ __device__ __forceinline__ int lds_byte(int r, int c) { const int st = (r >> 4) * 2 + (c >> 5), rr = r & 15, cc = c & 31, ob = rr * 64 + cc * 2; return st * 1024 + (ob ^ (((ob >> 9) & 1) << 5)); }
__host__ __device__ __forceinline__ void stage_rc(int b, int& R, int& C) { const int st = b / 1024, sb = b % 1024, swz = sb ^ (((sb >> 9) & 1) << 5); R = (st >> 1) * 16 + swz / 64; C = (st & 1) * 32 + (swz % 64) / 2; }
__host__ __device__ __forceinline__ int perm32(int rho) { const int n = rho >> 4, i = rho & 15; return 8 * (i >> 2) + 4 * n + (i & 3); }
struct Unit { int pm, pn; };
struct Gemm { const bf16_t* A; const bf16_t* Bt; int M, N, K, lda, tps; size_t slab; };
struct StaticOrder {
    int nM, nN, nwg, G, c;
    __device__ void init(int M, int N, int G_, int c_) { nM = M / BM; nN = N / BM; nwg = nM * nN; G = G_; c = c_; }
    __device__ bool next(int i, Unit& u) const {
        const long L = (long)i * G + c; if (L >= nwg) return false;
        int wgid = (int)L; { const int q = nwg / NXCD, r = nwg % NXCD, xcd = wgid % NXCD, off = wgid / NXCD; wgid = (xcd < r ? xcd * (q + 1) : r * (q + 1) + (xcd - r) * q) + off; }
        const int nig = WGM * nN, gid = wgid / nig, fm = gid * WGM, gsz = (nM - fm) < WGM ? (nM - fm) : WGM;
        u.pm = fm + ((wgid % nig) % gsz); u.pn = (wgid % nig) / gsz; return true;
    }
    __device__ __forceinline__ bool first(Unit& u, int, LAS unsigned char*) { return next(0, u); }
    __device__ __forceinline__ bool advance(int ui, Unit& u, int, LAS unsigned char*) { return next(ui + 1, u); }
};
struct QueueOrder {
    int nM, nN, start, cnt; unsigned* ctr; unsigned id_nxt, pend;
    __device__ void init(int M, int N, int xq, unsigned* ctr_) { nM = M / BM; nN = N / BM; const int nwg = nM * nN, q = nwg / NXCD, r = nwg % NXCD;
        cnt = q + (xq < r ? 1 : 0); start = xq < r ? xq * (q + 1) : r * (q + 1) + (xq - r) * q; ctr = ctr_ + xq; id_nxt = 0u; pend = 0u; }
    __device__ __forceinline__ bool decode(unsigned off, Unit& u) const { if (off >= (unsigned)cnt) return false; const int wgid = start + (int)off;
        const int nig = WGM * nN, gid = wgid / nig, fm = gid * WGM, gsz = (nM - fm) < WGM ? (nM - fm) : WGM;
        u.pm = fm + ((wgid % nig) % gsz); u.pn = (wgid % nig) / gsz; return true; }
    __device__ __forceinline__ bool first(Unit& u, int tid, LAS unsigned char* lds) {
        volatile LAS unsigned* qw = (volatile LAS unsigned*)(lds + STAGE_BYTES + 64);
        if (tid == 0) { const unsigned a0 = atomicAdd(ctr, 1u), a1 = atomicAdd(ctr, 1u); qw[0] = a0; qw[1] = a1; }
        asm volatile("s_waitcnt vmcnt(0) lgkmcnt(0)" ::: "memory"); __builtin_amdgcn_s_barrier(); __builtin_amdgcn_s_barrier(); asm volatile("" ::: "memory");
        const unsigned i0 = (unsigned)__builtin_amdgcn_readfirstlane((int)qw[0]); id_nxt = (unsigned)__builtin_amdgcn_readfirstlane((int)qw[1]);
        asm volatile("s_waitcnt lgkmcnt(0)" ::: "memory"); __builtin_amdgcn_s_barrier(); asm volatile("" ::: "memory");
        if (tid == 0) pend = atomicAdd(ctr, 1u);
        return decode(i0, u);
    }
    __device__ __forceinline__ bool advance(int, Unit& u, int tid, LAS unsigned char* lds) {
        volatile LAS unsigned* qw = (volatile LAS unsigned*)(lds + STAGE_BYTES + 64);
        const bool ok = decode(id_nxt, u);
        if (tid == 0) qw[0] = pend;
        asm volatile("s_waitcnt lgkmcnt(0)" ::: "memory"); __builtin_amdgcn_s_barrier(); __builtin_amdgcn_s_barrier(); asm volatile("" ::: "memory");
        id_nxt = (unsigned)__builtin_amdgcn_readfirstlane((int)qw[0]); asm volatile("s_waitcnt lgkmcnt(0)" ::: "memory");
        if (tid == 0) pend = atomicAdd(ctr, 1u);
        return ok;
    }
};
template <class Epi, class Sched>
__device__ __forceinline__ void gemm_phase(LAS unsigned char* lds, const Gemm g, Sched& S, const Epi& E, const int wid) {
    const int lane = lane_id(), tid = wid * 64 + lane, wr = wid >> 2, wc = wid & 3, fr = lane & 15, fq = lane >> 4;
    const int K = g.K, nt = K / BK, lda = g.lda;
    unsigned voffA[2], voffB[2];
#pragma unroll
    for (int i = 0; i < 2; ++i) { int R, C; stage_rc(tid * 16 + i * 8192, R, C); const int Rb = (R & ~31) + perm32(R & 31);
        voffA[i] = (unsigned)(R * lda + C) * 2u; voffB[i] = (unsigned)(Rb * K + C) * 2u; }
    const size_t kstep = (size_t)(BK * 2);
    const size_t hstepA = (size_t)HALF * lda * 2, hstepB = (size_t)HALF * K * 2;
    const unsigned ldsw = (unsigned)wid * 1024u;
    const int aoff = lds_byte(wr * 64 + fr, fq * 8), boff = lds_byte(wc * 32 + fr, fq * 8);
#define PG8_TILEA(pm) ((const char*)g.A + ((size_t)((pm) / g.tps) * g.slab + (size_t)((pm) % g.tps) * 256 * lda) * 2)
#define PG8_TILEB(pn) ((const char*)g.Bt + (size_t)(pn) * 2 * hstepB)
#define PG8_SA(b, h) (((b) * 2 + (h)) * HTB)
#define PG8_SB(b, h) ((4 + (b) * 2 + (h)) * HTB)
#define PG8_STAGE(bufoff, gbase, voff) do { _Pragma("unroll") for (int _i = 0; _i < 2; ++_i) \
        __builtin_amdgcn_global_load_lds((const unsigned*)((const char*)(gbase) + (voff)[_i]), (LAS unsigned*)(lds + (bufoff) + ldsw + _i * 8192), 16, 0, 0); } while (0)
#define PG8_LDA(dst, b, h) do { _Pragma("unroll") for (int m = 0; m < 4; ++m) _Pragma("unroll") for (int k = 0; k < 2; ++k) dst[m][k] = *(const LAS bf16x8*)(lds + PG8_SA(b, h) + aoff + m * 2048 + k * 1024); } while (0)
#define PG8_LDB(dst, b, h) do { _Pragma("unroll") for (int n = 0; n < 2; ++n) _Pragma("unroll") for (int k = 0; k < 2; ++k) dst[n][k] = *(const LAS bf16x8*)(lds + PG8_SB(b, h) + boff + n * 2048 + k * 1024); } while (0)
#define PG8_MMA(ai, bj, At, Bt) do { __builtin_amdgcn_s_setprio(1); _Pragma("unroll") for (int m = 0; m < 4; ++m) _Pragma("unroll") for (int n = 0; n < 2; ++n) _Pragma("unroll") for (int k = 0; k < 2; ++k) \
        acc[ai][bj][m][n] = __builtin_amdgcn_mfma_f32_16x16x32_bf16(Bt[n][k], At[m][k], acc[ai][bj][m][n], 0, 0, 0); __builtin_amdgcn_s_setprio(0); } while (0)
#define PG8_WAIT_V(n) asm volatile("s_waitcnt vmcnt(" #n ")" ::: "memory")
#define PG8_WAIT_L(n) asm volatile("s_waitcnt lgkmcnt(" #n ")" ::: "memory")
#define PG8_BAR __builtin_amdgcn_s_barrier()
#define PG8_SCHED __builtin_amdgcn_sched_barrier(0)
    Unit cur, nxt; int ui = 0;
    if (!S.first(cur, tid, lds)) return;
    f32x4 acc[2][2][4][2];
#pragma unroll
    for (int a = 0; a < 2; ++a)
#pragma unroll
        for (int b = 0; b < 2; ++b)
#pragma unroll
            for (int m = 0; m < 4; ++m)
#pragma unroll
                for (int n = 0; n < 2; ++n) acc[a][b][m][n] = (f32x4){0.f, 0.f, 0.f, 0.f};
    bf16x8 At[4][2], B0[2][2], B1[2][2];
    const char* cA = PG8_TILEA(cur.pm); const char* cB = PG8_TILEB(cur.pn);
    PG8_STAGE(PG8_SB(0, 0), cB, voffB); PG8_STAGE(PG8_SB(0, 1), cB + hstepB, voffB); PG8_STAGE(PG8_SA(0, 0), cA, voffA); PG8_STAGE(PG8_SA(0, 1), cA + hstepA, voffA);
    if (wr == 1) PG8_BAR;
    PG8_WAIT_V(2); PG8_BAR;
    PG8_STAGE(PG8_SB(1, 0), cB + kstep, voffB); PG8_STAGE(PG8_SA(1, 0), cA + kstep, voffA); PG8_STAGE(PG8_SB(1, 1), cB + hstepB + kstep, voffB);
    PG8_WAIT_V(6); PG8_BAR;
    for (;;) {
        const bool has_next = S.advance(ui, nxt, tid, lds);
        const char* nA = has_next ? PG8_TILEA(nxt.pm) : cA; const char* nB = has_next ? PG8_TILEB(nxt.pn) : cB;
        for (int t = 0; t < nt; t += 2) {
            const bool last = (t == nt - 2);
            const char* a1 = cA + (size_t)(t + 1) * kstep;
            const char* a2 = last ? nA : cA + (size_t)(t + 2) * kstep; const char* b2 = last ? nB : cB + (size_t)(t + 2) * kstep;
            const char* a3 = a2 + kstep; const char* b3 = b2 + kstep;
            PG8_LDB(B0, 0, 0); PG8_LDB(B1, 0, 1); PG8_SCHED; PG8_LDA(At, 0, 0); PG8_STAGE(PG8_SA(1, 1), a1 + hstepA, voffA);
            PG8_WAIT_V(8); PG8_WAIT_L(0); PG8_BAR; PG8_MMA(0, 0, At, B0); PG8_MMA(0, 1, At, B1); PG8_BAR; PG8_SCHED;
            PG8_LDA(At, 0, 1); PG8_STAGE(PG8_SB(0, 0), b2, voffB); PG8_STAGE(PG8_SB(0, 1), b2 + hstepB, voffB); PG8_STAGE(PG8_SA(0, 0), a2, voffA);
            PG8_WAIT_V(8); PG8_WAIT_L(0); PG8_BAR; PG8_MMA(1, 0, At, B0); PG8_MMA(1, 1, At, B1); PG8_BAR; PG8_SCHED;
            PG8_LDB(B0, 1, 0); PG8_LDB(B1, 1, 1); PG8_SCHED; PG8_LDA(At, 1, 0); PG8_STAGE(PG8_SA(0, 1), a2 + hstepA, voffA);
            PG8_WAIT_V(8); PG8_WAIT_L(0); PG8_BAR; PG8_MMA(0, 0, At, B0); PG8_MMA(0, 1, At, B1); PG8_BAR; PG8_SCHED;
            PG8_LDA(At, 1, 1); PG8_STAGE(PG8_SB(1, 0), b3, voffB); PG8_STAGE(PG8_SB(1, 1), b3 + hstepB, voffB); PG8_STAGE(PG8_SA(1, 0), a3, voffA);
            PG8_WAIT_V(8); PG8_WAIT_L(0); PG8_BAR; PG8_MMA(1, 0, At, B0); PG8_MMA(1, 1, At, B1); PG8_BAR; PG8_SCHED;
        }
        if (wr == 0) PG8_BAR;
        E(acc, cur, wr, wc, fr, fq);
        if (!has_next) break;
#pragma unroll
        for (int a = 0; a < 2; ++a)
#pragma unroll
            for (int b = 0; b < 2; ++b)
#pragma unroll
                for (int m = 0; m < 4; ++m)
#pragma unroll
                    for (int n = 0; n < 2; ++n) acc[a][b][m][n] = (f32x4){0.f, 0.f, 0.f, 0.f};
        cur = nxt; cA = nA; cB = nB; ++ui;
        if (wr == 1) PG8_BAR;
    }
    PG8_WAIT_V(0);
    PG8_BAR;
#undef PG8_TILEA
#undef PG8_TILEB
#undef PG8_SA
#undef PG8_SB
#undef PG8_STAGE
#undef PG8_LDA
#undef PG8_LDB
#undef PG8_MMA
#undef PG8_WAIT_V
#undef PG8_WAIT_L
#undef PG8_BAR
#undef PG8_SCHED
}

typedef f32x4 Acc[2][2][4][2];
__device__ __forceinline__ u32x4 pack8v(f32x4 a, f32x4 b) { u32x4 w; w.x = cvtpk(a[0], a[1]); w.y = cvtpk(a[2], a[3]); w.z = cvtpk(b[0], b[1]); w.w = cvtpk(b[2], b[3]); return w; }
__device__ __forceinline__ void unpack8(u32x4 w, f32x4& a, f32x4& b) {
    a[0] = __uint_as_float(w.x << 16); a[1] = __uint_as_float(w.x & 0xffff0000u); a[2] = __uint_as_float(w.y << 16); a[3] = __uint_as_float(w.y & 0xffff0000u);
    b[0] = __uint_as_float(w.z << 16); b[1] = __uint_as_float(w.z & 0xffff0000u); b[2] = __uint_as_float(w.w << 16); b[3] = __uint_as_float(w.w & 0xffff0000u);
}

struct EpiProj {
    unsigned char* ws;
    __device__ __forceinline__ void operator()(const Acc& acc, const Unit& u, int wr, int wc, int fr, int fq) const {
        const int d = wc * 32 + 8 * fq;
#pragma unroll
        for (int bj = 0; bj < 2; ++bj) {
            const int blk = u.pn * 2 + bj;
            if (blk >= 77) continue;
            bf16_t* base; size_t bstride; int kind = 0;
            if (blk < 8)       { base = (bf16_t*)(ws + WS_QN) + (size_t)blk * SEQ * 128; bstride = (size_t)8 * SEQ * 128; }
            else if (blk < 10) { base = (bf16_t*)(ws + WS_KC) + (size_t)(blk - 8) * KCROWS * 128; bstride = (size_t)2 * KCROWS * 128; }
            else if (blk < 12) { base = (bf16_t*)(ws + WS_VC) + (size_t)(blk - 10) * KCROWS * 128; bstride = (size_t)2 * KCROWS * 128; }
            else if (blk < 14) { base = (bf16_t*)(ws + WS_KSL) + (size_t)(blk - 12) * SEQ * 128; bstride = (size_t)2 * SEQ * 128; }
            else if (blk < 16) { base = (bf16_t*)(ws + WS_VSL) + (size_t)(blk - 14) * SEQ * 128; bstride = (size_t)2 * SEQ * 128; }
            else if (blk < 18) { base = (bf16_t*)(ws + WS_KW) + (size_t)(blk - 16) * SEQ * 128; bstride = (size_t)2 * SEQ * 128; }
            else if (blk < 20) { base = (bf16_t*)(ws + WS_VW) + (size_t)(blk - 18) * SEQ * 128; bstride = (size_t)2 * SEQ * 128; }
            else if (blk < 28) { base = (bf16_t*)(ws + WS_QD) + (size_t)(blk - 20) * SEQ * 128; bstride = (size_t)8 * SEQ * 128; }
            else if (blk < 36) { base = (bf16_t*)(ws + WS_KD) + (size_t)(blk - 28) * SEQ * 128; bstride = (size_t)8 * SEQ * 128; }
            else if (blk < 44) { base = (bf16_t*)(ws + WS_VD) + (size_t)(blk - 36) * SEQ * 128; bstride = (size_t)8 * SEQ * 128; }
            else if (blk < 76) { base = (bf16_t*)(ws + WS_GM) + (size_t)(blk - 44) * 128; bstride = 0; kind = 1; }
            else               { base = nullptr; bstride = 0; kind = 2; }
#pragma unroll
            for (int ai = 0; ai < 2; ++ai)
#pragma unroll
                for (int m = 0; m < 4; ++m) {
                    const int row = u.pm * 256 + ai * 128 + wr * 64 + m * 16 + fr;
                    f32x4 v0 = acc[ai][bj][m][0], v1 = acc[ai][bj][m][1];
                    if (kind == 0) {
                        const int b = row >> 14, s = row & (SEQ - 1);
                        *(u32x4*)(base + (size_t)b * bstride + (size_t)s * 128 + d) = pack8v(v0, v1);
                    } else if (kind == 1) {
#pragma unroll
                        for (int e = 0; e < 4; ++e) { v0[e] = sigmoidf_(v0[e]); v1[e] = sigmoidf_(v1[e]); }
                        *(u32x4*)(base + (size_t)row * 4096 + d) = pack8v(v0, v1);
                    } else {
                        if (d < 24) { float* gn = (float*)(ws + WS_GN) + (size_t)row * 24 + d;
#pragma unroll
                            for (int e = 0; e < 4; ++e) { v0[e] = sigmoidf_(v0[e]); v1[e] = sigmoidf_(v1[e]); }
                            *(f32x4*)gn = v0; *(f32x4*)(gn + 4) = v1; }
                    }
                }
        }
    }
};
struct EpiCmp1 {
    bf16_t* H; const float* bias;
    __device__ __forceinline__ void operator()(const Acc& acc, const Unit& u, int wr, int wc, int fr, int fq) const {
#pragma unroll
        for (int bj = 0; bj < 2; ++bj) {
            const int c = bj * 128 + wc * 32 + 8 * fq;
            const f32x4 b0 = *(const f32x4*)(bias + c), b1 = *(const f32x4*)(bias + c + 4);
#pragma unroll
            for (int ai = 0; ai < 2; ++ai)
#pragma unroll
                for (int m = 0; m < 4; ++m) {
                    const int row = u.pm * 256 + ai * 128 + wr * 64 + m * 16 + fr;
                    f32x4 v0 = acc[ai][bj][m][0] + b0, v1 = acc[ai][bj][m][1] + b1;
#pragma unroll
                    for (int e = 0; e < 4; ++e) {
                        float x = v0[e]; float t = 1.5957691216f * (x + 0.044715f * x * x * x); v0[e] = x * sigmoidf_(t);
                        x = v1[e]; t = 1.5957691216f * (x + 0.044715f * x * x * x); v1[e] = x * sigmoidf_(t); }
                    *(u32x4*)(H + (size_t)row * 256 + c) = pack8v(v0, v1);
                }
        }
    }
};
struct EpiCmp2 {
    bf16_t* O;
    __device__ __forceinline__ void operator()(const Acc& acc, const Unit& u, int wr, int wc, int fr, int fq) const {
        const int c = wc * 32 + 8 * fq;
#pragma unroll
        for (int ai = 0; ai < 2; ++ai)
#pragma unroll
            for (int m = 0; m < 4; ++m) {
                const int row = u.pm * 256 + ai * 128 + wr * 64 + m * 16 + fr;
                *(u32x4*)(O + (size_t)row * 128 + c) = pack8v(acc[ai][0][m][0], acc[ai][0][m][1]);
            }
    }
};
template <int MODE> struct EpiUp {
    bf16_t* T; const bf16_t* GM;
    __device__ __forceinline__ void operator()(const Acc& acc, const Unit& u, int wr, int wc, int fr, int fq) const {
#pragma unroll
        for (int bj = 0; bj < 2; ++bj) {
            const int c = u.pn * 256 + bj * 128 + wc * 32 + 8 * fq;
#pragma unroll
            for (int ai = 0; ai < 2; ++ai)
#pragma unroll
                for (int m = 0; m < 4; ++m) {
                    const int row = u.pm * 256 + ai * 128 + wr * 64 + m * 16 + fr;
                    f32x4 g0, g1; unpack8(*(const u32x4*)(GM + (size_t)row * 4096 + MODE * 2048 + c), g0, g1);
                    f32x4 v0 = acc[ai][bj][m][0] * g0, v1 = acc[ai][bj][m][1] * g1;
                    bf16_t* tp = T + (size_t)row * 2048 + c;
                    if (MODE == 1) { f32x4 t0, t1; unpack8(*(const u32x4*)tp, t0, t1); v0 += t0; v1 += t1; }
                    *(u32x4*)tp = pack8v(v0, v1);
                }
        }
    }
};
struct EpiRes {
    const float* res; float* out;
    __device__ __forceinline__ void operator()(const Acc& acc, const Unit& u, int wr, int wc, int fr, int fq) const {
#pragma unroll
        for (int bj = 0; bj < 2; ++bj) {
            const int c = u.pn * 256 + bj * 128 + wc * 32 + 8 * fq;
#pragma unroll
            for (int ai = 0; ai < 2; ++ai)
#pragma unroll
                for (int m = 0; m < 4; ++m) {
                    const size_t off = (size_t)(u.pm * 256 + ai * 128 + wr * 64 + m * 16 + fr) * DM + c;
                    const f32x4 r0 = *(const f32x4*)(res + off), r1 = *(const f32x4*)(res + off + 4);
                    *(f32x4*)(out + off) = r0 + acc[ai][bj][m][0]; *(f32x4*)(out + off + 4) = r1 + acc[ai][bj][m][1];
                }
        }
    }
};
struct EpiSwiglu {
    bf16_t* H;
    __device__ __forceinline__ void operator()(const Acc& acc, const Unit& u, int wr, int wc, int fr, int fq) const {
        const int c = u.pn * 128 + wc * 32 + 8 * fq;
#pragma unroll
        for (int ai = 0; ai < 2; ++ai)
#pragma unroll
            for (int m = 0; m < 4; ++m) {
                const int row = u.pm * 256 + ai * 128 + wr * 64 + m * 16 + fr;
                f32x4 v0, v1;
#pragma unroll
                for (int e = 0; e < 4; ++e) { const float a0 = acc[ai][0][m][0][e], a1 = acc[ai][0][m][1][e];
                    v0[e] = a0 * sigmoidf_(a0) * acc[ai][1][m][0][e]; v1[e] = a1 * sigmoidf_(a1) * acc[ai][1][m][1][e]; }
                *(u32x4*)(H + (size_t)row * DFF + c) = pack8v(v0, v1);
            }
    }
};
}

namespace att {
constexpr int D = 128, NW = 8, QBLK = 32, KVBLK = 64, QB = NW * QBLK;
constexpr int SHM_V = KVBLK * D * 2, SHM_K = KVBLK * D * 2;
constexpr int LDS_TB = 2 * SHM_V + 2 * SHM_K + NW * 64 * 4;
constexpr int LDS_TBX = LDS_TB + 12 * 128 * 4;
constexpr int TBXN = 544, TBX0 = 320;
constexpr int LDS_SEL = LDS_TBX + 12 * TBXN * 4;
constexpr int LDS_PSLC = LDS_TB + 12 * 128 * 4;
constexpr int BAND = 113;
constexpr float THR = 8.f;
#define KSWZ(row, colB) ((row) * 256 + ((colB) ^ (((row) & 7) << 4)))
#define SBAR() __builtin_amdgcn_sched_barrier(0)
__device__ __forceinline__ int v_st(int k, int c) { const int kk = (k & ~0xC) | ((k & 4) << 1) | ((k & 8) >> 1); return ((kk >> 3) * 4 + (c >> 5)) * 512 + ((kk & 7) * 32 + (c & 31)) * 2; }
__device__ __forceinline__ int v_rd_base(int lane) { return ((lane & 3) << 3) | (((lane >> 2) & 3) << 6) | (((lane >> 4) & 1) << 5) | (((lane >> 5) & 1) << 8); }
constexpr int v_rd_off(int d0, int ks, int half) { return d0 * 512 + ks * 4096 + half * 2048; }
__device__ __forceinline__ int crow(int r, int hi) { return (r & 3) + 8 * (r >> 2) + 4 * hi; }
__device__ __forceinline__ bf16x8 load8(const bf16_t* p) { return *reinterpret_cast<const bf16x8*>(p); }

__device__ __forceinline__ void bias_mask_tile(f32x16& p0, f32x16& p1, int dq, unsigned W, const float* tbx) {
    const float NEG = -__builtin_inff();
    const float* bp = tbx + (dq - 63);
#pragma unroll
    for (int r = 0; r < 16; ++r) {
        const int c = (r & 3) + 8 * (r >> 2);
        const unsigned r0 = (unsigned)(dq - c), r1 = (unsigned)(dq - c - 32);
        const float b0 = bp[63 - c], b1 = bp[31 - c];
        p0[r] = r0 >= W ? NEG : p0[r] + b0;
        p1[r] = r1 >= W ? NEG : p1[r] + b1;
        if ((r & 3) == 3) __builtin_amdgcn_sched_barrier(0);
    }
}
__device__ __forceinline__ void mask_tile(f32x16& p0, f32x16& p1, int dq, unsigned W) {
    const float NEG = -__builtin_inff();
#pragma unroll
    for (int r = 0; r < 16; ++r) {
        const int c = (r & 3) + 8 * (r >> 2);
        if ((unsigned)(dq - c) >= W) p0[r] = NEG;
        if ((unsigned)(dq - c - 32) >= W) p1[r] = NEG;
    }
}
__device__ __forceinline__ void partialSM(f32x16& p0, f32x16& p1, float& m_reg, float& mn, float& alpha) {
    float pmax = p0[0];
#pragma unroll
    for (int r = 1; r < 16; ++r) pmax = fmaxf(pmax, p0[r]);
#pragma unroll
    for (int r = 0; r < 16; ++r) pmax = fmaxf(pmax, p1[r]);
    { auto rr = __builtin_amdgcn_permlane32_swap(__float_as_uint(pmax), __float_as_uint(pmax), false, false);
      pmax = fmaxf(__uint_as_float(rr[0]), __uint_as_float(rr[1])); }
    constexpr float C2 = 1.4426950408889634f * SM_SCALE;
    if (__builtin_expect(__all((pmax - m_reg) * SM_SCALE <= THR), 1)) { mn = m_reg; alpha = 1.f; }
    else { mn = fmaxf(m_reg, pmax); alpha = __builtin_amdgcn_exp2f((m_reg - mn) * C2); m_reg = mn; }
    const float mnL = -mn * C2;
#pragma unroll
    for (int r = 0; r < 16; ++r) p0[r] = fmaf(p0[r], C2, mnL);
#pragma unroll
    for (int r = 0; r < 16; ++r) p1[r] = fmaf(p1[r], C2, mnL);
#pragma unroll
    for (int r = 0; r < 16; ++r) p0[r] = __builtin_amdgcn_exp2f(p0[r]);
}
#define PK4(P, B_, OUT) do { unsigned a0 = cvtpk(P[B_+0], P[B_+1]), a1 = cvtpk(P[B_+2], P[B_+3]);                          \
        unsigned b0 = cvtpk(P[B_+4], P[B_+5]), b1 = cvtpk(P[B_+6], P[B_+7]);                                             \
        auto r0 = __builtin_amdgcn_permlane32_swap(a0, b0, false, false); auto r1 = __builtin_amdgcn_permlane32_swap(a1, b1, false, false); \
        u32x4 w = {r0[0], r1[0], r0[1], r1[1]}; OUT = *reinterpret_cast<bf16x8*>(&w); } while (0)
__device__ __forceinline__ void finishSM(f32x16& p0, f32x16& p1, float alpha, float& l_reg, bf16x8& pa0, bf16x8& pa1, bf16x8& pa2, bf16x8& pa3) {
#pragma unroll
    for (int r = 0; r < 16; ++r) p1[r] = __builtin_amdgcn_exp2f(p1[r]);
    float ps = 0;
#pragma unroll
    for (int r = 0; r < 16; ++r) ps += p0[r];
#pragma unroll
    for (int r = 0; r < 16; ++r) ps += p1[r];
    { auto rr = __builtin_amdgcn_permlane32_swap(__float_as_uint(ps), __float_as_uint(ps), false, false);
      ps = __uint_as_float(rr[0]) + __uint_as_float(rr[1]); }
    l_reg = l_reg * alpha + ps;
    PK4(p0, 0, pa0); PK4(p0, 8, pa1); PK4(p1, 0, pa2); PK4(p1, 8, pa3);
}
template <int KB, bool SK>
__device__ __forceinline__ void qkt(f32x16& p0, f32x16& p1, const char* K_lds, int r32, int hi, const bf16x8* qr, bool act) {
    if (SK && !act) return;
    p0 = f32x16{}; p1 = f32x16{};
    const char* kb[4];
#pragma unroll
    for (int dd = 0; dd < 4; ++dd) kb[dd] = K_lds + KB * SHM_K + KSWZ(r32, (dd * 16 + hi * 8) * 2);
#pragma unroll
    for (int d0 = 0; d0 < 8; ++d0) { const char* a = kb[d0 & 3] + (d0 >> 2) * 128;
        bf16x8 b0 = *reinterpret_cast<const bf16x8*>(a);
        bf16x8 b1 = *reinterpret_cast<const bf16x8*>(a + 32 * 256);
        p0 = __builtin_amdgcn_mfma_f32_32x32x16_bf16(b0, qr[d0], p0, 0, 0, 0);
        p1 = __builtin_amdgcn_mfma_f32_32x32x16_bf16(b1, qr[d0], p1, 0, 0, 0); }
}
template <int VB, bool SK>
__device__ __forceinline__ void pv_tile(f32x16* o, int vb0, bf16x8 pa0, bf16x8 pa1, bf16x8 pa2, bf16x8 pa3, bool act) {
    if (SK && !act) return;
#define TRRD(dst, off) asm volatile("ds_read_b64_tr_b16 %0, %1 offset:%2" : "=&v"(dst) : "v"(vb0), "i"(off) : "memory")
#define PV_D0(d0) do { s16x4 l0, l1, l2, l3, h0, h1, h2, h3; constexpr int b_ = VB * SHM_V + v_rd_off(d0, 0, 0); \
        TRRD(l0, b_); TRRD(h0, b_ + 2048); TRRD(l1, b_ + 4096); TRRD(h1, b_ + 6144); TRRD(l2, b_ + 8192); TRRD(h2, b_ + 10240); TRRD(l3, b_ + 12288); TRRD(h3, b_ + 14336); \
        asm volatile("s_waitcnt lgkmcnt(0)" ::: "memory"); SBAR();   \
        o[d0] = __builtin_amdgcn_mfma_f32_32x32x16_bf16(pa0, (bf16x8){l0[0], l0[1], l0[2], l0[3], h0[0], h0[1], h0[2], h0[3]}, o[d0], 0, 0, 0);   \
        o[d0] = __builtin_amdgcn_mfma_f32_32x32x16_bf16(pa1, (bf16x8){l1[0], l1[1], l1[2], l1[3], h1[0], h1[1], h1[2], h1[3]}, o[d0], 0, 0, 0);   \
        o[d0] = __builtin_amdgcn_mfma_f32_32x32x16_bf16(pa2, (bf16x8){l2[0], l2[1], l2[2], l2[3], h2[0], h2[1], h2[2], h2[3]}, o[d0], 0, 0, 0);   \
        o[d0] = __builtin_amdgcn_mfma_f32_32x32x16_bf16(pa3, (bf16x8){l3[0], l3[1], l3[2], l3[3], h3[0], h3[1], h3[2], h3[3]}, o[d0], 0, 0, 0); } while (0)
    PV_D0(0); PV_D0(1); PV_D0(2); PV_D0(3);
#undef PV_D0
#undef TRRD
}

__device__ __forceinline__ void pv_tile2(f32x16* o, f32x16* o2, int vb0, bf16x8 pa0, bf16x8 pa1, bf16x8 pa2, bf16x8 pa3) {
#define TRRD(dst, off) asm volatile("ds_read_b64_tr_b16 %0, %1 offset:%2" : "=&v"(dst) : "v"(vb0), "i"(off) : "memory")
#define PV2_D0(d0) do { s16x4 l0, l1, l2, l3, h0, h1, h2, h3, L0, L1, L2, L3, H0, H1, H2, H3; constexpr int b_ = v_rd_off(d0, 0, 0), c_ = SHM_V + v_rd_off(d0, 0, 0); \
        TRRD(l0, b_); TRRD(h0, b_ + 2048); TRRD(L0, c_); TRRD(H0, c_ + 2048); TRRD(l1, b_ + 4096); TRRD(h1, b_ + 6144); TRRD(L1, c_ + 4096); TRRD(H1, c_ + 6144); \
        TRRD(l2, b_ + 8192); TRRD(h2, b_ + 10240); TRRD(L2, c_ + 8192); TRRD(H2, c_ + 10240); TRRD(l3, b_ + 12288); TRRD(h3, b_ + 14336); TRRD(L3, c_ + 12288); TRRD(H3, c_ + 14336); \
        asm volatile("s_waitcnt lgkmcnt(0)" ::: "memory"); SBAR();   \
        o[d0]  = __builtin_amdgcn_mfma_f32_32x32x16_bf16(pa0, (bf16x8){l0[0], l0[1], l0[2], l0[3], h0[0], h0[1], h0[2], h0[3]}, o[d0], 0, 0, 0);   \
        o2[d0] = __builtin_amdgcn_mfma_f32_32x32x16_bf16(pa0, (bf16x8){L0[0], L0[1], L0[2], L0[3], H0[0], H0[1], H0[2], H0[3]}, o2[d0], 0, 0, 0);  \
        o[d0]  = __builtin_amdgcn_mfma_f32_32x32x16_bf16(pa1, (bf16x8){l1[0], l1[1], l1[2], l1[3], h1[0], h1[1], h1[2], h1[3]}, o[d0], 0, 0, 0);   \
        o2[d0] = __builtin_amdgcn_mfma_f32_32x32x16_bf16(pa1, (bf16x8){L1[0], L1[1], L1[2], L1[3], H1[0], H1[1], H1[2], H1[3]}, o2[d0], 0, 0, 0);  \
        o[d0]  = __builtin_amdgcn_mfma_f32_32x32x16_bf16(pa2, (bf16x8){l2[0], l2[1], l2[2], l2[3], h2[0], h2[1], h2[2], h2[3]}, o[d0], 0, 0, 0);   \
        o2[d0] = __builtin_amdgcn_mfma_f32_32x32x16_bf16(pa2, (bf16x8){L2[0], L2[1], L2[2], L2[3], H2[0], H2[1], H2[2], H2[3]}, o2[d0], 0, 0, 0);  \
        o[d0]  = __builtin_amdgcn_mfma_f32_32x32x16_bf16(pa3, (bf16x8){l3[0], l3[1], l3[2], l3[3], h3[0], h3[1], h3[2], h3[3]}, o[d0], 0, 0, 0);   \
        o2[d0] = __builtin_amdgcn_mfma_f32_32x32x16_bf16(pa3, (bf16x8){L3[0], L3[1], L3[2], L3[3], H3[0], H3[1], H3[2], H3[3]}, o2[d0], 0, 0, 0); } while (0)
    PV2_D0(0); PV2_D0(1); PV2_D0(2); PV2_D0(3);
#undef PV2_D0
#undef TRRD
}

struct BlockRef { const bf16_t* Q; const bf16_t* K; const bf16_t* V; bf16_t* O; int P0; const float* tb; const unsigned* sel; const bf16_t* V2; bf16_t* O2; };
struct Seam { bf16x8 qr[8]; bf16x8 st_v0, st_v1, st_k0, st_k1; };
__device__ __forceinline__ int swa_jlo(int P0, int W) { const int lowk = P0 - W + 1; return lowk > 0 ? lowk / KVBLK : 0; }
#define ROW(p, k0, rr) ((const bf16_t*)((const char*)((p) + (size_t)((k0) + ((rr) - sr)) * D) + loff))
#define VMW() asm volatile("s_waitcnt vmcnt(0)" ::: "memory")
#define VMWN(n) asm volatile("s_waitcnt vmcnt(%0)" :: "i"(n) : "memory")
#define SLOAD_H(Kp, Vp, k0) do { S.st_v0 = load8(ROW(Vp, k0, sr)); S.st_v1 = load8(ROW(Vp, k0, 32 + sr));              \
                         S.st_k0 = load8(ROW(Kp, k0, sr)); S.st_k1 = load8(ROW(Kp, k0, 32 + sr)); } while (0)
#define SWRITE_HK(bf) do { *(bf16x8*)(K_lds + (bf) * SHM_K + kws) = S.st_k0; *(bf16x8*)(K_lds + (bf) * SHM_K + kws + 32 * 256) = S.st_k1; } while (0)
#define SWRITE_HV(bf) do { *(bf16x8*)(V_lds + (bf) * SHM_V + vst0) = S.st_v0; *(bf16x8*)(V_lds + (bf) * SHM_V + vst1) = S.st_v1; } while (0)
#define SWRITE_H(bf) do { SWRITE_HV(bf); SWRITE_HK(bf); } while (0)
template <int MODE> __device__ __forceinline__ int mode_w() { return MODE == 1 ? 512 : (1 << 30); }
template <int MODE> __device__ __forceinline__ size_t qrow_off(int wid, int r) { return MODE == 2 ? ((size_t)(r >> 3) * SEQ + wid * 8 + (r & 7)) * D : (size_t)(wid * QBLK + r) * D; }
__device__ __forceinline__ void sel_stage(const BlockRef& b, char* lds, int par, int wid) {
    const int tid = wid * 64 + lane_id();
    if (tid < 128) { const u32x4 w = *(const u32x4*)(b.sel + (size_t)(b.P0 + (tid >> 1)) * 8 + (tid & 1) * 4);
        *(u32x4*)(lds + LDS_SEL + par * 2048 + (tid >> 1) * 32 + (tid & 1) * 16) = w; }
}
template <int MODE>
__device__ __forceinline__ void attn_prime(const BlockRef& cur, char* lds, Seam& S, int par, const int wid) {
    const int W = mode_w<MODE>();
    const int lane = lane_id(), tid = wid * 64 + lane, r32 = lane & 31, hi = lane >> 5;
    const int sr = tid >> 4, sc = (tid & 15) * 8, kws = KSWZ(sr, sc * 2); char* K_lds = lds + 2 * SHM_V;
    const unsigned loff = (unsigned)(sr * D + sc) * 2u;
    const int kb0 = swa_jlo(cur.P0, W) * KVBLK;
#pragma unroll
    for (int d0 = 0; d0 < 8; ++d0) S.qr[d0] = load8(cur.Q + qrow_off<MODE>(wid, r32) + d0 * 16 + hi * 8);
    if (MODE == 2) sel_stage(cur, lds, par, wid);
    SLOAD_H(cur.K, cur.V, kb0); VMW(); SWRITE_HK(0);
    __syncthreads();
}
template <int MODE>
__device__ __forceinline__ void attn_block(const BlockRef& cur, const BlockRef& nxt, char* lds, Seam& S, int par, const int wid) {
    constexpr bool SK = MODE == 2;
    const int W = mode_w<MODE>();
    const int lane = lane_id(), tid = wid * 64 + lane, r32 = lane & 31, hi = lane >> 5;
    const int j_lo = swa_jlo(cur.P0, W);
    constexpr int WROWS = MODE == 2 ? 8 : QBLK, BROWS = MODE == 2 ? 64 : QB;
    const int j_hi = (cur.P0 + BROWS - 1) / KVBLK + 1;
    const int NT = j_hi - j_lo;
    const int kbn = swa_jlo(nxt.P0, W) * KVBLK;
    const int qlo = cur.P0 + wid * WROWS, qm = qlo + (MODE == 2 ? (r32 & 7) : r32) - 4 * hi;
    char* V_lds = lds; char* K_lds = lds + 2 * SHM_V;
    float* ws = (float*)(lds + 2 * SHM_V + 2 * SHM_K) + wid * 64; float* li_l = ws, * al_l = ws + 32;
    const float* tb = cur.tb + (MODE == 2 ? (r32 >> 3) * TBXN : 0);
    const unsigned* selrow = (const unsigned*)(lds + LDS_SEL + par * 2048) + (wid * 8 + (r32 & 7)) * 8;
    unsigned selw = 0u;
    float m_reg = -1e30f, l_reg = 0; f32x16 o[4] = {};
    const int sr = tid >> 4, sc = (tid & 15) * 8, vst0 = v_st(sr, sc), vst1 = v_st(32 + sr, sc), kws = KSWZ(sr, sc * 2);
    const unsigned loff = (unsigned)(sr * D + sc) * 2u;
    const int vb0 = (int)(uintptr_t)V_lds + v_rd_base(lane);
    const bf16_t* Kh = cur.K; const bf16_t* Vh = cur.V;
#define RESC(a) do { if (__any((a) < 1.f)) { if (hi == 0) al_l[r32] = (a); asm volatile("s_waitcnt lgkmcnt(0)" ::: "memory");              \
                     for (int d_ = 0; d_ < 4; ++d_) for (int r = 0; r < 16; ++r) o[d_][r] *= al_l[crow(r, hi)]; } } while (0)
#define KBASE(t) ((j_lo + (t)) * KVBLK)
#define GEOACT(t) (KBASE(t) <= qlo + WROWS - 1 && KBASE(t) + KVBLK - 1 >= qlo - W + 1)
#define SETACT(actX, bitX, t) do { if (MODE == 2) { const int j_ = j_lo + (t); if ((j_ & 31) == 0 || (t) == 0) selw = selrow[j_ >> 5]; \
                                   actX = GEOACT(t) && __any(((selw >> (j_ & 31)) & 1u) != 0u); } else { actX = GEOACT(t); } } while (0)
#define MASKT(P0_, P1_, actX, bitX, t) do { const int kb_ = KBASE(t); if (!SK || actX) {                                             \
        if (kb_ + KVBLK - 1 + BAND > qlo) bias_mask_tile(P0_, P1_, qm - kb_, (unsigned)W, tb);                                        \
        else if (MODE == 1 && kb_ <= qlo + WROWS - 1 - W) mask_tile(P0_, P1_, qm - kb_, (unsigned)W);                                  \
        if (MODE == 2) { if (((selw >> ((j_lo + (t)) & 31)) & 1u) == 0u) { const float NEG_ = -__builtin_inff(); _Pragma("unroll") for (int r_ = 0; r_ < 16; ++r_) { P0_[r_] = NEG_; P1_[r_] = NEG_; } } } } } while (0)
    constexpr int NQL = 8;
#define SEAM_K0() do { VMWN(NQL); SWRITE_HK(0); SBAR(); } while (0)
    f32x16 pA0, pA1, pB0, pB1; float mnA, mnB, alA, alB; bf16x8 pa0, pa1, pa2, pa3;
    bool actA = true, actB = true; unsigned bitA = 1u, bitB = 1u;
    SWRITE_HV(0); SBAR();
    if (NT > 1) { SLOAD_H(Kh, Vh, KBASE(1)); }
    SETACT(actA, bitA, 0);
    SBAR(); qkt<0, SK>(pA0, pA1, K_lds, r32, hi, S.qr, actA);
    if (!SK || actA) { MASKT(pA0, pA1, actA, bitA, 0); partialSM(pA0, pA1, m_reg, mnA, alA); } else alA = 1.f;
    if (NT > 1) { VMW(); SWRITE_H(1); }
    __syncthreads();
#define HALF_STEP(PX0, PX1, mnX, alX, actX, bitX, PY0, PY1, alY, actY, t, KB, VB, SB) do {                                    \
        SETACT(actX, bitX, t);                                                                                                \
        SBAR(); qkt<KB, SK>(PX0, PX1, K_lds, r32, hi, S.qr, actX);                                                            \
        if (!SK || actY) finishSM(PY0, PY1, alY, l_reg, pa0, pa1, pa2, pa3); SBAR();                                          \
        if ((t) + 1 < NT) { SLOAD_H(Kh, Vh, KBASE((t) + 1)); SBAR(); }                                                        \
        pv_tile<VB, SK>(o, vb0, pa0, pa1, pa2, pa3, actY);                                                                    \
        if (!SK || actX) { MASKT(PX0, PX1, actX, bitX, (t)); partialSM(PX0, PX1, m_reg, mnX, alX); } else alX = 1.f;          \
        __syncthreads();                                                                                                      \
        if ((t) + 1 < NT) { VMW(); SWRITE_H(SB); }                                                                            \
        RESC(alX); __syncthreads(); } while (0)
    for (int t = 1; t + 1 < NT; t += 2) {
        HALF_STEP(pB0, pB1, mnB, alB, actB, bitB, pA0, pA1, alA, actA, t, 1, 0, 0);
        HALF_STEP(pA0, pA1, mnA, alA, actA, bitA, pB0, pB1, alB, actB, t + 1, 0, 1, 1);
    }
    const bool even = (NT & 1) == 0;
    if (even) { SETACT(actB, bitB, NT - 1); SBAR(); qkt<1, SK>(pB0, pB1, K_lds, r32, hi, S.qr, actB); SBAR(); }
    SLOAD_H(nxt.K, nxt.V, kbn); SBAR();
#pragma unroll
    for (int d0 = 0; d0 < 8; ++d0) S.qr[d0] = load8(nxt.Q + qrow_off<MODE>(wid, r32) + d0 * 16 + hi * 8);
    SBAR();
    if (!SK || actA) finishSM(pA0, pA1, alA, l_reg, pa0, pa1, pa2, pa3); SBAR();
    pv_tile<0, SK>(o, vb0, pa0, pa1, pa2, pa3, actA);
    if (even) { if (!SK || actB) { MASKT(pB0, pB1, actB, bitB, NT - 1); partialSM(pB0, pB1, m_reg, mnB, alB); } else alB = 1.f; __syncthreads(); RESC(alB);
        if (!SK || actB) finishSM(pB0, pB1, alB, l_reg, pa0, pa1, pa2, pa3); SBAR(); pv_tile<1, SK>(o, vb0, pa0, pa1, pa2, pa3, actB); }
    SBAR(); SEAM_K0();
    if (hi == 0) li_l[r32] = l_reg; asm volatile("s_waitcnt lgkmcnt(0)" ::: "memory");
    float rli[16];
#pragma unroll
    for (int r = 0; r < 16; ++r) rli[r] = __builtin_amdgcn_rcpf(li_l[crow(r, hi)]);
#pragma unroll
    for (int r = 0; r < 16; ++r) { const int orow = crow(r, hi); bf16_t* Ow = cur.O + qrow_off<MODE>(wid, orow) - (size_t)orow * D;
#pragma unroll
        for (int d0 = 0; d0 < 4; ++d0) { const float v = o[d0][r] * rli[r];
            const float vn = xor1_(v);
            if ((r32 & 1) == 0) *(unsigned*)(Ow + (size_t)orow * D + d0 * 32 + r32) = cvtpk(v, vn); } }
    if (MODE == 2) sel_stage(nxt, lds, par ^ 1, wid);
    __syncthreads();
#undef RESC
#undef KBASE
#undef GEOACT
#undef SETACT
#undef MASKT
#undef SEAM_K0
#undef HALF_STEP
}
}


namespace att {
constexpr int A2_V = 0, A2_K = 3 * SHM_V, A2_WS = A2_K + 2 * SHM_K;
constexpr int A2_TBX = A2_WS + NW * 64 * 4;
constexpr int A2D_TBX = 3 * 2 * SHM_V + 2 * SHM_K + NW * 64 * 4;
constexpr int A2_SEL = A2_TBX + 12 * TBXN * 4;
__device__ __forceinline__ int swap23(int k) { return (k & ~0xC) | ((k & 4) << 1) | ((k & 8) >> 1); }
template <int MODE, bool DV2>
__device__ __forceinline__ void attn_block2(const BlockRef& cur, char* lds, const int wid) {
    constexpr int VST = DV2 ? 2 * SHM_V : SHM_V;
    constexpr int A2K = 3 * VST, A2WS = A2K + 2 * SHM_K, A2SEL = A2WS + NW * 64 * 4 + 12 * TBXN * 4;
    constexpr bool SK = MODE == 2;
    const int W = mode_w<MODE>();
    const int lane = lane_id(), tid = wid * 64 + lane, r32 = lane & 31, hi = lane >> 5;
    constexpr int WROWS = MODE == 2 ? 8 : QBLK, BROWS = MODE == 2 ? 64 : QB;
    const int j_lo = swa_jlo(cur.P0, W);
    const int j_hi = (cur.P0 + BROWS - 1) / KVBLK + 1;
    const int NT = j_hi - j_lo;
    const int qlo = cur.P0 + wid * WROWS, qm = qlo + (MODE == 2 ? (r32 & 7) : r32) - 4 * hi;
    char* V_lds = lds + A2_V; char* K_lds = lds + A2K;
    float* ws = (float*)(lds + A2WS) + wid * 64; float* li_l = ws, * al_l = ws + 32;
    const float* tb = cur.tb + (MODE == 2 ? (r32 >> 3) * TBXN : 0);
    const unsigned* selrow = (const unsigned*)(lds + A2SEL) + (wid * 8 + (r32 & 7)) * 8;
    unsigned selw = 0u;
    unsigned kgo[2], vgo[2];
#pragma unroll
    for (int i = 0; i < 2; ++i) { const int pc = 2 * wid + i;
        const int row = 4 * pc + (lane >> 4), c = (lane & 15) ^ (row & 7); kgo[i] = (unsigned)(row * 256 + c * 16);
        const int sub = 2 * pc + (lane >> 5), kk = (sub >> 2) * 8 + ((lane & 31) >> 2), k = swap23(kk), cc = (sub & 3) * 32 + (lane & 3) * 8; vgo[i] = (unsigned)(k * 256 + cc * 2); }
    bf16x8 qr[8];
#pragma unroll
    for (int d0 = 0; d0 < 8; ++d0) qr[d0] = load8(cur.Q + qrow_off<MODE>(wid, r32) + d0 * 16 + hi * 8);
    if (MODE == 2) { if (tid < 128) { const u32x4 w = *(const u32x4*)(cur.sel + (size_t)(cur.P0 + (tid >> 1)) * 8 + (tid & 1) * 4);
        *(u32x4*)(lds + A2SEL + (tid >> 1) * 32 + (tid & 1) * 16) = w; } }
    LAS unsigned char* ldsl = (LAS unsigned char*)lds;
    const char* Kg = (const char*)cur.K; const char* Vg = (const char*)cur.V; const char* Vg2 = (const char*)cur.V2;
#define A2_DMA(t_) do { const int t__ = (t_); const size_t go_ = (size_t)(j_lo + t__) * (KVBLK * D * 2);                                           \
        LAS unsigned char* kd_ = ldsl + A2K + (t__ & 1) * SHM_K + wid * 2048; LAS unsigned char* vd_ = ldsl + A2_V + (t__ % 3) * VST + wid * 2048;      \
        _Pragma("unroll") for (int i_ = 0; i_ < 2; ++i_) {                                                                                         \
            __builtin_amdgcn_global_load_lds((const unsigned*)(Kg + go_ + kgo[i_]), (LAS unsigned*)(kd_ + i_ * 1024), 16, 0, 0);                  \
            __builtin_amdgcn_global_load_lds((const unsigned*)(Vg + go_ + vgo[i_]), (LAS unsigned*)(vd_ + i_ * 1024), 16, 0, 0);                  \
            if (DV2) __builtin_amdgcn_global_load_lds((const unsigned*)(Vg2 + go_ + vgo[i_]), (LAS unsigned*)(vd_ + SHM_V + i_ * 1024), 16, 0, 0); } } while (0)
#define A2_BAR() do { asm volatile("s_waitcnt vmcnt(0) lgkmcnt(0)" ::: "memory"); __builtin_amdgcn_s_barrier(); asm volatile("" ::: "memory"); } while (0)
    A2_DMA(0);
    A2_BAR();
    float m_reg = -1e30f, l_reg = 0; f32x16 o[4] = {}; f32x16 o2[DV2 ? 4 : 1] = {};
    const int vbase = (int)(uintptr_t)V_lds + v_rd_base(lane);
#define RESC(a) do { if (__any((a) < 1.f)) { if (hi == 0) al_l[r32] = (a); asm volatile("s_waitcnt lgkmcnt(0)" ::: "memory");              \
                     for (int d_ = 0; d_ < 4; ++d_) for (int r = 0; r < 16; ++r) { const float f_ = al_l[crow(r, hi)]; o[d_][r] *= f_; if (DV2) o2[d_][r] *= f_; } } } while (0)
#define KBASE(t) ((j_lo + (t)) * KVBLK)
#define GEOACT(t) (KBASE(t) <= qlo + WROWS - 1 && KBASE(t) + KVBLK - 1 >= qlo - W + 1)
#define SETACT(actX, t) do { if (MODE == 2) { const int j_ = j_lo + (t); if ((j_ & 31) == 0 || (t) == 0) selw = selrow[j_ >> 5]; \
                                   actX = GEOACT(t) && __any(((selw >> (j_ & 31)) & 1u) != 0u); } else { actX = GEOACT(t); } } while (0)
#define MASKT(P0_, P1_, t) do { const int kb_ = KBASE(t);                                                                             \
        if (kb_ + KVBLK - 1 + BAND > qlo) bias_mask_tile(P0_, P1_, qm - kb_, (unsigned)W, tb);                                        \
        else if (MODE == 1 && kb_ <= qlo + WROWS - 1 - W) mask_tile(P0_, P1_, qm - kb_, (unsigned)W);                                  \
        if (MODE == 2) { if (((selw >> ((j_lo + (t)) & 31)) & 1u) == 0u) { const float NEG_ = -__builtin_inff(); _Pragma("unroll") for (int r_ = 0; r_ < 16; ++r_) { P0_[r_] = NEG_; P1_[r_] = NEG_; } } } } while (0)
    f32x16 pA0, pA1, pB0, pB1; float mnA, mnB, alA = 1.f, alB = 1.f; bf16x8 pa0, pa1, pa2, pa3;
    bool actA = true, actB = true;
    if (NT > 1) A2_DMA(1);
    SETACT(actA, 0);
    SBAR(); qkt<0, SK>(pA0, pA1, K_lds, r32, hi, qr, actA);
    if (!SK || actA) { MASKT(pA0, pA1, 0); partialSM(pA0, pA1, m_reg, mnA, alA); } else alA = 1.f;
    A2_BAR();
#define STEP2(PX0, PX1, mnX, alX, actX, PY0, PY1, alY, actY, t) do {                                                          \
        if ((t) + 1 < NT) A2_DMA((t) + 1);                                                                                    \
        SETACT(actX, t);                                                                                                      \
        SBAR(); qkt<0, SK>(PX0, PX1, K_lds + ((t) & 1) * SHM_K, r32, hi, qr, actX);                                           \
        if (!SK || actY) finishSM(PY0, PY1, alY, l_reg, pa0, pa1, pa2, pa3); SBAR();                                          \
        pv_tile<0, SK>(o, vbase + (((t) - 1) % 3) * VST, pa0, pa1, pa2, pa3, actY);                                           \
        if (DV2) pv_tile<0, SK>(o2, vbase + (((t) - 1) % 3) * VST + SHM_V, pa0, pa1, pa2, pa3, actY);                         \
        if (!SK || actX) { MASKT(PX0, PX1, (t)); partialSM(PX0, PX1, m_reg, mnX, alX); } else alX = 1.f;                      \
        RESC(alX);                                                                                                            \
        A2_BAR(); } while (0)
    int t = 1;
    for (; t + 1 < NT; t += 2) {
        STEP2(pB0, pB1, mnB, alB, actB, pA0, pA1, alA, actA, t);
        STEP2(pA0, pA1, mnA, alA, actA, pB0, pB1, alB, actB, t + 1);
    }
    if (t < NT) {
        STEP2(pB0, pB1, mnB, alB, actB, pA0, pA1, alA, actA, t);
        if (!SK || actB) finishSM(pB0, pB1, alB, l_reg, pa0, pa1, pa2, pa3); SBAR();
        pv_tile<0, SK>(o, vbase + ((NT - 1) % 3) * VST, pa0, pa1, pa2, pa3, actB);
        if (DV2) pv_tile<0, SK>(o2, vbase + ((NT - 1) % 3) * VST + SHM_V, pa0, pa1, pa2, pa3, actB);
    } else {
        if (!SK || actA) finishSM(pA0, pA1, alA, l_reg, pa0, pa1, pa2, pa3); SBAR();
        pv_tile<0, SK>(o, vbase + ((NT - 1) % 3) * VST, pa0, pa1, pa2, pa3, actA);
        if (DV2) pv_tile<0, SK>(o2, vbase + ((NT - 1) % 3) * VST + SHM_V, pa0, pa1, pa2, pa3, actA);
    }
    if (hi == 0) li_l[r32] = l_reg; asm volatile("s_waitcnt lgkmcnt(0)" ::: "memory");
    float rli[16];
#pragma unroll
    for (int r = 0; r < 16; ++r) rli[r] = __builtin_amdgcn_rcpf(li_l[crow(r, hi)]);
#pragma unroll
    for (int r = 0; r < 16; ++r) { const int orow = crow(r, hi); bf16_t* Ow = cur.O + qrow_off<MODE>(wid, orow);
#pragma unroll
        for (int d0 = 0; d0 < 4; ++d0) { const float v = o[d0][r] * rli[r];
            const float vn = xor1_(v);
            if ((r32 & 1) == 0) *(unsigned*)(Ow + d0 * 32 + r32) = cvtpk(v, vn);
            if (DV2) { const float v2 = o2[d0][r] * rli[r]; const float vn2 = xor1_(v2);
                if ((r32 & 1) == 0) *(unsigned*)(cur.O2 + qrow_off<MODE>(wid, orow) + d0 * 32 + r32) = cvtpk(v2, vn2); } } }
    A2_BAR();
#undef A2_DMA
#undef A2_BAR
#undef RESC
#undef KBASE
#undef GEOACT
#undef SETACT
#undef MASKT
#undef STEP2
}
}


namespace att {
constexpr int A3_V = 0, A3_K = 2 * 2 * SHM_V, A3_WS = A3_K + 2 * SHM_K;
constexpr int A3_TBX = A3_WS + NW * 64 * 4;
__device__ __forceinline__ void attn_block3(const BlockRef& cur, char* lds, const int wid) {
    const int lane = lane_id(), r32 = lane & 31, hi = lane >> 5;
    const int NT = (cur.P0 + QB - 1) / KVBLK + 1;
    const int qlo = cur.P0 + wid * QBLK, qm = qlo + r32 - 4 * hi;
    char* V_lds = lds + A3_V; char* K_lds = lds + A3_K;
    float* ws = (float*)(lds + A3_WS) + wid * 64; float* li_l = ws, * al_l = ws + 32;
    const float* tb = cur.tb;
    unsigned kgo[2], vgo[2];
#pragma unroll
    for (int i = 0; i < 2; ++i) { const int pc = 2 * wid + i;
        const int row = 4 * pc + (lane >> 4), c = (lane & 15) ^ (row & 7); kgo[i] = (unsigned)(row * 256 + c * 16);
        const int sub = 2 * pc + (lane >> 5), kk = (sub >> 2) * 8 + ((lane & 31) >> 2), k = swap23(kk), cc = (sub & 3) * 32 + (lane & 3) * 8; vgo[i] = (unsigned)(k * 256 + cc * 2); }
    bf16x8 qr[8];
#pragma unroll
    for (int d0 = 0; d0 < 8; ++d0) qr[d0] = load8(cur.Q + (size_t)(wid * QBLK + r32) * D + d0 * 16 + hi * 8);
    LAS unsigned char* ldsl = (LAS unsigned char*)lds;
    const char* Kg = (const char*)cur.K; const char* Vg = (const char*)cur.V; const char* Vg2 = (const char*)cur.V2;
#define A3_DMA(t_) do { const int t__ = (t_); const size_t go_ = (size_t)t__ * (KVBLK * D * 2);                                                   \
        LAS unsigned char* kd_ = ldsl + A3_K + (t__ & 1) * SHM_K + wid * 2048; LAS unsigned char* vd_ = ldsl + A3_V + (t__ & 1) * 2 * SHM_V + wid * 2048; \
        _Pragma("unroll") for (int i_ = 0; i_ < 2; ++i_) {                                                                                         \
            __builtin_amdgcn_global_load_lds((const unsigned*)(Kg + go_ + kgo[i_]), (LAS unsigned*)(kd_ + i_ * 1024), 16, 0, 0);                  \
            __builtin_amdgcn_global_load_lds((const unsigned*)(Vg + go_ + vgo[i_]), (LAS unsigned*)(vd_ + i_ * 1024), 16, 0, 0);                  \
            __builtin_amdgcn_global_load_lds((const unsigned*)(Vg2 + go_ + vgo[i_]), (LAS unsigned*)(vd_ + SHM_V + i_ * 1024), 16, 0, 0); } } while (0)
#define A3_BAR() do { asm volatile("s_waitcnt vmcnt(0) lgkmcnt(0)" ::: "memory"); __builtin_amdgcn_s_barrier(); asm volatile("" ::: "memory"); } while (0)
    A3_DMA(0);
    A3_BAR();
    float m_reg = -1e30f, l_reg = 0; f32x16 o[4] = {}, o2[4] = {};
    const int vbase = (int)(uintptr_t)V_lds + v_rd_base(lane);
    for (int t = 0; t < NT; ++t) {
        f32x16 p0, p1; float mn, alpha; bf16x8 pa0, pa1, pa2, pa3;
        const int kb = t * KVBLK;
        qkt<0, false>(p0, p1, K_lds + (t & 1) * SHM_K, r32, hi, qr, true);
        SBAR(); if (t + 1 < NT) A3_DMA(t + 1);
        SBAR();
        if (kb + KVBLK - 1 + BAND > qlo) bias_mask_tile(p0, p1, qm - kb, 1u << 30, tb);
        partialSM(p0, p1, m_reg, mn, alpha);
        if (__any(alpha < 1.f)) { if (hi == 0) al_l[r32] = alpha; asm volatile("s_waitcnt lgkmcnt(0)" ::: "memory");
#pragma unroll
            for (int d_ = 0; d_ < 4; ++d_)
#pragma unroll
                for (int r = 0; r < 16; ++r) { const float f_ = al_l[crow(r, hi)]; o[d_][r] *= f_; o2[d_][r] *= f_; } }
        finishSM(p0, p1, alpha, l_reg, pa0, pa1, pa2, pa3); SBAR();
        pv_tile2(o, o2, vbase + (t & 1) * 2 * SHM_V, pa0, pa1, pa2, pa3);
        A3_BAR();
    }
    if (hi == 0) li_l[r32] = l_reg; asm volatile("s_waitcnt lgkmcnt(0)" ::: "memory");
#pragma unroll
    for (int r = 0; r < 16; ++r) { const int orow = crow(r, hi); const float rli = __builtin_amdgcn_rcpf(li_l[orow]);
        const size_t ro = (size_t)(wid * QBLK + orow) * D;
#pragma unroll
        for (int d0 = 0; d0 < 4; ++d0) { const float v = o[d0][r] * rli, v2 = o2[d0][r] * rli; const float vn = xor1_(v), vn2 = xor1_(v2);
            if ((r32 & 1) == 0) { *(unsigned*)(cur.O + ro + d0 * 32 + r32) = cvtpk(v, vn); *(unsigned*)(cur.O2 + ro + d0 * 32 + r32) = cvtpk(v2, vn2); } } }
    A3_BAR();
#undef A3_DMA
#undef A3_BAR
}
}

namespace att {
__device__ __forceinline__ void cmp_bias_mask(f32x16& p0, f32x16& p1, int dq16, const float* tb) {
    const float NEG = -__builtin_inff();
#pragma unroll
    for (int r = 0; r < 16; ++r) {
        const int c = (r & 3) + 8 * (r >> 2);
        const int r0 = dq16 - 16 * c, r1 = dq16 - 16 * (c + 32);
        const float b0 = tb[(unsigned)r0 < 127u ? r0 : 127], b1 = tb[(unsigned)r1 < 127u ? r1 : 127];
        p0[r] = r0 < 0 ? NEG : p0[r] + b0;
        p1[r] = r1 < 0 ? NEG : p1[r] + b1;
    }
}
__device__ __forceinline__ void cmp_item(char* lds, unsigned char* wsb, float* d_oc_, int b, int g, int qb, const int wid) {
    constexpr float C2 = 1.4426950408889634f * SM_SCALE;
    const int lane = lane_id(), tid = wid * 64 + lane, r32 = lane & 31, hi = lane >> 5;
    const int t0 = qb * 64, head = r32 >> 3, ql = r32 & 7, h = g * 4 + head, t = t0 + wid * 8 + ql;
    const bf16_t* Q = (const bf16_t*)(wsb + WS_QN) + ((size_t)(b * 8 + h) * SEQ + t) * 128;
    const bf16_t* Kc = (const bf16_t*)(wsb + WS_KCMP) + (size_t)(b * 2 + g) * 1024 * 128;
    const bf16_t* Vc = (const bf16_t*)(wsb + WS_VCMP) + (size_t)(b * 2 + g) * 1024 * 128;
    char* V_lds = lds; char* K_lds = lds + 2 * SHM_V;
    float* pslc = (float*)(lds + LDS_PSLC);
    const float* tb = (const float*)(lds + LDS_TB) + h * 128;
    const int sr = tid >> 4, sc = (tid & 15) * 8, vst0 = v_st(sr, sc), vst1 = v_st(32 + sr, sc), kws = KSWZ(sr, sc * 2);
    const int vb0 = (int)(uintptr_t)V_lds + v_rd_base(lane);
    bf16x8 qr[8];
#pragma unroll
    for (int d0 = 0; d0 < 8; ++d0) qr[d0] = load8(Q + d0 * 16 + hi * 8);
    int nk = t0 / 16 + 3; if (nk > 1024) nk = 1024;
    const int NT = (nk + 63) >> 6;
    constexpr int PSS = 257;
    for (int i = tid; i < 64 * PSS; i += 512) pslc[i] = 0.f;
    float m = -1e30f, l = 0.f;
    bf16x8 k0 = load8(Kc + (size_t)sr * 128 + sc), k1 = load8(Kc + (size_t)(32 + sr) * 128 + sc), v0, v1;
#ifdef PROBE_CA
    for (int rp_ = 0; rp_ < 2; ++rp_) { m = -1e30f; l = 0.f;
#endif
    for (int j = 0; j < NT; ++j) {
        __syncthreads();
        *(bf16x8*)(K_lds + kws) = k0; *(bf16x8*)(K_lds + kws + 32 * 256) = k1;
        __syncthreads();
        { const int jn = j + 1 < NT ? j + 1 : 0;
          k0 = load8(Kc + (size_t)(64 * jn + sr) * 128 + sc); k1 = load8(Kc + (size_t)(64 * jn + 32 + sr) * 128 + sc); }
        f32x16 p0, p1;
        qkt<0, false>(p0, p1, K_lds, r32, hi, qr, true);
        if (1024 * j + 1152 > t0 + wid * 8) cmp_bias_mask(p0, p1, t - 31 - 16 * (64 * j + 4 * hi), tb);
        float pmax = p0[0];
#pragma unroll
        for (int r = 1; r < 16; ++r) pmax = fmaxf(pmax, p0[r]);
#pragma unroll
        for (int r = 0; r < 16; ++r) pmax = fmaxf(pmax, p1[r]);
        { auto rr = __builtin_amdgcn_permlane32_swap(__float_as_uint(pmax), __float_as_uint(pmax), false, false);
          pmax = fmaxf(__uint_as_float(rr[0]), __uint_as_float(rr[1])); }
        const float mn = fmaxf(m, pmax), mnL = -mn * C2;
        float ps = 0.f;
#pragma unroll
        for (int r = 0; r < 16; ++r) ps += __builtin_amdgcn_exp2f(fmaf(p0[r], C2, mnL)) + __builtin_amdgcn_exp2f(fmaf(p1[r], C2, mnL));
        { auto rr = __builtin_amdgcn_permlane32_swap(__float_as_uint(ps), __float_as_uint(ps), false, false);
          ps = __uint_as_float(rr[0]) + __uint_as_float(rr[1]); }
        l = l * __builtin_amdgcn_exp2f((m - mn) * C2) + ps; m = mn;
    }
#ifdef PROBE_CA
    }
#endif
    const float rl = l > 0.f ? 1.f / l : 0.f, mL = -m * C2;
    float pend = 0.f;
    f32x16 o[4] = {};
    v0 = load8(Vc + (size_t)sr * 128 + sc); v1 = load8(Vc + (size_t)(32 + sr) * 128 + sc);
#ifdef PROBE_CB
    for (int rp_ = 0; rp_ < 2; ++rp_) {
    if (rp_) { __syncthreads(); for (int i = tid; i < 64 * PSS; i += 512) pslc[i] = 0.f;
#pragma unroll
        for (int d_ = 0; d_ < 4; ++d_) o[d_] = f32x16{};
        k0 = load8(Kc + (size_t)sr * 128 + sc); k1 = load8(Kc + (size_t)(32 + sr) * 128 + sc); v0 = load8(Vc + (size_t)sr * 128 + sc); v1 = load8(Vc + (size_t)(32 + sr) * 128 + sc); }
#endif
    for (int j = 0; j < NT; ++j) {
        __syncthreads();
        *(bf16x8*)(K_lds + kws) = k0; *(bf16x8*)(K_lds + kws + 32 * 256) = k1;
        *(bf16x8*)(V_lds + vst0) = v0; *(bf16x8*)(V_lds + vst1) = v1;
        __syncthreads();
        if (j + 1 < NT) { k0 = load8(Kc + (size_t)(64 * (j + 1) + sr) * 128 + sc); k1 = load8(Kc + (size_t)(64 * (j + 1) + 32 + sr) * 128 + sc);
                          v0 = load8(Vc + (size_t)(64 * (j + 1) + sr) * 128 + sc); v1 = load8(Vc + (size_t)(64 * (j + 1) + 32 + sr) * 128 + sc); }
        f32x16 p0, p1;
        qkt<0, false>(p0, p1, K_lds, r32, hi, qr, true);
        if (1024 * j + 1152 > t0 + wid * 8) cmp_bias_mask(p0, p1, t - 31 - 16 * (64 * j + 4 * hi), tb);
#pragma unroll
        for (int r = 0; r < 16; ++r) { p0[r] = __builtin_amdgcn_exp2f(fmaf(p0[r], C2, mL)) * rl; p1[r] = __builtin_amdgcn_exp2f(fmaf(p1[r], C2, mL)) * rl; }
        float own[8], a1[8];
#pragma unroll
        for (int gi = 0; gi < 8; ++gi) {
            float a = gi < 4 ? p0[4 * gi] : p1[4 * (gi - 4)];
            float bs = gi < 4 ? (p0[4 * gi + 1] + p0[4 * gi + 2] + p0[4 * gi + 3]) : (p1[4 * (gi - 4) + 1] + p1[4 * (gi - 4) + 2] + p1[4 * (gi - 4) + 3]);
            float ow = a + 2.f * bs;
            ow += __int_as_float(__builtin_amdgcn_update_dpp(0, __float_as_int(ow), 0x128, 0xf, 0xf, false));
            a  += __int_as_float(__builtin_amdgcn_update_dpp(0, __float_as_int(a), 0x128, 0xf, 0xf, false));
            { auto rr = __builtin_amdgcn_permlane16_swap(__float_as_uint(ow), __float_as_uint(ow), false, false); ow = __uint_as_float(rr[0]) + __uint_as_float(rr[1]); }
            { auto rr = __builtin_amdgcn_permlane16_swap(__float_as_uint(a), __float_as_uint(a), false, false); a = __uint_as_float(rr[0]) + __uint_as_float(rr[1]); }
            own[gi] = ow; a1[gi] = a;
        }
        {
            float* prow = pslc + (wid * 8 + ql) * PSS + 16 * j + hi;
            float T[8];
#pragma unroll
            for (int gi = 0; gi < 8; ++gi) {
                auto rr = __builtin_amdgcn_permlane32_swap(__float_as_uint(a1[gi]), __float_as_uint(a1[gi < 7 ? gi + 1 : 7]), false, false);
                T[gi] = own[gi] + (hi == 0 ? __uint_as_float(rr[1]) : __uint_as_float(rr[0]));
            }
            { auto r0 = __builtin_amdgcn_permlane32_swap(0u, __float_as_uint(a1[0]), false, false);
              if (j > 0 && hi == 1 && head == 3) prow[-2] = pend + __uint_as_float(r0[0]); }
            const float t0_ = head == 0 ? T[0] : (head == 1 ? T[2] : (head == 2 ? T[4] : T[6]));
            const float t1_ = head == 0 ? T[1] : (head == 1 ? T[3] : (head == 2 ? T[5] : T[7]));
            const int g0 = 2 * head, bo0 = 2 * (g0 & 3) + 8 * (g0 >> 2);
            prow[bo0] = t0_;
            if (!(head == 3 && hi == 1)) prow[bo0 + 2] = t1_;
            pend = own[7];
        }
        bf16x8 pa0, pa1, pa2, pa3;
        PK4(p0, 0, pa0); PK4(p0, 8, pa1); PK4(p1, 0, pa2); PK4(p1, 8, pa3);
        pv_tile<0, false>(o, vb0, pa0, pa1, pa2, pa3, true);
    }
#ifdef PROBE_CB
    }
#endif
    if (hi == 1 && head == 3) pslc[(wid * 8 + ql) * PSS + 16 * (NT - 1) + 15] = pend;
    bf16_t* OC = (bf16_t*)d_oc_;
#pragma unroll
    for (int r = 0; r < 16; ++r) { const int orow = crow(r, hi), hr = orow >> 3, qr_ = orow & 7;
        bf16_t* dst = OC + ((size_t)(b * 8 + g * 4 + hr) * SEQ + t0 + wid * 8 + qr_) * 128;
#pragma unroll
        for (int d0 = 0; d0 < 4; ++d0) { const float v = o[d0][r]; const float vn = xor1_(v);
            if ((r32 & 1) == 0) *(unsigned*)(dst + d0 * 32 + r32) = cvtpk(v, vn); } }
    __syncthreads();
    unsigned* SELM = (unsigned*)(wsb + WS_SELM) + ((size_t)(b * 2 + g) * SEQ + t0) * 8;
    for (int qi = 0; qi < 8; ++qi) {
        const int q = wid * 8 + qi, jt = qb;
        unsigned key[4];
#pragma unroll
        for (int i4 = 0; i4 < 4; ++i4) { const int blk = lane + 64 * i4;
            const bool forced = (blk == 0) | (blk == jt) | (blk == jt - 1);
            const float v = forced ? 1e30f : (blk > jt ? -1e30f : pslc[q * PSS + blk]);
            key[i4] = v < 0.f ? 0u : __float_as_uint(v) + 1u; }
        unsigned prefix = 0u; int need = 16, matches = 256, sh = 0;
        for (int bit = 31; bit >= 0; --bit) {
            const unsigned cand = (prefix | (1u << bit)) >> bit;
            int c = 0;
#pragma unroll
            for (int i4 = 0; i4 < 4; ++i4) c += __popcll(__ballot((key[i4] >> bit) == cand));
            if (c >= need) { prefix |= 1u << bit; matches = c; } else { need -= c; matches -= c; }
            if (matches == need) { sh = bit; break; }
        }
        const unsigned pfx = prefix >> sh;
        unsigned long long selm[4]; int seen = 0;
#pragma unroll
        for (int i4 = 0; i4 < 4; ++i4) {
            const unsigned ks = key[i4] >> sh;
            const unsigned long long tie = __ballot(ks == pfx);
            const int rank = seen + __popcll(tie & ((1ull << lane) - 1ull));
            selm[i4] = __ballot(ks > pfx || (ks == pfx && rank < need));
            seen += __popcll(tie);
        }
        if (lane == 0) {
            u32x4 w0 = {(unsigned)selm[0], (unsigned)(selm[0] >> 32), (unsigned)selm[1], (unsigned)(selm[1] >> 32)};
            u32x4 w1 = {(unsigned)selm[2], (unsigned)(selm[2] >> 32), (unsigned)selm[3], (unsigned)(selm[3] >> 32)};
            *(u32x4*)(SELM + (size_t)q * 8) = w0; *(u32x4*)(SELM + (size_t)q * 8 + 4) = w1;
        }
    }
    __syncthreads();
}
}

constexpr int NPH = 15;
struct Args { const float* in[22]; float* out; unsigned char* ws; int ph_lo, ph_hi; };
enum { I_X = 0, I_NMG, I_WIN, I_PEK, I_PEV, I_W1K, I_W2K, I_W1V, I_W2V, I_LQ1, I_LK1, I_LQ2, I_LK2, I_HG, I_WUPN, I_WUPD, I_WOUT, I_NFG, I_WFFI, I_WFFO, I_TAB, I_NFIN };
constexpr size_t OC_OFF = 0, OS_OFF = (size_t)TOK * 1024 * 2, OW_OFF = 2 * OS_OFF;

template <int KIND> __device__ __forceinline__ int srcmap(int n) {
    if (KIND == 1) { return n < 2560 ? n : (n < 9728 ? n + 24 : (n < 9752 ? n - 9728 + 2560 : -1)); }
    if (KIND == 2) { const int tile = n >> 8, half = (n >> 7) & 1, j = n & 127; return half * DFF + tile * 128 + j; }
    if (KIND == 3) { return n < 128 ? n : -1; }
    return n;
}
template <int KIND>
__device__ __forceinline__ void transpose_item(const float* W, int K, int N, bf16_t* WT, int nblk, LAS float* scr, int item, int lane) {
    const int kb = item / nblk, nb = item % nblk, k0 = 64 * kb, n0 = 32 * nb;
    const int src = srcmap<KIND>(n0 + (lane & 31));
#pragma unroll 8
    for (int i = 0; i < 32; ++i) { const int kk = 2 * i + (lane >> 5); scr[kk * 33 + (lane & 31)] = src >= 0 ? W[(size_t)(k0 + kk) * N + src] : 0.f; }
    asm volatile("s_waitcnt lgkmcnt(0)" ::: "memory");
    const int c = lane & 7;
#pragma unroll
    for (int j = 0; j < 4; ++j) { const int n = (lane >> 3) + 8 * j; const LAS float* s = scr + (8 * c) * 33 + n;
        u32x4 o; o.x = cvtpk(s[0 * 33], s[1 * 33]); o.y = cvtpk(s[2 * 33], s[3 * 33]); o.z = cvtpk(s[4 * 33], s[5 * 33]); o.w = cvtpk(s[6 * 33], s[7 * 33]);
        *(u32x4*)(WT + (size_t)(n0 + n) * K + k0 + 8 * c) = o; }
    asm volatile("s_waitcnt lgkmcnt(0)" ::: "memory");
}
template <bool BF>
__device__ __forceinline__ void rms_row(const float* xrow, const float* g, void* orow, int lane) {
    const f32x4* xr = (const f32x4*)xrow + lane; const f32x4* gr = (const f32x4*)g + lane;
    f32x4 v[8]; float s = 0.f;
#pragma unroll
    for (int j = 0; j < 8; ++j) { v[j] = xr[64 * j]; s += (v[j].x * v[j].x + v[j].y * v[j].y) + (v[j].z * v[j].z + v[j].w * v[j].w); }
    const float rstd = rsqrtf(wave_sum(s) * (1.f / DM) + RMS_EPS);
#pragma unroll
    for (int j = 0; j < 8; ++j) { const f32x4 gg = gr[64 * j]; const f32x4 y = v[j] * rstd * gg;
        if (BF) { u32x2 w; w.x = cvtpk(y.x, y.y); w.y = cvtpk(y.z, y.w); ((u32x2*)orow)[64 * j + lane] = w; }
        else ((f32x4*)orow)[64 * j + lane] = y; }
}
__device__ __forceinline__ int t5_bucket(int n) {
    if (n < 16) return n;
    int l = 16 + (int)(logf((float)n / 16.f) / 2.0794415416798357f * 16.f);
    return l < 31 ? l : 31;
}
__device__ __forceinline__ void load_bias_tables(char* lds, const float* table, int tid0, int tbx_off = att::LDS_TBX) {
    float* tb = (float*)(lds + att::LDS_TB);
    for (int i = tid0; i < 12 * 128; i += 512) { const int h = i >> 7, rel = i & 127;
        tb[i] = (table[t5_bucket(rel) * 12 + h] - table[31 * 12 + h]) * (1.f / SM_SCALE); }
    float* tbx = (float*)(lds + tbx_off);
    for (int i = tid0; i < 12 * att::TBXN; i += 512) { const int h = i / att::TBXN, rel = i % att::TBXN - att::TBX0;
        tbx[i] = (rel >= 0 && rel < att::BAND) ? (table[t5_bucket(rel) * 12 + h] - table[31 * 12 + h]) * (1.f / SM_SCALE) : 0.f; }
    __syncthreads();
}

__global__ void __launch_bounds__(512, 2) mega_fwd(Args args) {
    extern __shared__ __attribute__((aligned(16))) unsigned char lds[];
    LAS unsigned char* ldsl = (LAS unsigned char*)lds;
    const int wave = __builtin_amdgcn_readfirstlane(threadIdx.x >> 6) & 7;
#define lane lane_id()
#define tid (wave * 64 + lane_id())
    const int G = gridDim.x, bx = blockIdx.x;
    const int gw = bx * 8 + wave, NGW = G * 8;
    unsigned char* ws = args.ws;
    const int lo = args.ph_lo, hi = args.ph_hi;
#ifndef PHASE_MASK
#define PHASE_MASK 0x7fff
#endif
#define IN(k) (lo <= (k) && (k) < hi && ((PHASE_MASK >> (k)) & 1))
#define SEAM(k) do { if (IN(k) && IN((k) + 1)) cg::this_grid().sync(); } while (0)
#ifndef DUP_MASK
#define DUP_MASK 0
#endif
#define REPS(k) for (int rep_ = 0; rep_ <= ((DUP_MASK >> (k)) & 1); ++rep_)
#define REPSYNC() do { if (rep_ == 0 && false) {} } while (0)
    const float* x = args.in[I_X];
    float* out = args.out;
    bf16_t* XN = (bf16_t*)(ws + WS_XN);

    REPS(0) if (IN(0)) {
        if (rep_) cg::this_grid().sync();
        LAS float* scr = (LAS float*)(ldsl + wave * 16384);
        constexpr int I0 = 32 * (NPROJ / 32), I1 = I0 + 32 * (2 * DFF / 32), I2 = I1 + (DFF / 64) * (DM / 32), I3 = I2 + 32 * (DM / 32), I4 = I3 + 16 * (DM / 32), I5 = I4 + 16 * (DM / 32),
                      I6 = I5 + 64 * 8, I7 = I6 + 64 * 8, I8 = I7 + 4 * 8, I9 = I8 + 4 * 8;
        for (int it = gw; it < I9; it += NGW) {
            if (it < I0)      transpose_item<1>(args.in[I_WIN], DM, NPROJ_SRC, (bf16_t*)(ws + WS_WIN), NPROJ / 32, scr, it, lane);
            else if (it < I1) transpose_item<2>(args.in[I_WFFI], DM, 2 * DFF, (bf16_t*)(ws + WS_WFFI), 2 * DFF / 32, scr, it - I0, lane);
            else if (it < I2) transpose_item<0>(args.in[I_WFFO], DFF, DM, (bf16_t*)(ws + WS_WFFO), DM / 32, scr, it - I1, lane);
            else if (it < I3) transpose_item<0>(args.in[I_WOUT], DM, DM, (bf16_t*)(ws + WS_WOUT), DM / 32, scr, it - I2, lane);
            else if (it < I4) transpose_item<0>(args.in[I_WUPN], 1024, DM, (bf16_t*)(ws + WS_WUPN), DM / 32, scr, it - I3, lane);
            else if (it < I5) transpose_item<0>(args.in[I_WUPD], 1024, DM, (bf16_t*)(ws + WS_WUPD), DM / 32, scr, it - I4, lane);
            else if (it < I6) transpose_item<0>(args.in[I_W1K], 4096, 256, (bf16_t*)(ws + WS_W1K), 8, scr, it - I5, lane);
            else if (it < I7) transpose_item<0>(args.in[I_W1V], 4096, 256, (bf16_t*)(ws + WS_W1V), 8, scr, it - I6, lane);
            else if (it < I8) transpose_item<3>(args.in[I_W2K], 256, 128, (bf16_t*)(ws + WS_W2K), 8, scr, it - I7, lane);
            else              transpose_item<3>(args.in[I_W2V], 256, 128, (bf16_t*)(ws + WS_W2V), 8, scr, it - I8, lane);
        }
        for (int m = gw; m < TOK; m += NGW) rms_row<true>(x + (size_t)m * DM, args.in[I_NMG], XN + (size_t)m * DM, lane);
        for (int o = gw; o < 512; o += NGW) {
            const int kv = o >> 8, n = o & 255; const float* pe = args.in[kv ? I_PEV : I_PEK]; const float* w1 = args.in[kv ? I_W1V : I_W1K];
            float s = 0.f; for (int k = lane; k < 4096; k += 64) s += pe[k] * w1[(size_t)k * 256 + n];
            s = wave_sum(s); if (lane == 0) ((float*)(ws + (kv ? WS_BV : WS_BK)))[n] = s;
        }
        if (bx == 0 && tid < 64) ((unsigned*)ws)[tid] = 0u;
        { const int gt = bx * 512 + tid;
          if (gt < 2048) { const int slab = gt >> 8, off = (gt & 255) * 8; bf16_t* p = (bf16_t*)(ws + (slab < 4 ? WS_KC : WS_VC)) + ((size_t)(slab & 3) * KCROWS + SEQ) * 128 + off;
              *(u32x4*)p = (u32x4){0u, 0u, 0u, 0u}; } }
    }
    SEAM(0);
#ifdef EXTRA_SYNCS
    for (int es = 0; es < EXTRA_SYNCS; ++es) cg::this_grid().sync();
#endif
    REPS(1) if (IN(1)) {
        if (rep_) cg::this_grid().sync();
        pg8::Gemm g{XN, (const bf16_t*)(ws + WS_WIN), TOK, NPROJ, DM, DM, TOK / 256, 0};
        pg8::QueueOrder S; S.init(TOK, NPROJ, bx & 7, (unsigned*)ws + 32);
        pg8::EpiProj E{ws};
        pg8::gemm_phase(ldsl, g, S, E, wave);
    }
    SEAM(1);
    REPS(2) if (IN(2) && !CMP_IN_P4) {
        if (rep_) cg::this_grid().sync();
        for (int kv = 0; kv < 2; ++kv) {
            pg8::Gemm g{(const bf16_t*)(ws + (kv ? WS_VC : WS_KC)), (const bf16_t*)(ws + (kv ? WS_W1V : WS_W1K)), 4096, 256, 4096, 2048, 4, (size_t)KCROWS * 128};
            pg8::StaticOrder S; S.init(4096, 256, G, (bx + 128 * kv) % G);
            pg8::EpiCmp1 E{(bf16_t*)(ws + (kv ? WS_HV : WS_HK)), (const float*)(ws + (kv ? WS_BV : WS_BK))};
            pg8::gemm_phase(ldsl, g, S, E, wave);
        }
    }
    if (!CMP_IN_P4) SEAM(2);
    REPS(3) if (IN(3) && !CMP_IN_P4) {
        if (rep_) cg::this_grid().sync();
        for (int kv = 0; kv < 2; ++kv) {
            pg8::Gemm g{(const bf16_t*)(ws + (kv ? WS_HV : WS_HK)), (const bf16_t*)(ws + (kv ? WS_W2V : WS_W2K)), 4096, 256, 256, 256, 16, 0};
            pg8::StaticOrder S; S.init(4096, 256, G, (bx + 128 * kv) % G);
            pg8::EpiCmp2 E{(bf16_t*)(ws + (kv ? WS_VCMP : WS_KCMP))};
            pg8::gemm_phase(ldsl, g, S, E, wave);
        }
    }
    if (!CMP_IN_P4) SEAM(3);
    REPS(4) if (IN(4)) {
        if (rep_) cg::this_grid().sync();
        if (CMP_IN_P4) {
            for (int u = bx; u < 32; u += G) {
                const int kv = u >> 4, pm = u & 15;
                {
                    const bf16_t* A = (const bf16_t*)(ws + (kv ? WS_VC : WS_KC)) + (size_t)(pm >> 2) * KCROWS * 128 + (size_t)(pm & 3) * 256 * 2048;
                    pg8::Gemm g{A, (const bf16_t*)(ws + (kv ? WS_W1V : WS_W1K)), 256, 256, 4096, 2048, 1, 0};
                    pg8::StaticOrder S; S.init(256, 256, 1, 0);
                    pg8::EpiCmp1 E{(bf16_t*)(ws + (kv ? WS_HV : WS_HK)) + (size_t)pm * 256 * 256, (const float*)(ws + (kv ? WS_BV : WS_BK))};
                    pg8::gemm_phase(ldsl, g, S, E, wave);
                }
                __builtin_amdgcn_fence(__ATOMIC_RELEASE, "agent"); asm volatile("s_waitcnt vmcnt(0)" ::: "memory"); __syncthreads(); __builtin_amdgcn_fence(__ATOMIC_ACQUIRE, "agent");
                {
                    pg8::Gemm g{(const bf16_t*)(ws + (kv ? WS_HV : WS_HK)) + (size_t)pm * 256 * 256, (const bf16_t*)(ws + (kv ? WS_W2V : WS_W2K)), 256, 256, 256, 256, 1, 0};
                    pg8::StaticOrder S; S.init(256, 256, 1, 0);
                    pg8::EpiCmp2 E{(bf16_t*)(ws + (kv ? WS_VCMP : WS_KCMP)) + (size_t)pm * 256 * 128};
                    pg8::gemm_phase(ldsl, g, S, E, wave);
                }
            }
            __syncthreads();
        }
        load_bias_tables((char*)lds, args.in[I_TAB], wave * 64 + lane_id(), att::A3_TBX);
        const bf16_t* QD = (const bf16_t*)(ws + WS_QD); const bf16_t* KD = (const bf16_t*)(ws + WS_KD); const bf16_t* VD = (const bf16_t*)(ws + WS_VD);
        bf16_t* O12 = (bf16_t*)(ws + WS_O12);
        const int total = 16 * 32 * 2;
        auto ref = [&](int idx) { const int L = idx >> 1, pass = idx & 1, vq = (G == 256) ? (L >> 8) * 8 + (L & 7) : (L >> 5), xx = (G == 256) ? ((L >> 3) & 31) : (L & 31), qb = pass ? 63 - xx : xx;
            const int bh = vq >> 1;
            att::BlockRef r; r.Q = QD + ((size_t)vq * SEQ + (size_t)qb * 256) * 128; r.K = KD + (size_t)vq * SEQ * 128;
            r.V = VD + (size_t)(bh * 2) * SEQ * 128; r.V2 = VD + (size_t)(bh * 2 + 1) * SEQ * 128;
            r.O = O12 + ((size_t)(vq * 2) * SEQ + (size_t)qb * 256) * 128; r.O2 = O12 + ((size_t)(vq * 2 + 1) * SEQ + (size_t)qb * 256) * 128; r.P0 = qb * 256;
            r.tb = (const float*)(lds + att::A3_TBX) + (8 + (bh & 3)) * att::TBXN + att::TBX0; r.sel = nullptr; return r; };
        (void)total;
        auto refq = [&](int vq, int qb) { const int bh = vq >> 1;
            att::BlockRef r; r.Q = QD + ((size_t)vq * SEQ + (size_t)qb * 256) * 128; r.K = KD + (size_t)vq * SEQ * 128;
            r.V = VD + (size_t)(bh * 2) * SEQ * 128; r.V2 = VD + (size_t)(bh * 2 + 1) * SEQ * 128;
            r.O = O12 + ((size_t)(vq * 2) * SEQ + (size_t)qb * 256) * 128; r.O2 = O12 + ((size_t)(vq * 2 + 1) * SEQ + (size_t)qb * 256) * 128; r.P0 = qb * 256;
            r.tb = (const float*)(lds + att::A3_TBX) + (8 + (bh & 3)) * att::TBXN + att::TBX0; r.sel = nullptr; return r; };
        unsigned* qctr = (unsigned*)ws; volatile unsigned* qw = (volatile unsigned*)(lds + LDS_BYTES - 16);
        for (int rnd = 0; rnd < 2; ++rnd) {
            const int vq = rnd * 8 + (bx & 7);
            for (;;) {
                __syncthreads();
                if (tid == 0) *qw = atomicAdd(qctr + vq, 1u);
                __syncthreads();
                const unsigned w = (unsigned)__builtin_amdgcn_readfirstlane((int)*qw);
                if (w >= 64u) break;
                att::attn_block3(refq(vq, 63 - (int)w), (char*)lds, wave);
            }
        }
    }
    asm volatile("" ::: "memory");
    REPS(15) if (IN(4)) {
        if (rep_) cg::this_grid().sync();
        __syncthreads();
        load_bias_tables((char*)lds, args.in[I_TAB], wave * 64 + lane_id(), att::A2_TBX);
        const bf16_t* QN = (const bf16_t*)(ws + WS_QN);
#ifndef NO_WIN
        {
            const bf16_t* KW = (const bf16_t*)(ws + WS_KW); const bf16_t* VW = (const bf16_t*)(ws + WS_VW); bf16_t* OW = (bf16_t*)((char*)out + OW_OFF);
            const int total = 16 * 64;
            auto ref = [&](int L) { const int bh = L >> 6, qb = L & 63, kvh = (bh >> 3) * 2 + ((bh & 7) >> 2);
                att::BlockRef r; r.Q = QN + ((size_t)bh * SEQ + (size_t)qb * 256) * 128; r.K = KW + (size_t)kvh * SEQ * 128; r.V = VW + (size_t)kvh * SEQ * 128;
                r.O = OW + ((size_t)bh * SEQ + (size_t)qb * 256) * 128; r.P0 = qb * 256; r.tb = (const float*)(lds + att::A2_TBX) + (bh & 7) * att::TBXN + att::TBX0; r.sel = nullptr; r.V2 = nullptr; r.O2 = nullptr; return r; };
            {
                unsigned* qctr = (unsigned*)ws + 24; volatile unsigned* qw = (volatile unsigned*)(lds + LDS_BYTES - 16);
                for (;;) {
                    __syncthreads();
                    if (tid == 0) *qw = atomicAdd(qctr, 1u);
                    __syncthreads();
                    const unsigned w = (unsigned)__builtin_amdgcn_readfirstlane((int)*qw);
                    if (w >= (unsigned)total) break;
                    att::attn_block2<1, false>(ref((int)w), (char*)lds, wave);
                }
            }
        }
#endif
    }
    SEAM(4);
    REPS(5) if (IN(5)) {
        if (rep_) cg::this_grid().sync();
        load_bias_tables((char*)lds, args.in[I_TAB], wave * 64 + lane_id());
        {
            unsigned* qctr = (unsigned*)ws + 20; volatile unsigned* qw = (volatile unsigned*)(lds + LDS_BYTES - 16); const int bg = bx & 3;
            for (;;) {
                __syncthreads();
                if (tid == 0) *qw = atomicAdd(qctr + bg, 1u);
                __syncthreads();
                const unsigned w = (unsigned)__builtin_amdgcn_readfirstlane((int)*qw);
                if (w >= 256u) break;
                att::cmp_item((char*)lds, ws, (float*)((char*)out + OC_OFF), bg >> 1, bg & 1, 255 - (int)w, wave);
            }
        }
    }
    SEAM(5);
    REPS(6) if (IN(6)) {
        if (rep_) cg::this_grid().sync();
        load_bias_tables((char*)lds, args.in[I_TAB], wave * 64 + lane_id());
        const bf16_t* QN = (const bf16_t*)(ws + WS_QN);
        __syncthreads();
#ifndef NO_SEL
        {
            const bf16_t* KS = (const bf16_t*)(ws + WS_KSL); const bf16_t* VS = (const bf16_t*)(ws + WS_VSL); bf16_t* OS = (bf16_t*)((char*)out + OS_OFF);
            const unsigned* SELM = (const unsigned*)(ws + WS_SELM);
            const int total = 4 * 128 * 2;
            auto ref = [&](int idx) { const int L = idx >> 1, pass = idx & 1, bg = (G == 256) ? (L & 3) : (L >> 7), xx = (G == 256) ? ((((L >> 2) & 1) * 2 + (L >> 8)) * 32 + ((L >> 3) & 31)) : (L & 127), qb = pass ? 255 - xx : xx;
                const size_t qo = ((size_t)((bg >> 1) * 8 + (bg & 1) * 4) * SEQ + (size_t)qb * 64) * 128;
                att::BlockRef r; r.Q = QN + qo; r.K = KS + (size_t)bg * SEQ * 128; r.V = VS + (size_t)bg * SEQ * 128;
                r.O = OS + qo; r.P0 = qb * 64; r.tb = (const float*)(lds + att::LDS_TBX) + ((bg & 1) * 4) * att::TBXN + att::TBX0;
                r.sel = SELM + (size_t)bg * SEQ * 8; r.V2 = nullptr; r.O2 = nullptr; return r; };
            (void)total;
            unsigned* qctr = (unsigned*)ws + 16; volatile unsigned* qw = (volatile unsigned*)(lds + LDS_BYTES - 16); const int bgq = bx & 3;
            auto refs = [&](int qb) { const int bg = bgq; const size_t qo = ((size_t)((bg >> 1) * 8 + (bg & 1) * 4) * SEQ + (size_t)qb * 64) * 128;
                att::BlockRef r; r.Q = QN + qo; r.K = KS + (size_t)bg * SEQ * 128; r.V = VS + (size_t)bg * SEQ * 128;
                r.O = OS + qo; r.P0 = qb * 64; r.tb = (const float*)(lds + att::LDS_TBX) + ((bg & 1) * 4) * att::TBXN + att::TBX0;
                r.sel = SELM + (size_t)bg * SEQ * 8; r.V2 = nullptr; r.O2 = nullptr; return r; };
#define SEL_FETCH(dst) do { __syncthreads(); if (tid == 0) *qw = atomicAdd(qctr + bgq, 1u); __syncthreads(); dst = (unsigned)__builtin_amdgcn_readfirstlane((int)*qw); } while (0)
            unsigned w0; SEL_FETCH(w0);
            if (w0 < 256u) {
                att::BlockRef cur = refs(255 - (int)w0); att::Seam S; int par = 0;
                att::attn_prime<2>(cur, (char*)lds, S, par, wave);
                for (;;) {
                    unsigned wn; SEL_FETCH(wn);
                    const bool last = wn >= 256u;
                    const att::BlockRef nxt = last ? cur : refs(255 - (int)wn);
                    att::attn_block<2>(cur, nxt, (char*)lds, S, par, wave);
                    if (last) break;
                    cur = nxt; par ^= 1;
                }
            }
#undef SEL_FETCH
        }
#endif
    }
    SEAM(6);
    REPS(7) if (IN(7)) {
        if (rep_) cg::this_grid().sync();
        float lam;
        { const float* q1 = args.in[I_LQ1]; const float* k1 = args.in[I_LK1]; const float* q2 = args.in[I_LQ2]; const float* k2 = args.in[I_LK2];
          float s1 = q1[lane] * k1[lane] + q1[lane + 64] * k1[lane + 64], s2 = q2[lane] * k2[lane] + q2[lane + 64] * k2[lane + 64];
          s1 = wave_sum(s1); s2 = wave_sum(s2); lam = expf(s1) - expf(s2) + 0.2f; }
        const bf16_t* OC = (const bf16_t*)((char*)out + OC_OFF); const bf16_t* OS = (const bf16_t*)((char*)out + OS_OFF); const bf16_t* OW = (const bf16_t*)((char*)out + OW_OFF);
        const bf16_t* O12 = (const bf16_t*)(ws + WS_O12); const float* GN = (const float*)(ws + WS_GN); const float* hg = args.in[I_HG];
        bf16_t* ONSA = (bf16_t*)(ws + WS_ONSA); bf16_t* OD = (bf16_t*)(ws + WS_OD);
        for (int m = gw; m < TOK; m += NGW) {
            const int b = m >> 14, s = m & (SEQ - 1);
            {
                const int h = lane >> 3, d = (lane & 7) * 16; const size_t off = ((size_t)(b * 8 + h) * SEQ + s) * 128 + d;
                const float g0 = GN[(size_t)m * 24 + h * 3], g1 = GN[(size_t)m * 24 + h * 3 + 1], g2 = GN[(size_t)m * 24 + h * 3 + 2];
#pragma unroll
                for (int e = 0; e < 2; ++e) { f32x4 c0, c1, s0, s1, w0, w1;
                    pg8::unpack8(*(const u32x4*)(OC + off + e * 8), c0, c1); pg8::unpack8(*(const u32x4*)(OS + off + e * 8), s0, s1); pg8::unpack8(*(const u32x4*)(OW + off + e * 8), w0, w1);
                    *(u32x4*)(ONSA + (size_t)m * 1024 + h * 128 + d + e * 8) = pg8::pack8v(c0 * g0 + s0 * g1 + w0 * g2, c1 * g0 + s1 * g1 + w1 * g2); }
            }
            {
                const int h = lane >> 4, j = (lane & 15) * 16, vhalf = j >> 7, d = j & 127;
                const size_t o1 = ((size_t)(((b * 4 + h) * 2 + 0) * 2 + vhalf) * SEQ + s) * 128 + d, o2 = ((size_t)(((b * 4 + h) * 2 + 1) * 2 + vhalf) * SEQ + s) * 128 + d;
                f32x4 v[4]; float ss = 0.f;
#pragma unroll
                for (int e = 0; e < 2; ++e) { f32x4 a0, a1, b0, b1; pg8::unpack8(*(const u32x4*)(O12 + o1 + e * 8), a0, a1); pg8::unpack8(*(const u32x4*)(O12 + o2 + e * 8), b0, b1);
                    v[2 * e] = a0 - b0 * lam; v[2 * e + 1] = a1 - b1 * lam; }
#pragma unroll
                for (int e = 0; e < 4; ++e) ss += (v[e].x * v[e].x + v[e].y * v[e].y) + (v[e].z * v[e].z + v[e].w * v[e].w);
                ss = row16_sum(ss);
                const float rstd = rsqrtf(ss * (1.f / 256.f) + RMS_EPS) * 0.8f;
                const f32x4* gp = (const f32x4*)(hg + h * 256 + j);
#pragma unroll
                for (int e = 0; e < 2; ++e) *(u32x4*)(OD + (size_t)m * 1024 + h * 256 + j + e * 8) = pg8::pack8v(v[2 * e] * rstd * gp[2 * e], v[2 * e + 1] * rstd * gp[2 * e + 1]);
            }
        }
    }
    SEAM(7);
    REPS(8) if (IN(8)) {
        if (rep_) cg::this_grid().sync();
#ifdef PROBE8
        { pg8::Gemm g{(const bf16_t*)(ws + WS_ONSA), (const bf16_t*)(ws + WS_WUPN), TOK, DM, 1024, 1024, TOK / 256, 0};
          pg8::StaticOrder S; S.init(TOK, DM, G, bx); pg8::EpiUp<0> E{(bf16_t*)(ws + WS_QN), (const bf16_t*)(ws + WS_GM)}; pg8::gemm_phase(ldsl, g, S, E, wave); }
        { pg8::Gemm g{(const bf16_t*)(ws + WS_OD), (const bf16_t*)(ws + WS_WUPD), TOK, DM, 1024, 1024, TOK / 256, 0};
          pg8::StaticOrder S; S.init(TOK, DM, G, bx); pg8::EpiUp<1> E{(bf16_t*)(ws + WS_QN), (const bf16_t*)(ws + WS_GM)}; pg8::gemm_phase(ldsl, g, S, E, wave); }
        cg::this_grid().sync();
#endif
        pg8::Gemm g{(const bf16_t*)(ws + WS_ONSA), (const bf16_t*)(ws + WS_WUPN), TOK, DM, 1024, 1024, TOK / 256, 0};
        pg8::StaticOrder S; S.init(TOK, DM, G, bx);
        pg8::EpiUp<0> E{(bf16_t*)(ws + WS_MIX), (const bf16_t*)(ws + WS_GM)};
        pg8::gemm_phase(ldsl, g, S, E, wave);
    }
    if (IN(9)) {
        pg8::Gemm g{(const bf16_t*)(ws + WS_OD), (const bf16_t*)(ws + WS_WUPD), TOK, DM, 1024, 1024, TOK / 256, 0};
        pg8::StaticOrder S; S.init(TOK, DM, G, bx);
        pg8::EpiUp<1> E{(bf16_t*)(ws + WS_MIX), (const bf16_t*)(ws + WS_GM)};
        pg8::gemm_phase(ldsl, g, S, E, wave);
    }
    SEAM(9);
    REPS(10) if (IN(10)) {
        if (rep_) cg::this_grid().sync();
        pg8::Gemm g{(const bf16_t*)(ws + WS_MIX), (const bf16_t*)(ws + WS_WOUT), TOK, DM, DM, DM, TOK / 256, 0};
        pg8::StaticOrder S; S.init(TOK, DM, G, bx);
        pg8::EpiRes E{x, out};
        pg8::gemm_phase(ldsl, g, S, E, wave);
    }
    SEAM(10);
    REPS(11) if (IN(11)) { if (rep_) cg::this_grid().sync(); for (int m = gw; m < TOK; m += NGW) rms_row<true>(out + (size_t)m * DM, args.in[I_NFG], XN + (size_t)m * DM, lane); }
    SEAM(11);
    REPS(12) if (IN(12)) {
        if (rep_) cg::this_grid().sync();
        pg8::Gemm g{XN, (const bf16_t*)(ws + WS_WFFI), TOK, 2 * DFF, DM, DM, TOK / 256, 0};
        pg8::QueueOrder S; S.init(TOK, 2 * DFF, bx & 7, (unsigned*)ws + 40);
        pg8::EpiSwiglu E{(bf16_t*)(ws + WS_HID)};
        pg8::gemm_phase(ldsl, g, S, E, wave);
    }
    SEAM(12);
    if (IN(13)) {
        pg8::Gemm g{(const bf16_t*)(ws + WS_HID), (const bf16_t*)(ws + WS_WFFO), TOK, DM, DFF, DFF, TOK / 256, 0};
        pg8::StaticOrder S; S.init(TOK, DM, G, bx);
#ifdef PROBE13
        { pg8::EpiRes E0{out, (float*)(ws + WS_GM)}; pg8::gemm_phase(ldsl, g, S, E0, wave); cg::this_grid().sync(); }
#endif
        pg8::EpiRes E{out, out};
        pg8::gemm_phase(ldsl, g, S, E, wave);
    }
    SEAM(13);
#ifdef PROBE14
    if (IN(14)) { for (int m = gw; m < TOK; m += NGW) rms_row<false>(out + (size_t)m * DM, args.in[I_NFIN], (float*)(ws + WS_GM) + (size_t)m * DM, lane); cg::this_grid().sync(); }
#endif
    if (IN(14)) { for (int m = gw; m < TOK; m += NGW) rms_row<false>(out + (size_t)m * DM, args.in[I_NFIN], out + (size_t)m * DM, lane); }
#undef IN
#undef SEAM
#undef lane
#undef tid
}

extern "C" void kernel_launch(void* const* d_in, const int* in_sizes, int n_in, void* d_out, int out_size, void* d_ws, size_t ws_size, hipStream_t stream) {
    static int grid = 0;
    if (grid == 0) {
        if (n_in != 22 || out_size != TOK * DM || ws_size < WS_END) { fprintf(stderr, "kernel_launch: unexpected shapes (n_in %d out %d ws %zu need %zu)\n", n_in, out_size, ws_size, (size_t)WS_END); grid = -1; return; }
        int dev = 0, cus = 0, per_cu = 0;
        (void)hipGetDevice(&dev); (void)hipDeviceGetAttribute(&cus, hipDeviceAttributeMultiprocessorCount, dev);
        if (hipFuncSetAttribute((const void*)mega_fwd, hipFuncAttributeMaxDynamicSharedMemorySize, LDS_BYTES) != hipSuccess) { fprintf(stderr, "kernel_launch: hipFuncSetAttribute failed\n"); grid = -1; return; }
        (void)hipOccupancyMaxActiveBlocksPerMultiprocessor(&per_cu, (const void*)mega_fwd, 512, LDS_BYTES);
        (void)hipGetLastError();
        if (per_cu < 1) per_cu = 1;
        grid = cus > 0 ? cus : 256;
        fprintf(stderr, "kernel_launch: grid %d (per_cu %d)\n", grid, per_cu);
    }
    if (grid < 0) return;
    Args a{};
    for (int i = 0; i < 22; ++i) a.in[i] = (const float*)d_in[i];
    a.out = (float*)d_out; a.ws = (unsigned char*)d_ws;
#if MK_N_LAUNCHES == 1
    a.ph_lo = 0; a.ph_hi = NPH;
    void* kargs[] = {&a};
    hipError_t e = hipLaunchCooperativeKernel((const void*)mega_fwd, dim3(grid), dim3(512), kargs, LDS_BYTES, stream);
    if (e != hipSuccess) fprintf(stderr, "kernel_launch: cooperative launch failed: %s\n", hipGetErrorString(e));
#else
    for (int p = 0; p < NPH; ++p) { a.ph_lo = p; a.ph_hi = p + 1; hipLaunchKernelGGL(mega_fwd, dim3(grid), dim3(512), LDS_BYTES, stream, a); }
#endif
}
```

```cpp
#include <hip/hip_runtime.h>
#include <hip/hip_cooperative_groups.h>
#include <cstdio>
#include <cstdint>
namespace cg = cooperative_groups;

#ifndef MK_N_LAUNCHES
#define MK_N_LAUNCHES 1
#endif
#define CMP_IN_P4 1
#define DUP_MASK 0x0

#define LAS __attribute__((address_space(3)))
typedef unsigned short bf16_t;
typedef short bf16x8 __attribute__((ext_vector_type(8)));
typedef short s16x4 __attribute__((ext_vector_type(4)));
typedef float f32x4 __attribute__((ext_vector_type(4)));
typedef float f32x16 __attribute__((ext_vector_type(16)));
typedef unsigned u32x4 __attribute__((ext_vector_type(4)));
typedef unsigned u32x2 __attribute__((ext_vector_type(2)));

constexpr int SEQ = 16384, NBATCH = 2, TOK = NBATCH * SEQ, DM = 2048, DFF = 5632, HD = 128;
constexpr int NPROJ_SRC = 9752, NPROJ = 9984;
constexpr int KCROWS = SEQ + 16;
constexpr float SM_SCALE = 0.08838834764831845f;
constexpr float RMS_EPS = 1e-6f;

constexpr size_t WS_WIN  = 1u << 20;
constexpr size_t WS_WFFI = WS_WIN  + (size_t)NPROJ * DM * 2;
constexpr size_t WS_WFFO = WS_WFFI + (size_t)2 * DFF * DM * 2;
constexpr size_t WS_WOUT = WS_WFFO + (size_t)DM * DFF * 2;
constexpr size_t WS_WUPN = WS_WOUT + (size_t)DM * DM * 2;
constexpr size_t WS_WUPD = WS_WUPN + (size_t)DM * 1024 * 2;
constexpr size_t WS_W1K  = WS_WUPD + (size_t)DM * 1024 * 2;
constexpr size_t WS_W1V  = WS_W1K + (size_t)256 * 4096 * 2;
constexpr size_t WS_W2K  = WS_W1V + (size_t)256 * 4096 * 2;
constexpr size_t WS_W2V  = WS_W2K + (size_t)256 * 256 * 2;
constexpr size_t WS_BK   = WS_W2V + (size_t)256 * 256 * 2;
constexpr size_t WS_BV   = WS_BK + 1024;
constexpr size_t WS_XN   = WS_BV + 1024;
constexpr size_t WS_QN   = WS_XN + (size_t)TOK * DM * 2;
constexpr size_t WS_KC   = WS_QN + (size_t)TOK * 1024 * 2;
constexpr size_t WS_VC   = WS_KC + (size_t)4 * KCROWS * 128 * 2;
constexpr size_t WS_KSL  = WS_VC + (size_t)4 * KCROWS * 128 * 2;
constexpr size_t WS_VSL  = WS_KSL + (size_t)4 * SEQ * 128 * 2;
constexpr size_t WS_KW   = WS_VSL + (size_t)4 * SEQ * 128 * 2;
constexpr size_t WS_VW   = WS_KW + (size_t)4 * SEQ * 128 * 2;
constexpr size_t WS_QD   = WS_VW + (size_t)4 * SEQ * 128 * 2;
constexpr size_t WS_KD   = WS_QD + (size_t)TOK * 1024 * 2;
constexpr size_t WS_VD   = WS_KD + (size_t)TOK * 1024 * 2;
constexpr size_t WS_GM   = WS_VD + (size_t)TOK * 1024 * 2;
constexpr size_t WS_GN   = WS_GM + (size_t)TOK * 4096 * 2;
constexpr size_t WS_HK   = WS_GN + (size_t)TOK * 24 * 4;
constexpr size_t WS_HV   = WS_HK + (size_t)4096 * 256 * 2;
constexpr size_t WS_KCMP = WS_HV + (size_t)4096 * 256 * 2;
constexpr size_t WS_VCMP = WS_KCMP + (size_t)4096 * 128 * 2;
constexpr size_t WS_SELM = WS_VCMP + (size_t)4096 * 128 * 2;
constexpr size_t WS_END  = WS_SELM + (size_t)4 * SEQ * 8 * 4;
constexpr size_t WS_O12  = WS_XN;
constexpr size_t WS_ONSA = WS_QD;
constexpr size_t WS_OD   = WS_KD;
constexpr size_t WS_MIX  = WS_XN;
constexpr size_t WS_HID  = WS_QN;
static_assert(WS_HID + (size_t)TOK * DFF * 2 <= WS_GM, "HID overlay");
static_assert(WS_END <= (size_t)1 << 30, "workspace");

constexpr int LDS_BYTES = 163840;

__device__ __forceinline__ unsigned cvtpk(float lo, float hi) { unsigned r; asm volatile("v_cvt_pk_bf16_f32 %0, %1, %2" : "=v"(r) : "v"(lo), "v"(hi)); return r; }
__device__ __forceinline__ float bf2f(unsigned short h) { return __uint_as_float((unsigned)h << 16); }
__device__ __forceinline__ float sigmoidf_(float x) { return __builtin_amdgcn_rcpf(1.f + __builtin_amdgcn_exp2f(-1.4426950408889634f * x)); }
__device__ __forceinline__ int lane_id() {
    unsigned l; asm volatile("v_mbcnt_lo_u32_b32 %0, -1, 0\n\tv_mbcnt_hi_u32_b32 %0, -1, %0" : "=v"(l)); return (int)(l & 63u); }
__device__ __forceinline__ float xor1_(float v) { return __int_as_float(__builtin_amdgcn_update_dpp(0, __float_as_int(v), 0xB1, 0xf, 0xf, false)); }
#define DPP_F(v, ctrl) __int_as_float(__builtin_amdgcn_update_dpp(0, __float_as_int(v), ctrl, 0xf, 0xf, false))
__device__ __forceinline__ float row16_sum(float v) {
    v += DPP_F(v, 0xB1); v += DPP_F(v, 0x4E); v += DPP_F(v, 0x141); v += DPP_F(v, 0x140); return v; }
__device__ __forceinline__ float wave_sum(float v) {
    v = row16_sum(v);
    { auto rr = __builtin_amdgcn_permlane16_swap(__float_as_uint(v), __float_as_uint(v), false, false); v = __uint_as_float(rr[0]) + __uint_as_float(rr[1]); }
    { auto rr = __builtin_amdgcn_permlane32_swap(__float_as_uint(v), __float_as_uint(v), false, false); v = __uint_as_float(rr[0]) + __uint_as_float(rr[1]); }
    return v;
}

namespace pg8 {
constexpr int BM = 256, BK = 64, HALF = 128, HTB = HALF * BK * 2, STAGE_BYTES = 8 * HTB, NXCD = 8, WGM = 8;
__host__ __device__ __forceinline__ int lds_byte(int r, int c) { const int st = (r >> 4) * 2 + (c >> 5), rr = r & 15, cc = c & 31, ob = rr * 64 + cc * 2; return st * 1024 + (ob ^ (((ob >> 9) & 1) << 5)); }
__host__ __device__ __forceinline__ void stage_rc(int b, int& R, int& C) { const int st = b / 1024, sb = b % 1024, swz = sb ^ (((sb >> 9) & 1) << 5); R = (st >> 1) * 16 + swz / 64; C = (st & 1) * 32 + (swz % 64) / 2; }
__host__ __device__ __forceinline__ int perm32(int rho) { const int n = rho >> 4, i = rho & 15; return 8 * (i >> 2) + 4 * n + (i & 3); }
struct Unit { int pm, pn; };
struct Gemm { const bf16_t* A; const bf16_t* Bt; int M, N, K, lda, tps; size_t slab; };
struct StaticOrder {
    int nM, nN, nwg, G, c;
    __device__ void init(int M, int N, int G_, int c_) { nM = M / BM; nN = N / BM; nwg = nM * nN; G = G_; c = c_; }
    __device__ bool next(int i, Unit& u) const {
        const long L = (long)i * G + c; if (L >= nwg) return false;
        int wgid = (int)L; { const int q = nwg / NXCD, r = nwg % NXCD, xcd = wgid % NXCD, off = wgid / NXCD; wgid = (xcd < r ? xcd * (q + 1) : r * (q + 1) + (xcd - r) * q) + off; }
        const int nig = WGM * nN, gid = wgid / nig, fm = gid * WGM, gsz = (nM - fm) < WGM ? (nM - fm) : WGM;
        u.pm = fm + ((wgid % nig) % gsz); u.pn = (wgid % nig) / gsz; return true;
    }
};
template <class Epi>
__device__ __forceinline__ void gemm_phase(LAS unsigned char* lds, const Gemm g, const StaticOrder& S, const Epi& E, const int wid) {
    const int lane = lane_id(), tid = wid * 64 + lane, wr = wid >> 2, wc = wid & 3, fr = lane & 15, fq = lane >> 4;
    const int K = g.K, nt = K / BK, lda = g.lda;
    unsigned voffA[2], voffB[2];
#pragma unroll
    for (int i = 0; i < 2; ++i) { int R, C; stage_rc(tid * 16 + i * 8192, R, C); const int Rb = (R & ~31) + perm32(R & 31);
        voffA[i] = (unsigned)(R * lda + C) * 2u; voffB[i] = (unsigned)(Rb * K + C) * 2u; }
    const size_t kstep = (size_t)(BK * 2);
    const size_t hstepA = (size_t)HALF * lda * 2, hstepB = (size_t)HALF * K * 2;
    const unsigned ldsw = (unsigned)wid * 1024u;
    const int aoff = lds_byte(wr * 64 + fr, fq * 8), boff = lds_byte(wc * 32 + fr, fq * 8);
#define PG8_TILEA(pm) ((const char*)g.A + ((size_t)((pm) / g.tps) * g.slab + (size_t)((pm) % g.tps) * 256 * lda) * 2)
#define PG8_TILEB(pn) ((const char*)g.Bt + (size_t)(pn) * 2 * hstepB)
#define PG8_SA(b, h) (((b) * 2 + (h)) * HTB)
#define PG8_SB(b, h) ((4 + (b) * 2 + (h)) * HTB)
#define PG8_STAGE(bufoff, gbase, voff) do { _Pragma("unroll") for (int _i = 0; _i < 2; ++_i) \
        __builtin_amdgcn_global_load_lds((const unsigned*)((const char*)(gbase) + (voff)[_i]), (LAS unsigned*)(lds + (bufoff) + ldsw + _i * 8192), 16, 0, 0); } while (0)
#define PG8_LDA(dst, b, h) do { _Pragma("unroll") for (int m = 0; m < 4; ++m) _Pragma("unroll") for (int k = 0; k < 2; ++k) dst[m][k] = *(const LAS bf16x8*)(lds + PG8_SA(b, h) + aoff + m * 2048 + k * 1024); } while (0)
#define PG8_LDB(dst, b, h) do { _Pragma("unroll") for (int n = 0; n < 2; ++n) _Pragma("unroll") for (int k = 0; k < 2; ++k) dst[n][k] = *(const LAS bf16x8*)(lds + PG8_SB(b, h) + boff + n * 2048 + k * 1024); } while (0)
#define PG8_MMA(ai, bj, At, Bt) do { __builtin_amdgcn_s_setprio(1); _Pragma("unroll") for (int m = 0; m < 4; ++m) _Pragma("unroll") for (int n = 0; n < 2; ++n) _Pragma("unroll") for (int k = 0; k < 2; ++k) \
        acc[ai][bj][m][n] = __builtin_amdgcn_mfma_f32_16x16x32_bf16(Bt[n][k], At[m][k], acc[ai][bj][m][n], 0, 0, 0); __builtin_amdgcn_s_setprio(0); } while (0)
#define PG8_WAIT_V(n) asm volatile("s_waitcnt vmcnt(" #n ")" ::: "memory")
#define PG8_WAIT_L(n) asm volatile("s_waitcnt lgkmcnt(" #n ")" ::: "memory")
#define PG8_BAR __builtin_amdgcn_s_barrier()
#define PG8_SCHED __builtin_amdgcn_sched_barrier(0)
    Unit cur, nxt; int ui = 0;
    if (!S.next(0, cur)) return;
    f32x4 acc[2][2][4][2];
#pragma unroll
    for (int a = 0; a < 2; ++a)
#pragma unroll
        for (int b = 0; b < 2; ++b)
#pragma unroll
            for (int m = 0; m < 4; ++m)
#pragma unroll
                for (int n = 0; n < 2; ++n) acc[a][b][m][n] = (f32x4){0.f, 0.f, 0.f, 0.f};
    bf16x8 At[4][2], B0[2][2], B1[2][2];
    const char* cA = PG8_TILEA(cur.pm); const char* cB = PG8_TILEB(cur.pn);
    PG8_STAGE(PG8_SB(0, 0), cB, voffB); PG8_STAGE(PG8_SB(0, 1), cB + hstepB, voffB); PG8_STAGE(PG8_SA(0, 0), cA, voffA); PG8_STAGE(PG8_SA(0, 1), cA + hstepA, voffA);
    if (wr == 1) PG8_BAR;
    PG8_WAIT_V(2); PG8_BAR;
    PG8_STAGE(PG8_SB(1, 0), cB + kstep, voffB); PG8_STAGE(PG8_SA(1, 0), cA + kstep, voffA); PG8_STAGE(PG8_SB(1, 1), cB + hstepB + kstep, voffB);
    PG8_WAIT_V(6); PG8_BAR;
    for (;;) {
        const bool has_next = S.next(ui + 1, nxt);
        const char* nA = has_next ? PG8_TILEA(nxt.pm) : cA; const char* nB = has_next ? PG8_TILEB(nxt.pn) : cB;
        for (int t = 0; t < nt; t += 2) {
            const bool last = (t == nt - 2);
            const char* a1 = cA + (size_t)(t + 1) * kstep;
            const char* a2 = last ? nA : cA + (size_t)(t + 2) * kstep; const char* b2 = last ? nB : cB + (size_t)(t + 2) * kstep;
            const char* a3 = a2 + kstep; const char* b3 = b2 + kstep;
            PG8_LDB(B0, 0, 0); PG8_LDB(B1, 0, 1); PG8_SCHED; PG8_LDA(At, 0, 0); PG8_STAGE(PG8_SA(1, 1), a1 + hstepA, voffA);
            PG8_WAIT_V(8); PG8_WAIT_L(0); PG8_BAR; PG8_MMA(0, 0, At, B0); PG8_MMA(0, 1, At, B1); PG8_BAR; PG8_SCHED;
            PG8_LDA(At, 0, 1); PG8_STAGE(PG8_SB(0, 0), b2, voffB); PG8_STAGE(PG8_SB(0, 1), b2 + hstepB, voffB); PG8_STAGE(PG8_SA(0, 0), a2, voffA);
            PG8_WAIT_V(8); PG8_WAIT_L(0); PG8_BAR; PG8_MMA(1, 0, At, B0); PG8_MMA(1, 1, At, B1); PG8_BAR; PG8_SCHED;
            PG8_LDB(B0, 1, 0); PG8_LDB(B1, 1, 1); PG8_SCHED; PG8_LDA(At, 1, 0); PG8_STAGE(PG8_SA(0, 1), a2 + hstepA, voffA);
            PG8_WAIT_V(8); PG8_WAIT_L(0); PG8_BAR; PG8_MMA(0, 0, At, B0); PG8_MMA(0, 1, At, B1); PG8_BAR; PG8_SCHED;
            PG8_LDA(At, 1, 1); PG8_STAGE(PG8_SB(1, 0), b3, voffB); PG8_STAGE(PG8_SB(1, 1), b3 + hstepB, voffB); PG8_STAGE(PG8_SA(1, 0), a3, voffA);
            PG8_WAIT_V(8); PG8_WAIT_L(0); PG8_BAR; PG8_MMA(1, 0, At, B0); PG8_MMA(1, 1, At, B1); PG8_BAR; PG8_SCHED;
        }
        if (wr == 0) PG8_BAR;
        E(acc, cur, wr, wc, fr, fq);
        if (!has_next) break;
#pragma unroll
        for (int a = 0; a < 2; ++a)
#pragma unroll
            for (int b = 0; b < 2; ++b)
#pragma unroll
                for (int m = 0; m < 4; ++m)
#pragma unroll
                    for (int n = 0; n < 2; ++n) acc[a][b][m][n] = (f32x4){0.f, 0.f, 0.f, 0.f};
        cur = nxt; cA = nA; cB = nB; ++ui;
        if (wr == 1) PG8_BAR;
    }
    PG8_WAIT_V(0);
    PG8_BAR;
#undef PG8_TILEA
#undef PG8_TILEB
#undef PG8_SA
#undef PG8_SB
#undef PG8_STAGE
#undef PG8_LDA
#undef PG8_LDB
#undef PG8_MMA
#undef PG8_WAIT_V
#undef PG8_WAIT_L
#undef PG8_BAR
#undef PG8_SCHED
}

typedef f32x4 Acc[2][2][4][2];
__device__ __forceinline__ u32x4 pack8v(f32x4 a, f32x4 b) { u32x4 w; w.x = cvtpk(a[0], a[1]); w.y = cvtpk(a[2], a[3]); w.z = cvtpk(b[0], b[1]); w.w = cvtpk(b[2], b[3]); return w; }
__device__ __forceinline__ void unpack8(u32x4 w, f32x4& a, f32x4& b) {
    a[0] = __uint_as_float(w.x << 16); a[1] = __uint_as_float(w.x & 0xffff0000u); a[2] = __uint_as_float(w.y << 16); a[3] = __uint_as_float(w.y & 0xffff0000u);
    b[0] = __uint_as_float(w.z << 16); b[1] = __uint_as_float(w.z & 0xffff0000u); b[2] = __uint_as_float(w.w << 16); b[3] = __uint_as_float(w.w & 0xffff0000u);
}

struct EpiProj {
    unsigned char* ws;
    __device__ __forceinline__ void operator()(const Acc& acc, const Unit& u, int wr, int wc, int fr, int fq) const {
        const int d = wc * 32 + 8 * fq;
#pragma unroll
        for (int bj = 0; bj < 2; ++bj) {
            const int blk = u.pn * 2 + bj;
            if (blk >= 77) continue;
            bf16_t* base; size_t bstride; int kind = 0;
            if (blk < 8)       { base = (bf16_t*)(ws + WS_QN) + (size_t)blk * SEQ * 128; bstride = (size_t)8 * SEQ * 128; }
            else if (blk < 10) { base = (bf16_t*)(ws + WS_KC) + (size_t)(blk - 8) * KCROWS * 128; bstride = (size_t)2 * KCROWS * 128; }
            else if (blk < 12) { base = (bf16_t*)(ws + WS_VC) + (size_t)(blk - 10) * KCROWS * 128; bstride = (size_t)2 * KCROWS * 128; }
            else if (blk < 14) { base = (bf16_t*)(ws + WS_KSL) + (size_t)(blk - 12) * SEQ * 128; bstride = (size_t)2 * SEQ * 128; }
            else if (blk < 16) { base = (bf16_t*)(ws + WS_VSL) + (size_t)(blk - 14) * SEQ * 128; bstride = (size_t)2 * SEQ * 128; }
            else if (blk < 18) { base = (bf16_t*)(ws + WS_KW) + (size_t)(blk - 16) * SEQ * 128; bstride = (size_t)2 * SEQ * 128; }
            else if (blk < 20) { base = (bf16_t*)(ws + WS_VW) + (size_t)(blk - 18) * SEQ * 128; bstride = (size_t)2 * SEQ * 128; }
            else if (blk < 28) { base = (bf16_t*)(ws + WS_QD) + (size_t)(blk - 20) * SEQ * 128; bstride = (size_t)8 * SEQ * 128; }
            else if (blk < 36) { base = (bf16_t*)(ws + WS_KD) + (size_t)(blk - 28) * SEQ * 128; bstride = (size_t)8 * SEQ * 128; }
            else if (blk < 44) { base = (bf16_t*)(ws + WS_VD) + (size_t)(blk - 36) * SEQ * 128; bstride = (size_t)8 * SEQ * 128; }
            else if (blk < 76) { base = (bf16_t*)(ws + WS_GM) + (size_t)(blk - 44) * 128; bstride = 0; kind = 1; }
            else               { base = nullptr; bstride = 0; kind = 2; }
#pragma unroll
            for (int ai = 0; ai < 2; ++ai)
#pragma unroll
                for (int m = 0; m < 4; ++m) {
                    const int row = u.pm * 256 + ai * 128 + wr * 64 + m * 16 + fr;
                    f32x4 v0 = acc[ai][bj][m][0], v1 = acc[ai][bj][m][1];
                    if (kind == 0) {
                        const int b = row >> 14, s = row & (SEQ - 1);
                        *(u32x4*)(base + (size_t)b * bstride + (size_t)s * 128 + d) = pack8v(v0, v1);
                    } else if (kind == 1) {
#pragma unroll
                        for (int e = 0; e < 4; ++e) { v0[e] = sigmoidf_(v0[e]); v1[e] = sigmoidf_(v1[e]); }
                        *(u32x4*)(base + (size_t)row * 4096 + d) = pack8v(v0, v1);
                    } else {
                        if (d < 24) { float* gn = (float*)(ws + WS_GN) + (size_t)row * 24 + d;
#pragma unroll
                            for (int e = 0; e < 4; ++e) { v0[e] = sigmoidf_(v0[e]); v1[e] = sigmoidf_(v1[e]); }
                            *(f32x4*)gn = v0; *(f32x4*)(gn + 4) = v1; }
                    }
                }
        }
    }
};
struct EpiCmp1 {
    bf16_t* H; const float* bias;
    __device__ __forceinline__ void operator()(const Acc& acc, const Unit& u, int wr, int wc, int fr, int fq) const {
#pragma unroll
        for (int bj = 0; bj < 2; ++bj) {
            const int c = bj * 128 + wc * 32 + 8 * fq;
            const f32x4 b0 = *(const f32x4*)(bias + c), b1 = *(const f32x4*)(bias + c + 4);
#pragma unroll
            for (int ai = 0; ai < 2; ++ai)
#pragma unroll
                for (int m = 0; m < 4; ++m) {
                    const int row = u.pm * 256 + ai * 128 + wr * 64 + m * 16 + fr;
                    f32x4 v0 = acc[ai][bj][m][0] + b0, v1 = acc[ai][bj][m][1] + b1;
#pragma unroll
                    for (int e = 0; e < 4; ++e) {
                        float x = v0[e]; float t = 1.5957691216f * (x + 0.044715f * x * x * x); v0[e] = x * sigmoidf_(t);
                        x = v1[e]; t = 1.5957691216f * (x + 0.044715f * x * x * x); v1[e] = x * sigmoidf_(t); }
                    *(u32x4*)(H + (size_t)row * 256 + c) = pack8v(v0, v1);
                }
        }
    }
};
struct EpiCmp2 {
    bf16_t* O;
    __device__ __forceinline__ void operator()(const Acc& acc, const Unit& u, int wr, int wc, int fr, int fq) const {
        const int c = wc * 32 + 8 * fq;
#pragma unroll
        for (int ai = 0; ai < 2; ++ai)
#pragma unroll
            for (int m = 0; m < 4; ++m) {
                const int row = u.pm * 256 + ai * 128 + wr * 64 + m * 16 + fr;
                *(u32x4*)(O + (size_t)row * 128 + c) = pack8v(acc[ai][0][m][0], acc[ai][0][m][1]);
            }
    }
};
template <int MODE> struct EpiUp {
    bf16_t* T; const bf16_t* GM;
    __device__ __forceinline__ void operator()(const Acc& acc, const Unit& u, int wr, int wc, int fr, int fq) const {
#pragma unroll
        for (int bj = 0; bj < 2; ++bj) {
            const int c = u.pn * 256 + bj * 128 + wc * 32 + 8 * fq;
#pragma unroll
            for (int ai = 0; ai < 2; ++ai)
#pragma unroll
                for (int m = 0; m < 4; ++m) {
                    const int row = u.pm * 256 + ai * 128 + wr * 64 + m * 16 + fr;
                    f32x4 g0, g1; unpack8(*(const u32x4*)(GM + (size_t)row * 4096 + MODE * 2048 + c), g0, g1);
                    f32x4 v0 = acc[ai][bj][m][0] * g0, v1 = acc[ai][bj][m][1] * g1;
                    bf16_t* tp = T + (size_t)row * 2048 + c;
                    if (MODE == 1) { f32x4 t0, t1; unpack8(*(const u32x4*)tp, t0, t1); v0 += t0; v1 += t1; }
                    *(u32x4*)tp = pack8v(v0, v1);
                }
        }
    }
};
struct EpiRes {
    const float* res; float* out;
    __device__ __forceinline__ void operator()(const Acc& acc, const Unit& u, int wr, int wc, int fr, int fq) const {
#pragma unroll
        for (int bj = 0; bj < 2; ++bj) {
            const int c = u.pn * 256 + bj * 128 + wc * 32 + 8 * fq;
#pragma unroll
            for (int ai = 0; ai < 2; ++ai)
#pragma unroll
                for (int m = 0; m < 4; ++m) {
                    const size_t off = (size_t)(u.pm * 256 + ai * 128 + wr * 64 + m * 16 + fr) * DM + c;
                    const f32x4 r0 = *(const f32x4*)(res + off), r1 = *(const f32x4*)(res + off + 4);
                    *(f32x4*)(out + off) = r0 + acc[ai][bj][m][0]; *(f32x4*)(out + off + 4) = r1 + acc[ai][bj][m][1];
                }
        }
    }
};
struct EpiSwiglu {
    bf16_t* H;
    __device__ __forceinline__ void operator()(const Acc& acc, const Unit& u, int wr, int wc, int fr, int fq) const {
        const int c = u.pn * 128 + wc * 32 + 8 * fq;
#pragma unroll
        for (int ai = 0; ai < 2; ++ai)
#pragma unroll
            for (int m = 0; m < 4; ++m) {
                const int row = u.pm * 256 + ai * 128 + wr * 64 + m * 16 + fr;
                f32x4 v0, v1;
#pragma unroll
                for (int e = 0; e < 4; ++e) { const float a0 = acc[ai][0][m][0][e], a1 = acc[ai][0][m][1][e];
                    v0[e] = a0 * sigmoidf_(a0) * acc[ai][1][m][0][e]; v1[e] = a1 * sigmoidf_(a1) * acc[ai][1][m][1][e]; }
                *(u32x4*)(H + (size_t)row * DFF + c) = pack8v(v0, v1);
            }
    }
};
}

namespace att {
constexpr int D = 128, NW = 8, QBLK = 32, KVBLK = 64, QB = NW * QBLK;
constexpr int SHM_V = KVBLK * D * 2, SHM_K = KVBLK * D * 2;
constexpr int LDS_TB = 2 * SHM_V + 2 * SHM_K + NW * 64 * 4;
constexpr int LDS_TBX = LDS_TB + 12 * 128 * 4;
constexpr int TBXN = 544, TBX0 = 320;
constexpr int LDS_SEL = LDS_TBX + 12 * TBXN * 4;
constexpr int LDS_PSLC = LDS_TB + 12 * 128 * 4;
constexpr int BAND = 113;
constexpr float THR = 8.f;
#define KSWZ(row, colB) ((row) * 256 + ((colB) ^ (((row) & 7) << 4)))
#define SBAR() __builtin_amdgcn_sched_barrier(0)
__device__ __forceinline__ int v_st(int k, int c) { const int kk = (k & ~0xC) | ((k & 4) << 1) | ((k & 8) >> 1); return ((kk >> 3) * 4 + (c >> 5)) * 512 + ((kk & 7) * 32 + (c & 31)) * 2; }
__device__ __forceinline__ int v_rd_base(int lane) { return ((lane & 3) << 3) | (((lane >> 2) & 3) << 6) | (((lane >> 4) & 1) << 5) | (((lane >> 5) & 1) << 8); }
constexpr int v_rd_off(int d0, int ks, int half) { return d0 * 512 + ks * 4096 + half * 2048; }
__device__ __forceinline__ int crow(int r, int hi) { return (r & 3) + 8 * (r >> 2) + 4 * hi; }
__device__ __forceinline__ bf16x8 load8(const bf16_t* p) { return *reinterpret_cast<const bf16x8*>(p); }

__device__ __forceinline__ void bias_mask_tile(f32x16& p0, f32x16& p1, int dq, unsigned W, const float* tbx) {
    const float NEG = -__builtin_inff();
    const float* bp = tbx + (dq - 63);
#pragma unroll
    for (int r = 0; r < 16; ++r) {
        const int c = (r & 3) + 8 * (r >> 2);
        const unsigned r0 = (unsigned)(dq - c), r1 = (unsigned)(dq - c - 32);
        const float b0 = bp[63 - c], b1 = bp[31 - c];
        p0[r] = r0 >= W ? NEG : p0[r] + b0;
        p1[r] = r1 >= W ? NEG : p1[r] + b1;
        if ((r & 3) == 3) __builtin_amdgcn_sched_barrier(0);
    }
}
__device__ __forceinline__ void mask_tile(f32x16& p0, f32x16& p1, int dq, unsigned W) {
    const float NEG = -__builtin_inff();
#pragma unroll
    for (int r = 0; r < 16; ++r) {
        const int c = (r & 3) + 8 * (r >> 2);
        if ((unsigned)(dq - c) >= W) p0[r] = NEG;
        if ((unsigned)(dq - c - 32) >= W) p1[r] = NEG;
    }
}
__device__ __forceinline__ void partialSM(f32x16& p0, f32x16& p1, float& m_reg, float& mn, float& alpha) {
    float pmax = p0[0];
#pragma unroll
    for (int r = 1; r < 16; ++r) pmax = fmaxf(pmax, p0[r]);
#pragma unroll
    for (int r = 0; r < 16; ++r) pmax = fmaxf(pmax, p1[r]);
    { auto rr = __builtin_amdgcn_permlane32_swap(__float_as_uint(pmax), __float_as_uint(pmax), false, false);
      pmax = fmaxf(__uint_as_float(rr[0]), __uint_as_float(rr[1])); }
    constexpr float C2 = 1.4426950408889634f * SM_SCALE;
    if (__builtin_expect(__all((pmax - m_reg) * SM_SCALE <= THR), 1)) { mn = m_reg; alpha = 1.f; }
    else { mn = fmaxf(m_reg, pmax); alpha = __builtin_amdgcn_exp2f((m_reg - mn) * C2); m_reg = mn; }
    const float mnL = -mn * C2;
#pragma unroll
    for (int r = 0; r < 16; ++r) p0[r] = fmaf(p0[r], C2, mnL);
#pragma unroll
    for (int r = 0; r < 16; ++r) p1[r] = fmaf(p1[r], C2, mnL);
#pragma unroll
    for (int r = 0; r < 16; ++r) p0[r] = __builtin_amdgcn_exp2f(p0[r]);
}
#define PK4(P, B_, OUT) do { unsigned a0 = cvtpk(P[B_+0], P[B_+1]), a1 = cvtpk(P[B_+2], P[B_+3]);                          \
        unsigned b0 = cvtpk(P[B_+4], P[B_+5]), b1 = cvtpk(P[B_+6], P[B_+7]);                                             \
        auto r0 = __builtin_amdgcn_permlane32_swap(a0, b0, false, false); auto r1 = __builtin_amdgcn_permlane32_swap(a1, b1, false, false); \
        u32x4 w = {r0[0], r1[0], r0[1], r1[1]}; OUT = *reinterpret_cast<bf16x8*>(&w); } while (0)
__device__ __forceinline__ void finishSM(f32x16& p0, f32x16& p1, float alpha, float& l_reg, bf16x8& pa0, bf16x8& pa1, bf16x8& pa2, bf16x8& pa3) {
#pragma unroll
    for (int r = 0; r < 16; ++r) p1[r] = __builtin_amdgcn_exp2f(p1[r]);
    float ps = 0;
#pragma unroll
    for (int r = 0; r < 16; ++r) ps += p0[r];
#pragma unroll
    for (int r = 0; r < 16; ++r) ps += p1[r];
    { auto rr = __builtin_amdgcn_permlane32_swap(__float_as_uint(ps), __float_as_uint(ps), false, false);
      ps = __uint_as_float(rr[0]) + __uint_as_float(rr[1]); }
    l_reg = l_reg * alpha + ps;
    PK4(p0, 0, pa0); PK4(p0, 8, pa1); PK4(p1, 0, pa2); PK4(p1, 8, pa3);
}
template <int KB, bool SK>
__device__ __forceinline__ void qkt(f32x16& p0, f32x16& p1, const char* K_lds, int r32, int hi, const bf16x8* qr, bool act) {
    if (SK && !act) return;
    p0 = f32x16{}; p1 = f32x16{};
    __builtin_amdgcn_s_setprio(1);
    const char* kb[4];
#pragma unroll
    for (int dd = 0; dd < 4; ++dd) kb[dd] = K_lds + KB * SHM_K + KSWZ(r32, (dd * 16 + hi * 8) * 2);
#pragma unroll
    for (int d0 = 0; d0 < 8; ++d0) { const char* a = kb[d0 & 3] + (d0 >> 2) * 128;
        bf16x8 b0 = *reinterpret_cast<const bf16x8*>(a);
        bf16x8 b1 = *reinterpret_cast<const bf16x8*>(a + 32 * 256);
        p0 = __builtin_amdgcn_mfma_f32_32x32x16_bf16(b0, qr[d0], p0, 0, 0, 0);
        p1 = __builtin_amdgcn_mfma_f32_32x32x16_bf16(b1, qr[d0], p1, 0, 0, 0); }
    __builtin_amdgcn_s_setprio(0);
}
template <int VB, bool SK>
__device__ __forceinline__ void pv_tile(f32x16* o, int vb0, bf16x8 pa0, bf16x8 pa1, bf16x8 pa2, bf16x8 pa3, bool act) {
    if (SK && !act) return;
#define TRRD(dst, off) asm volatile("ds_read_b64_tr_b16 %0, %1 offset:%2" : "=&v"(dst) : "v"(vb0), "i"(off) : "memory")
#define PV_D0(d0) do { s16x4 l0, l1, l2, l3, h0, h1, h2, h3; constexpr int b_ = VB * SHM_V + v_rd_off(d0, 0, 0); \
        TRRD(l0, b_); TRRD(h0, b_ + 2048); TRRD(l1, b_ + 4096); TRRD(h1, b_ + 6144); TRRD(l2, b_ + 8192); TRRD(h2, b_ + 10240); TRRD(l3, b_ + 12288); TRRD(h3, b_ + 14336); \
        asm volatile("s_waitcnt lgkmcnt(0)" ::: "memory"); SBAR();   \
        o[d0] = __builtin_amdgcn_mfma_f32_32x32x16_bf16(pa0, (bf16x8){l0[0], l0[1], l0[2], l0[3], h0[0], h0[1], h0[2], h0[3]}, o[d0], 0, 0, 0);   \
        o[d0] = __builtin_amdgcn_mfma_f32_32x32x16_bf16(pa1, (bf16x8){l1[0], l1[1], l1[2], l1[3], h1[0], h1[1], h1[2], h1[3]}, o[d0], 0, 0, 0);   \
        o[d0] = __builtin_amdgcn_mfma_f32_32x32x16_bf16(pa2, (bf16x8){l2[0], l2[1], l2[2], l2[3], h2[0], h2[1], h2[2], h2[3]}, o[d0], 0, 0, 0);   \
        o[d0] = __builtin_amdgcn_mfma_f32_32x32x16_bf16(pa3, (bf16x8){l3[0], l3[1], l3[2], l3[3], h3[0], h3[1], h3[2], h3[3]}, o[d0], 0, 0, 0); } while (0)
    __builtin_amdgcn_s_setprio(1); PV_D0(0); PV_D0(1); PV_D0(2); PV_D0(3); __builtin_amdgcn_s_setprio(0);
#undef PV_D0
#undef TRRD
}

__device__ __forceinline__ void pv_tile2(f32x16* o, f32x16* o2, int vb0, bf16x8 pa0, bf16x8 pa1, bf16x8 pa2, bf16x8 pa3) {
#define TRRD(dst, off) asm volatile("ds_read_b64_tr_b16 %0, %1 offset:%2" : "=&v"(dst) : "v"(vb0), "i"(off) : "memory")
#define PV2_D0(d0) do { s16x4 l0, l1, l2, l3, h0, h1, h2, h3, L0, L1, L2, L3, H0, H1, H2, H3; constexpr int b_ = v_rd_off(d0, 0, 0), c_ = SHM_V + v_rd_off(d0, 0, 0); \
        TRRD(l0, b_); TRRD(h0, b_ + 2048); TRRD(L0, c_); TRRD(H0, c_ + 2048); TRRD(l1, b_ + 4096); TRRD(h1, b_ + 6144); TRRD(L1, c_ + 4096); TRRD(H1, c_ + 6144); \
        TRRD(l2, b_ + 8192); TRRD(h2, b_ + 10240); TRRD(L2, c_ + 8192); TRRD(H2, c_ + 10240); TRRD(l3, b_ + 12288); TRRD(h3, b_ + 14336); TRRD(L3, c_ + 12288); TRRD(H3, c_ + 14336); \
        asm volatile("s_waitcnt lgkmcnt(0)" ::: "memory"); SBAR();   \
        o[d0]  = __builtin_amdgcn_mfma_f32_32x32x16_bf16(pa0, (bf16x8){l0[0], l0[1], l0[2], l0[3], h0[0], h0[1], h0[2], h0[3]}, o[d0], 0, 0, 0);   \
        o2[d0] = __builtin_amdgcn_mfma_f32_32x32x16_bf16(pa0, (bf16x8){L0[0], L0[1], L0[2], L0[3], H0[0], H0[1], H0[2], H0[3]}, o2[d0], 0, 0, 0);  \
        o[d0]  = __builtin_amdgcn_mfma_f32_32x32x16_bf16(pa1, (bf16x8){l1[0], l1[1], l1[2], l1[3], h1[0], h1[1], h1[2], h1[3]}, o[d0], 0, 0, 0);   \
        o2[d0] = __builtin_amdgcn_mfma_f32_32x32x16_bf16(pa1, (bf16x8){L1[0], L1[1], L1[2], L1[3], H1[0], H1[1], H1[2], H1[3]}, o2[d0], 0, 0, 0);  \
        o[d0]  = __builtin_amdgcn_mfma_f32_32x32x16_bf16(pa2, (bf16x8){l2[0], l2[1], l2[2], l2[3], h2[0], h2[1], h2[2], h2[3]}, o[d0], 0, 0, 0);   \
        o2[d0] = __builtin_amdgcn_mfma_f32_32x32x16_bf16(pa2, (bf16x8){L2[0], L2[1], L2[2], L2[3], H2[0], H2[1], H2[2], H2[3]}, o2[d0], 0, 0, 0);  \
        o[d0]  = __builtin_amdgcn_mfma_f32_32x32x16_bf16(pa3, (bf16x8){l3[0], l3[1], l3[2], l3[3], h3[0], h3[1], h3[2], h3[3]}, o[d0], 0, 0, 0);   \
        o2[d0] = __builtin_amdgcn_mfma_f32_32x32x16_bf16(pa3, (bf16x8){L3[0], L3[1], L3[2], L3[3], H3[0], H3[1], H3[2], H3[3]}, o2[d0], 0, 0, 0); } while (0)
    __builtin_amdgcn_s_setprio(1); PV2_D0(0); PV2_D0(1); PV2_D0(2); PV2_D0(3); __builtin_amdgcn_s_setprio(0);
#undef PV2_D0
#undef TRRD
}

struct BlockRef { const bf16_t* Q; const bf16_t* K; const bf16_t* V; bf16_t* O; int P0; const float* tb; const unsigned* sel; const bf16_t* V2; bf16_t* O2; };
struct Seam { bf16x8 qr[8]; bf16x8 st_v0, st_v1, st_k0, st_k1; };
__device__ __forceinline__ int swa_jlo(int P0, int W) { const int lowk = P0 - W + 1; return lowk > 0 ? lowk / KVBLK : 0; }
#define ROW(p, k0, rr) ((const bf16_t*)((const char*)((p) + (size_t)((k0) + ((rr) - sr)) * D) + loff))
#define VMW() asm volatile("s_waitcnt vmcnt(0)" ::: "memory")
#define VMWN(n) asm volatile("s_waitcnt vmcnt(%0)" :: "i"(n) : "memory")
#define SLOAD_H(Kp, Vp, k0) do { S.st_v0 = load8(ROW(Vp, k0, sr)); S.st_v1 = load8(ROW(Vp, k0, 32 + sr));              \
                         S.st_k0 = load8(ROW(Kp, k0, sr)); S.st_k1 = load8(ROW(Kp, k0, 32 + sr)); } while (0)
#define SWRITE_HK(bf) do { *(bf16x8*)(K_lds + (bf) * SHM_K + kws) = S.st_k0; *(bf16x8*)(K_lds + (bf) * SHM_K + kws + 32 * 256) = S.st_k1; } while (0)
#define SWRITE_HV(bf) do { *(bf16x8*)(V_lds + (bf) * SHM_V + vst0) = S.st_v0; *(bf16x8*)(V_lds + (bf) * SHM_V + vst1) = S.st_v1; } while (0)
#define SWRITE_H(bf) do { SWRITE_HV(bf); SWRITE_HK(bf); } while (0)
template <int MODE> __device__ __forceinline__ int mode_w() { return MODE == 1 ? 512 : (1 << 30); }
template <int MODE> __device__ __forceinline__ size_t qrow_off(int wid, int r) { return MODE == 2 ? ((size_t)(r >> 3) * SEQ + wid * 8 + (r & 7)) * D : (size_t)(wid * QBLK + r) * D; }
__device__ __forceinline__ void sel_stage(const BlockRef& b, char* lds, int par, int wid) {
    const int tid = wid * 64 + lane_id();
    if (tid < 128) { const u32x4 w = *(const u32x4*)(b.sel + (size_t)(b.P0 + (tid >> 1)) * 8 + (tid & 1) * 4);
        *(u32x4*)(lds + LDS_SEL + par * 2048 + (tid >> 1) * 32 + (tid & 1) * 16) = w; }
}
template <int MODE>
__device__ __forceinline__ void attn_prime(const BlockRef& cur, char* lds, Seam& S, int par, const int wid) {
    const int W = mode_w<MODE>();
    const int lane = lane_id(), tid = wid * 64 + lane, r32 = lane & 31, hi = lane >> 5;
    const int sr = tid >> 4, sc = (tid & 15) * 8, kws = KSWZ(sr, sc * 2); char* K_lds = lds + 2 * SHM_V;
    const unsigned loff = (unsigned)(sr * D + sc) * 2u;
    const int kb0 = swa_jlo(cur.P0, W) * KVBLK;
#pragma unroll
    for (int d0 = 0; d0 < 8; ++d0) S.qr[d0] = load8(cur.Q + qrow_off<MODE>(wid, r32) + d0 * 16 + hi * 8);
    if (MODE == 2) sel_stage(cur, lds, par, wid);
    SLOAD_H(cur.K, cur.V, kb0); VMW(); SWRITE_HK(0);
    __syncthreads();
}
template <int MODE>
__device__ __forceinline__ void attn_block(const BlockRef& cur, const BlockRef& nxt, char* lds, Seam& S, int par, const int wid) {
    constexpr bool SK = MODE == 2;
    const int W = mode_w<MODE>();
    const int lane = lane_id(), tid = wid * 64 + lane, r32 = lane & 31, hi = lane >> 5;
    const int j_lo = swa_jlo(cur.P0, W);
    constexpr int WROWS = MODE == 2 ? 8 : QBLK, BROWS = MODE == 2 ? 64 : QB;
    const int j_hi = (cur.P0 + BROWS - 1) / KVBLK + 1;
    const int NT = j_hi - j_lo;
    const int kbn = swa_jlo(nxt.P0, W) * KVBLK;
    const int qlo = cur.P0 + wid * WROWS, qm = qlo + (MODE == 2 ? (r32 & 7) : r32) - 4 * hi;
    char* V_lds = lds; char* K_lds = lds + 2 * SHM_V;
    float* ws = (float*)(lds + 2 * SHM_V + 2 * SHM_K) + wid * 64; float* li_l = ws, * al_l = ws + 32;
    const float* tb = cur.tb + (MODE == 2 ? (r32 >> 3) * TBXN : 0);
    const unsigned* selrow = (const unsigned*)(lds + LDS_SEL + par * 2048) + (wid * 8 + (r32 & 7)) * 8;
    unsigned selw = 0u;
    float m_reg = -1e30f, l_reg = 0; f32x16 o[4] = {};
    const int sr = tid >> 4, sc = (tid & 15) * 8, vst0 = v_st(sr, sc), vst1 = v_st(32 + sr, sc), kws = KSWZ(sr, sc * 2);
    const unsigned loff = (unsigned)(sr * D + sc) * 2u;
    const int vb0 = (int)(uintptr_t)V_lds + v_rd_base(lane);
    const bf16_t* Kh = cur.K; const bf16_t* Vh = cur.V;
#define RESC(a) do { if (__any((a) < 1.f)) { if (hi == 0) al_l[r32] = (a); asm volatile("s_waitcnt lgkmcnt(0)" ::: "memory");              \
                     for (int d_ = 0; d_ < 4; ++d_) for (int r = 0; r < 16; ++r) o[d_][r] *= al_l[crow(r, hi)]; } } while (0)
#define KBASE(t) ((j_lo + (t)) * KVBLK)
#define GEOACT(t) (KBASE(t) <= qlo + WROWS - 1 && KBASE(t) + KVBLK - 1 >= qlo - W + 1)
#define SETACT(actX, bitX, t) do { if (MODE == 2) { const int j_ = j_lo + (t); if ((j_ & 31) == 0 || (t) == 0) selw = selrow[j_ >> 5]; \
                                   actX = GEOACT(t) && __any(((selw >> (j_ & 31)) & 1u) != 0u); } else { actX = GEOACT(t); } } while (0)
#define MASKT(P0_, P1_, actX, bitX, t) do { const int kb_ = KBASE(t); if (!SK || actX) {                                             \
        if (kb_ + KVBLK - 1 + BAND > qlo) bias_mask_tile(P0_, P1_, qm - kb_, (unsigned)W, tb);                                        \
        else if (MODE == 1 && kb_ <= qlo + WROWS - 1 - W) mask_tile(P0_, P1_, qm - kb_, (unsigned)W);                                  \
        if (MODE == 2) { if (((selw >> ((j_lo + (t)) & 31)) & 1u) == 0u) { const float NEG_ = -__builtin_inff(); _Pragma("unroll") for (int r_ = 0; r_ < 16; ++r_) { P0_[r_] = NEG_; P1_[r_] = NEG_; } } } } } while (0)
    constexpr int NQL = 8;
#define SEAM_K0() do { VMWN(NQL); SWRITE_HK(0); SBAR(); } while (0)
    f32x16 pA0, pA1, pB0, pB1; float mnA, mnB, alA, alB; bf16x8 pa0, pa1, pa2, pa3;
    bool actA = true, actB = true; unsigned bitA = 1u, bitB = 1u;
    SWRITE_HV(0); SBAR();
    if (NT > 1) { SLOAD_H(Kh, Vh, KBASE(1)); }
    SETACT(actA, bitA, 0);
    SBAR(); qkt<0, SK>(pA0, pA1, K_lds, r32, hi, S.qr, actA);
    if (!SK || actA) { MASKT(pA0, pA1, actA, bitA, 0); partialSM(pA0, pA1, m_reg, mnA, alA); } else alA = 1.f;
    if (NT > 1) { VMW(); SWRITE_H(1); }
    __syncthreads();
#define HALF_STEP(PX0, PX1, mnX, alX, actX, bitX, PY0, PY1, alY, actY, t, KB, VB, SB) do {                                    \
        SETACT(actX, bitX, t);                                                                                                \
        SBAR(); qkt<KB, SK>(PX0, PX1, K_lds, r32, hi, S.qr, actX);                                                            \
        if (!SK || actY) finishSM(PY0, PY1, alY, l_reg, pa0, pa1, pa2, pa3); SBAR();                                          \
        if ((t) + 1 < NT) { SLOAD_H(Kh, Vh, KBASE((t) + 1)); SBAR(); }                                                        \
        pv_tile<VB, SK>(o, vb0, pa0, pa1, pa2, pa3, actY);                                                                    \
        if (!SK || actX) { MASKT(PX0, PX1, actX, bitX, (t)); partialSM(PX0, PX1, m_reg, mnX, alX); } else alX = 1.f;          \
        __syncthreads();                                                                                                      \
        if ((t) + 1 < NT) { VMW(); SWRITE_H(SB); }                                                                            \
        RESC(alX); __syncthreads(); } while (0)
    for (int t = 1; t + 1 < NT; t += 2) {
        HALF_STEP(pB0, pB1, mnB, alB, actB, bitB, pA0, pA1, alA, actA, t, 1, 0, 0);
        HALF_STEP(pA0, pA1, mnA, alA, actA, bitA, pB0, pB1, alB, actB, t + 1, 0, 1, 1);
    }
    const bool even = (NT & 1) == 0;
    if (even) { SETACT(actB, bitB, NT - 1); SBAR(); qkt<1, SK>(pB0, pB1, K_lds, r32, hi, S.qr, actB); SBAR(); }
    SLOAD_H(nxt.K, nxt.V, kbn); SBAR();
#pragma unroll
    for (int d0 = 0; d0 < 8; ++d0) S.qr[d0] = load8(nxt.Q + qrow_off<MODE>(wid, r32) + d0 * 16 + hi * 8);
    SBAR();
    if (!SK || actA) finishSM(pA0, pA1, alA, l_reg, pa0, pa1, pa2, pa3); SBAR();
    pv_tile<0, SK>(o, vb0, pa0, pa1, pa2, pa3, actA);
    if (even) { if (!SK || actB) { MASKT(pB0, pB1, actB, bitB, NT - 1); partialSM(pB0, pB1, m_reg, mnB, alB); } else alB = 1.f; __syncthreads(); RESC(alB);
        if (!SK || actB) finishSM(pB0, pB1, alB, l_reg, pa0, pa1, pa2, pa3); SBAR(); pv_tile<1, SK>(o, vb0, pa0, pa1, pa2, pa3, actB); }
    SBAR(); SEAM_K0();
    if (hi == 0) li_l[r32] = l_reg; asm volatile("s_waitcnt lgkmcnt(0)" ::: "memory");
    float rli[16];
#pragma unroll
    for (int r = 0; r < 16; ++r) rli[r] = __builtin_amdgcn_rcpf(li_l[crow(r, hi)]);
#pragma unroll
    for (int r = 0; r < 16; ++r) { const int orow = crow(r, hi); bf16_t* Ow = cur.O + qrow_off<MODE>(wid, orow) - (size_t)orow * D;
#pragma unroll
        for (int d0 = 0; d0 < 4; ++d0) { const float v = o[d0][r] * rli[r];
            const float vn = xor1_(v);
            if ((r32 & 1) == 0) *(unsigned*)(Ow + (size_t)orow * D + d0 * 32 + r32) = cvtpk(v, vn); } }
    if (MODE == 2) sel_stage(nxt, lds, par ^ 1, wid);
    __syncthreads();
#undef RESC
#undef KBASE
#undef GEOACT
#undef SETACT
#undef MASKT
#undef SEAM_K0
#undef HALF_STEP
}
}


namespace att {
constexpr int A2_V = 0, A2_K = 3 * SHM_V, A2_WS = A2_K + 2 * SHM_K;
constexpr int A2_TBX = A2_WS + NW * 64 * 4;
constexpr int A2D_TBX = 3 * 2 * SHM_V + 2 * SHM_K + NW * 64 * 4;
constexpr int A2_SEL = A2_TBX + 12 * TBXN * 4;
__device__ __forceinline__ int swap23(int k) { return (k & ~0xC) | ((k & 4) << 1) | ((k & 8) >> 1); }
template <int MODE, bool DV2>
__device__ __forceinline__ void attn_block2(const BlockRef& cur, char* lds, const int wid) {
    constexpr int VST = DV2 ? 2 * SHM_V : SHM_V;
    constexpr int A2K = 3 * VST, A2WS = A2K + 2 * SHM_K, A2SEL = A2WS + NW * 64 * 4 + 12 * TBXN * 4;
    constexpr bool SK = MODE == 2;
    const int W = mode_w<MODE>();
    const int lane = lane_id(), tid = wid * 64 + lane, r32 = lane & 31, hi = lane >> 5;
    constexpr int WROWS = MODE == 2 ? 8 : QBLK, BROWS = MODE == 2 ? 64 : QB;
    const int j_lo = swa_jlo(cur.P0, W);
    const int j_hi = (cur.P0 + BROWS - 1) / KVBLK + 1;
    const int NT = j_hi - j_lo;
    const int qlo = cur.P0 + wid * WROWS, qm = qlo + (MODE == 2 ? (r32 & 7) : r32) - 4 * hi;
    char* V_lds = lds + A2_V; char* K_lds = lds + A2K;
    float* ws = (float*)(lds + A2WS) + wid * 64; float* li_l = ws, * al_l = ws + 32;
    const float* tb = cur.tb + (MODE == 2 ? (r32 >> 3) * TBXN : 0);
    const unsigned* selrow = (const unsigned*)(lds + A2SEL) + (wid * 8 + (r32 & 7)) * 8;
    unsigned selw = 0u;
    unsigned kgo[2], vgo[2];
#pragma unroll
    for (int i = 0; i < 2; ++i) { const int pc = 2 * wid + i;
        const int row = 4 * pc + (lane >> 4), c = (lane & 15) ^ (row & 7); kgo[i] = (unsigned)(row * 256 + c * 16);
        const int sub = 2 * pc + (lane >> 5), kk = (sub >> 2) * 8 + ((lane & 31) >> 2), k = swap23(kk), cc = (sub & 3) * 32 + (lane & 3) * 8; vgo[i] = (unsigned)(k * 256 + cc * 2); }
    bf16x8 qr[8];
#pragma unroll
    for (int d0 = 0; d0 < 8; ++d0) qr[d0] = load8(cur.Q + qrow_off<MODE>(wid, r32) + d0 * 16 + hi * 8);
    if (MODE == 2) { if (tid < 128) { const u32x4 w = *(const u32x4*)(cur.sel + (size_t)(cur.P0 + (tid >> 1)) * 8 + (tid & 1) * 4);
        *(u32x4*)(lds + A2SEL + (tid >> 1) * 32 + (tid & 1) * 16) = w; } }
    LAS unsigned char* ldsl = (LAS unsigned char*)lds;
    const char* Kg = (const char*)cur.K; const char* Vg = (const char*)cur.V; const char* Vg2 = (const char*)cur.V2;
#define A2_DMA(t_) do { const int t__ = (t_); const size_t go_ = (size_t)(j_lo + t__) * (KVBLK * D * 2);                                           \
        LAS unsigned char* kd_ = ldsl + A2K + (t__ & 1) * SHM_K + wid * 2048; LAS unsigned char* vd_ = ldsl + A2_V + (t__ % 3) * VST + wid * 2048;      \
        _Pragma("unroll") for (int i_ = 0; i_ < 2; ++i_) {                                                                                         \
            __builtin_amdgcn_global_load_lds((const unsigned*)(Kg + go_ + kgo[i_]), (LAS unsigned*)(kd_ + i_ * 1024), 16, 0, 0);                  \
            __builtin_amdgcn_global_load_lds((const unsigned*)(Vg + go_ + vgo[i_]), (LAS unsigned*)(vd_ + i_ * 1024), 16, 0, 0);                  \
            if (DV2) __builtin_amdgcn_global_load_lds((const unsigned*)(Vg2 + go_ + vgo[i_]), (LAS unsigned*)(vd_ + SHM_V + i_ * 1024), 16, 0, 0); } } while (0)
#define A2_BAR() do { asm volatile("s_waitcnt vmcnt(0) lgkmcnt(0)" ::: "memory"); __builtin_amdgcn_s_barrier(); asm volatile("" ::: "memory"); } while (0)
    A2_DMA(0);
    A2_BAR();
    float m_reg = -1e30f, l_reg = 0; f32x16 o[4] = {}; f32x16 o2[DV2 ? 4 : 1] = {};
    const int vbase = (int)(uintptr_t)V_lds + v_rd_base(lane);
#define RESC(a) do { if (__any((a) < 1.f)) { if (hi == 0) al_l[r32] = (a); asm volatile("s_waitcnt lgkmcnt(0)" ::: "memory");              \
                     for (int d_ = 0; d_ < 4; ++d_) for (int r = 0; r < 16; ++r) { const float f_ = al_l[crow(r, hi)]; o[d_][r] *= f_; if (DV2) o2[d_][r] *= f_; } } } while (0)
#define KBASE(t) ((j_lo + (t)) * KVBLK)
#define GEOACT(t) (KBASE(t) <= qlo + WROWS - 1 && KBASE(t) + KVBLK - 1 >= qlo - W + 1)
#define SETACT(actX, t) do { if (MODE == 2) { const int j_ = j_lo + (t); if ((j_ & 31) == 0 || (t) == 0) selw = selrow[j_ >> 5]; \
                                   actX = GEOACT(t) && __any(((selw >> (j_ & 31)) & 1u) != 0u); } else { actX = GEOACT(t); } } while (0)
#define MASKT(P0_, P1_, t) do { const int kb_ = KBASE(t);                                                                             \
        if (kb_ + KVBLK - 1 + BAND > qlo) bias_mask_tile(P0_, P1_, qm - kb_, (unsigned)W, tb);                                        \
        else if (MODE == 1 && kb_ <= qlo + WROWS - 1 - W) mask_tile(P0_, P1_, qm - kb_, (unsigned)W);                                  \
        if (MODE == 2) { if (((selw >> ((j_lo + (t)) & 31)) & 1u) == 0u) { const float NEG_ = -__builtin_inff(); _Pragma("unroll") for (int r_ = 0; r_ < 16; ++r_) { P0_[r_] = NEG_; P1_[r_] = NEG_; } } } } while (0)
    f32x16 pA0, pA1, pB0, pB1; float mnA, mnB, alA = 1.f, alB = 1.f; bf16x8 pa0, pa1, pa2, pa3;
    bool actA = true, actB = true;
    if (NT > 1) A2_DMA(1);
    SETACT(actA, 0);
    SBAR(); qkt<0, SK>(pA0, pA1, K_lds, r32, hi, qr, actA);
    if (!SK || actA) { MASKT(pA0, pA1, 0); partialSM(pA0, pA1, m_reg, mnA, alA); } else alA = 1.f;
    A2_BAR();
#define STEP2(PX0, PX1, mnX, alX, actX, PY0, PY1, alY, actY, t) do {                                                          \
        if ((t) + 1 < NT) A2_DMA((t) + 1);                                                                                    \
        SETACT(actX, t);                                                                                                      \
        SBAR(); qkt<0, SK>(PX0, PX1, K_lds + ((t) & 1) * SHM_K, r32, hi, qr, actX);                                           \
        if (!SK || actY) finishSM(PY0, PY1, alY, l_reg, pa0, pa1, pa2, pa3); SBAR();                                          \
        pv_tile<0, SK>(o, vbase + (((t) - 1) % 3) * VST, pa0, pa1, pa2, pa3, actY);                                           \
        if (DV2) pv_tile<0, SK>(o2, vbase + (((t) - 1) % 3) * VST + SHM_V, pa0, pa1, pa2, pa3, actY);                         \
        if (!SK || actX) { MASKT(PX0, PX1, (t)); partialSM(PX0, PX1, m_reg, mnX, alX); } else alX = 1.f;                      \
        RESC(alX);                                                                                                            \
        A2_BAR(); } while (0)
    int t = 1;
    for (; t + 1 < NT; t += 2) {
        STEP2(pB0, pB1, mnB, alB, actB, pA0, pA1, alA, actA, t);
        STEP2(pA0, pA1, mnA, alA, actA, pB0, pB1, alB, actB, t + 1);
    }
    if (t < NT) {
        STEP2(pB0, pB1, mnB, alB, actB, pA0, pA1, alA, actA, t);
        if (!SK || actB) finishSM(pB0, pB1, alB, l_reg, pa0, pa1, pa2, pa3); SBAR();
        pv_tile<0, SK>(o, vbase + ((NT - 1) % 3) * VST, pa0, pa1, pa2, pa3, actB);
        if (DV2) pv_tile<0, SK>(o2, vbase + ((NT - 1) % 3) * VST + SHM_V, pa0, pa1, pa2, pa3, actB);
    } else {
        if (!SK || actA) finishSM(pA0, pA1, alA, l_reg, pa0, pa1, pa2, pa3); SBAR();
        pv_tile<0, SK>(o, vbase + ((NT - 1) % 3) * VST, pa0, pa1, pa2, pa3, actA);
        if (DV2) pv_tile<0, SK>(o2, vbase + ((NT - 1) % 3) * VST + SHM_V, pa0, pa1, pa2, pa3, actA);
    }
    if (hi == 0) li_l[r32] = l_reg; asm volatile("s_waitcnt lgkmcnt(0)" ::: "memory");
    float rli[16];
#pragma unroll
    for (int r = 0; r < 16; ++r) rli[r] = __builtin_amdgcn_rcpf(li_l[crow(r, hi)]);
#pragma unroll
    for (int r = 0; r < 16; ++r) { const int orow = crow(r, hi); bf16_t* Ow = cur.O + qrow_off<MODE>(wid, orow);
#pragma unroll
        for (int d0 = 0; d0 < 4; ++d0) { const float v = o[d0][r] * rli[r];
            const float vn = xor1_(v);
            if ((r32 & 1) == 0) *(unsigned*)(Ow + d0 * 32 + r32) = cvtpk(v, vn);
            if (DV2) { const float v2 = o2[d0][r] * rli[r]; const float vn2 = xor1_(v2);
                if ((r32 & 1) == 0) *(unsigned*)(cur.O2 + qrow_off<MODE>(wid, orow) + d0 * 32 + r32) = cvtpk(v2, vn2); } } }
    A2_BAR();
#undef A2_DMA
#undef A2_BAR
#undef RESC
#undef KBASE
#undef GEOACT
#undef SETACT
#undef MASKT
#undef STEP2
}
}


namespace att {
constexpr int A3_V = 0, A3_K = 2 * 2 * SHM_V, A3_WS = A3_K + 2 * SHM_K;
constexpr int A3_TBX = A3_WS + NW * 64 * 4;
__device__ __forceinline__ void attn_block3(const BlockRef& cur, char* lds, const int wid) {
    const int lane = lane_id(), r32 = lane & 31, hi = lane >> 5;
    const int NT = (cur.P0 + QB - 1) / KVBLK + 1;
    const int qlo = cur.P0 + wid * QBLK, qm = qlo + r32 - 4 * hi;
    char* V_lds = lds + A3_V; char* K_lds = lds + A3_K;
    float* ws = (float*)(lds + A3_WS) + wid * 64; float* li_l = ws, * al_l = ws + 32;
    const float* tb = cur.tb;
    unsigned kgo[2], vgo[2];
#pragma unroll
    for (int i = 0; i < 2; ++i) { const int pc = 2 * wid + i;
        const int row = 4 * pc + (lane >> 4), c = (lane & 15) ^ (row & 7); kgo[i] = (unsigned)(row * 256 + c * 16);
        const int sub = 2 * pc + (lane >> 5), kk = (sub >> 2) * 8 + ((lane & 31) >> 2), k = swap23(kk), cc = (sub & 3) * 32 + (lane & 3) * 8; vgo[i] = (unsigned)(k * 256 + cc * 2); }
    bf16x8 qr[8];
#pragma unroll
    for (int d0 = 0; d0 < 8; ++d0) qr[d0] = load8(cur.Q + (size_t)(wid * QBLK + r32) * D + d0 * 16 + hi * 8);
    LAS unsigned char* ldsl = (LAS unsigned char*)lds;
    const char* Kg = (const char*)cur.K; const char* Vg = (const char*)cur.V; const char* Vg2 = (const char*)cur.V2;
#define A3_DMA(t_) do { const int t__ = (t_); const size_t go_ = (size_t)t__ * (KVBLK * D * 2);                                                   \
        LAS unsigned char* kd_ = ldsl + A3_K + (t__ & 1) * SHM_K + wid * 2048; LAS unsigned char* vd_ = ldsl + A3_V + (t__ & 1) * 2 * SHM_V + wid * 2048; \
        _Pragma("unroll") for (int i_ = 0; i_ < 2; ++i_) {                                                                                         \
            __builtin_amdgcn_global_load_lds((const unsigned*)(Kg + go_ + kgo[i_]), (LAS unsigned*)(kd_ + i_ * 1024), 16, 0, 0);                  \
            __builtin_amdgcn_global_load_lds((const unsigned*)(Vg + go_ + vgo[i_]), (LAS unsigned*)(vd_ + i_ * 1024), 16, 0, 0);                  \
            __builtin_amdgcn_global_load_lds((const unsigned*)(Vg2 + go_ + vgo[i_]), (LAS unsigned*)(vd_ + SHM_V + i_ * 1024), 16, 0, 0); } } while (0)
#define A3_BAR() do { asm volatile("s_waitcnt vmcnt(0) lgkmcnt(0)" ::: "memory"); __builtin_amdgcn_s_barrier(); asm volatile("" ::: "memory"); } while (0)
    A3_DMA(0);
    A3_BAR();
    float m_reg = -1e30f, l_reg = 0; f32x16 o[4] = {}, o2[4] = {};
    const int vbase = (int)(uintptr_t)V_lds + v_rd_base(lane);
    for (int t = 0; t < NT; ++t) {
        f32x16 p0, p1; float mn, alpha; bf16x8 pa0, pa1, pa2, pa3;
        const int kb = t * KVBLK;
        qkt<0, false>(p0, p1, K_lds + (t & 1) * SHM_K, r32, hi, qr, true);
        SBAR(); if (t + 1 < NT) A3_DMA(t + 1);
        SBAR();
        if (kb + KVBLK - 1 + BAND > qlo) bias_mask_tile(p0, p1, qm - kb, 1u << 30, tb);
        partialSM(p0, p1, m_reg, mn, alpha);
        if (__any(alpha < 1.f)) { if (hi == 0) al_l[r32] = alpha; asm volatile("s_waitcnt lgkmcnt(0)" ::: "memory");
#pragma unroll
            for (int d_ = 0; d_ < 4; ++d_)
#pragma unroll
                for (int r = 0; r < 16; ++r) { const float f_ = al_l[crow(r, hi)]; o[d_][r] *= f_; o2[d_][r] *= f_; } }
        finishSM(p0, p1, alpha, l_reg, pa0, pa1, pa2, pa3); SBAR();
        pv_tile2(o, o2, vbase + (t & 1) * 2 * SHM_V, pa0, pa1, pa2, pa3);
        A3_BAR();
    }
    if (hi == 0) li_l[r32] = l_reg; asm volatile("s_waitcnt lgkmcnt(0)" ::: "memory");
#pragma unroll
    for (int r = 0; r < 16; ++r) { const int orow = crow(r, hi); const float rli = __builtin_amdgcn_rcpf(li_l[orow]);
        const size_t ro = (size_t)(wid * QBLK + orow) * D;
#pragma unroll
        for (int d0 = 0; d0 < 4; ++d0) { const float v = o[d0][r] * rli, v2 = o2[d0][r] * rli; const float vn = xor1_(v), vn2 = xor1_(v2);
            if ((r32 & 1) == 0) { *(unsigned*)(cur.O + ro + d0 * 32 + r32) = cvtpk(v, vn); *(unsigned*)(cur.O2 + ro + d0 * 32 + r32) = cvtpk(v2, vn2); } } }
    A3_BAR();
#undef A3_DMA
#undef A3_BAR
}
}

namespace att {
__device__ __forceinline__ void cmp_bias_mask(f32x16& p0, f32x16& p1, int dq16, const float* tb) {
    const float NEG = -__builtin_inff();
#pragma unroll
    for (int r = 0; r < 16; ++r) {
        const int c = (r & 3) + 8 * (r >> 2);
        const int r0 = dq16 - 16 * c, r1 = dq16 - 16 * (c + 32);
        const float b0 = tb[(unsigned)r0 < 127u ? r0 : 127], b1 = tb[(unsigned)r1 < 127u ? r1 : 127];
        p0[r] = r0 < 0 ? NEG : p0[r] + b0;
        p1[r] = r1 < 0 ? NEG : p1[r] + b1;
    }
}
__device__ __forceinline__ void cmp_item(char* lds, unsigned char* wsb, float* d_oc_, int b, int g, int qb, const int wid) {
    constexpr float C2 = 1.4426950408889634f * SM_SCALE;
    const int lane = lane_id(), tid = wid * 64 + lane, r32 = lane & 31, hi = lane >> 5;
    const int t0 = qb * 64, head = r32 >> 3, ql = r32 & 7, h = g * 4 + head, t = t0 + wid * 8 + ql;
    const bf16_t* Q = (const bf16_t*)(wsb + WS_QN) + ((size_t)(b * 8 + h) * SEQ + t) * 128;
    const bf16_t* Kc = (const bf16_t*)(wsb + WS_KCMP) + (size_t)(b * 2 + g) * 1024 * 128;
    const bf16_t* Vc = (const bf16_t*)(wsb + WS_VCMP) + (size_t)(b * 2 + g) * 1024 * 128;
    char* V_lds = lds; char* K_lds = lds + 2 * SHM_V;
    float* pslc = (float*)(lds + LDS_PSLC);
    const float* tb = (const float*)(lds + LDS_TB) + h * 128;
    const int sr = tid >> 4, sc = (tid & 15) * 8, vst0 = v_st(sr, sc), vst1 = v_st(32 + sr, sc), kws = KSWZ(sr, sc * 2);
    const int vb0 = (int)(uintptr_t)V_lds + v_rd_base(lane);
    bf16x8 qr[8];
#pragma unroll
    for (int d0 = 0; d0 < 8; ++d0) qr[d0] = load8(Q + d0 * 16 + hi * 8);
    int nk = t0 / 16 + 3; if (nk > 1024) nk = 1024;
    const int NT = (nk + 63) >> 6;
    constexpr int PSS = 257;
    for (int i = tid; i < 64 * PSS; i += 512) pslc[i] = 0.f;
    float m = -1e30f, l = 0.f;
    bf16x8 k0 = load8(Kc + (size_t)sr * 128 + sc), k1 = load8(Kc + (size_t)(32 + sr) * 128 + sc), v0, v1;
#ifdef PROBE_CA
    for (int rp_ = 0; rp_ < 2; ++rp_) { m = -1e30f; l = 0.f;
#endif
    for (int j = 0; j < NT; ++j) {
        __syncthreads();
        *(bf16x8*)(K_lds + kws) = k0; *(bf16x8*)(K_lds + kws + 32 * 256) = k1;
        __syncthreads();
        { const int jn = j + 1 < NT ? j + 1 : 0;
          k0 = load8(Kc + (size_t)(64 * jn + sr) * 128 + sc); k1 = load8(Kc + (size_t)(64 * jn + 32 + sr) * 128 + sc); }
        f32x16 p0, p1;
        qkt<0, false>(p0, p1, K_lds, r32, hi, qr, true);
        if (1024 * j + 1152 > t0 + wid * 8) cmp_bias_mask(p0, p1, t - 31 - 16 * (64 * j + 4 * hi), tb);
        float pmax = p0[0];
#pragma unroll
        for (int r = 1; r < 16; ++r) pmax = fmaxf(pmax, p0[r]);
#pragma unroll
        for (int r = 0; r < 16; ++r) pmax = fmaxf(pmax, p1[r]);
        { auto rr = __builtin_amdgcn_permlane32_swap(__float_as_uint(pmax), __float_as_uint(pmax), false, false);
          pmax = fmaxf(__uint_as_float(rr[0]), __uint_as_float(rr[1])); }
        const float mn = fmaxf(m, pmax), mnL = -mn * C2;
        float ps = 0.f;
#pragma unroll
        for (int r = 0; r < 16; ++r) ps += __builtin_amdgcn_exp2f(fmaf(p0[r], C2, mnL)) + __builtin_amdgcn_exp2f(fmaf(p1[r], C2, mnL));
        { auto rr = __builtin_amdgcn_permlane32_swap(__float_as_uint(ps), __float_as_uint(ps), false, false);
          ps = __uint_as_float(rr[0]) + __uint_as_float(rr[1]); }
        l = l * __builtin_amdgcn_exp2f((m - mn) * C2) + ps; m = mn;
    }
#ifdef PROBE_CA
    }
#endif
    const float rl = l > 0.f ? 1.f / l : 0.f, mL = -m * C2;
    float pend = 0.f;
    f32x16 o[4] = {};
    v0 = load8(Vc + (size_t)sr * 128 + sc); v1 = load8(Vc + (size_t)(32 + sr) * 128 + sc);
#ifdef PROBE_CB
    for (int rp_ = 0; rp_ < 2; ++rp_) {
    if (rp_) { __syncthreads(); for (int i = tid; i < 64 * PSS; i += 512) pslc[i] = 0.f;
#pragma unroll
        for (int d_ = 0; d_ < 4; ++d_) o[d_] = f32x16{};
        k0 = load8(Kc + (size_t)sr * 128 + sc); k1 = load8(Kc + (size_t)(32 + sr) * 128 + sc); v0 = load8(Vc + (size_t)sr * 128 + sc); v1 = load8(Vc + (size_t)(32 + sr) * 128 + sc); }
#endif
    for (int j = 0; j < NT; ++j) {
        __syncthreads();
        *(bf16x8*)(K_lds + kws) = k0; *(bf16x8*)(K_lds + kws + 32 * 256) = k1;
        *(bf16x8*)(V_lds + vst0) = v0; *(bf16x8*)(V_lds + vst1) = v1;
        __syncthreads();
        if (j + 1 < NT) { k0 = load8(Kc + (size_t)(64 * (j + 1) + sr) * 128 + sc); k1 = load8(Kc + (size_t)(64 * (j + 1) + 32 + sr) * 128 + sc);
                          v0 = load8(Vc + (size_t)(64 * (j + 1) + sr) * 128 + sc); v1 = load8(Vc + (size_t)(64 * (j + 1) + 32 + sr) * 128 + sc); }
        f32x16 p0, p1;
        qkt<0, false>(p0, p1, K_lds, r32, hi, qr, true);
        if (1024 * j + 1152 > t0 + wid * 8) cmp_bias_mask(p0, p1, t - 31 - 16 * (64 * j + 4 * hi), tb);
#pragma unroll
        for (int r = 0; r < 16; ++r) { p0[r] = __builtin_amdgcn_exp2f(fmaf(p0[r], C2, mL)) * rl; p1[r] = __builtin_amdgcn_exp2f(fmaf(p1[r], C2, mL)) * rl; }
        float own[8], a1[8];
#pragma unroll
        for (int gi = 0; gi < 8; ++gi) {
            float a = gi < 4 ? p0[4 * gi] : p1[4 * (gi - 4)];
            float bs = gi < 4 ? (p0[4 * gi + 1] + p0[4 * gi + 2] + p0[4 * gi + 3]) : (p1[4 * (gi - 4) + 1] + p1[4 * (gi - 4) + 2] + p1[4 * (gi - 4) + 3]);
            float ow = a + 2.f * bs;
            ow += __int_as_float(__builtin_amdgcn_update_dpp(0, __float_as_int(ow), 0x128, 0xf, 0xf, false));
            a  += __int_as_float(__builtin_amdgcn_update_dpp(0, __float_as_int(a), 0x128, 0xf, 0xf, false));
            { auto rr = __builtin_amdgcn_permlane16_swap(__float_as_uint(ow), __float_as_uint(ow), false, false); ow = __uint_as_float(rr[0]) + __uint_as_float(rr[1]); }
            { auto rr = __builtin_amdgcn_permlane16_swap(__float_as_uint(a), __float_as_uint(a), false, false); a = __uint_as_float(rr[0]) + __uint_as_float(rr[1]); }
            own[gi] = ow; a1[gi] = a;
        }
        {
            float* prow = pslc + (wid * 8 + ql) * PSS + 16 * j + hi;
            float T[8];
#pragma unroll
            for (int gi = 0; gi < 8; ++gi) {
                auto rr = __builtin_amdgcn_permlane32_swap(__float_as_uint(a1[gi]), __float_as_uint(a1[gi < 7 ? gi + 1 : 7]), false, false);
                T[gi] = own[gi] + (hi == 0 ? __uint_as_float(rr[1]) : __uint_as_float(rr[0]));
            }
            { auto r0 = __builtin_amdgcn_permlane32_swap(0u, __float_as_uint(a1[0]), false, false);
              if (j > 0 && hi == 1 && head == 3) prow[-2] = pend + __uint_as_float(r0[0]); }
            const float t0_ = head == 0 ? T[0] : (head == 1 ? T[2] : (head == 2 ? T[4] : T[6]));
            const float t1_ = head == 0 ? T[1] : (head == 1 ? T[3] : (head == 2 ? T[5] : T[7]));
            const int g0 = 2 * head, bo0 = 2 * (g0 & 3) + 8 * (g0 >> 2);
            prow[bo0] = t0_;
            if (!(head == 3 && hi == 1)) prow[bo0 + 2] = t1_;
            pend = own[7];
        }
        bf16x8 pa0, pa1, pa2, pa3;
        PK4(p0, 0, pa0); PK4(p0, 8, pa1); PK4(p1, 0, pa2); PK4(p1, 8, pa3);
        pv_tile<0, false>(o, vb0, pa0, pa1, pa2, pa3, true);
    }
#ifdef PROBE_CB
    }
#endif
    if (hi == 1 && head == 3) pslc[(wid * 8 + ql) * PSS + 16 * (NT - 1) + 15] = pend;
    bf16_t* OC = (bf16_t*)d_oc_;
#pragma unroll
    for (int r = 0; r < 16; ++r) { const int orow = crow(r, hi), hr = orow >> 3, qr_ = orow & 7;
        bf16_t* dst = OC + ((size_t)(b * 8 + g * 4 + hr) * SEQ + t0 + wid * 8 + qr_) * 128;
#pragma unroll
        for (int d0 = 0; d0 < 4; ++d0) { const float v = o[d0][r]; const float vn = xor1_(v);
            if ((r32 & 1) == 0) *(unsigned*)(dst + d0 * 32 + r32) = cvtpk(v, vn); } }
    __syncthreads();
    unsigned* SELM = (unsigned*)(wsb + WS_SELM) + ((size_t)(b * 2 + g) * SEQ + t0) * 8;
    for (int qi = 0; qi < 8; ++qi) {
        const int q = wid * 8 + qi, jt = qb;
        unsigned key[4];
#pragma unroll
        for (int i4 = 0; i4 < 4; ++i4) { const int blk = lane + 64 * i4;
            const bool forced = (blk == 0) | (blk == jt) | (blk == jt - 1);
            const float v = forced ? 1e30f : (blk > jt ? -1e30f : pslc[q * PSS + blk]);
            key[i4] = v < 0.f ? 0u : __float_as_uint(v) + 1u; }
        unsigned prefix = 0u; int need = 16, matches = 256, sh = 0;
        for (int bit = 31; bit >= 0; --bit) {
            const unsigned cand = (prefix | (1u << bit)) >> bit;
            int c = 0;
#pragma unroll
            for (int i4 = 0; i4 < 4; ++i4) c += __popcll(__ballot((key[i4] >> bit) == cand));
            if (c >= need) { prefix |= 1u << bit; matches = c; } else { need -= c; matches -= c; }
            if (matches == need) { sh = bit; break; }
        }
        const unsigned pfx = prefix >> sh;
        unsigned long long selm[4]; int seen = 0;
#pragma unroll
        for (int i4 = 0; i4 < 4; ++i4) {
            const unsigned ks = key[i4] >> sh;
            const unsigned long long tie = __ballot(ks == pfx);
            const int rank = seen + __popcll(tie & ((1ull << lane) - 1ull));
            selm[i4] = __ballot(ks > pfx || (ks == pfx && rank < need));
            seen += __popcll(tie);
        }
        if (lane == 0) {
            u32x4 w0 = {(unsigned)selm[0], (unsigned)(selm[0] >> 32), (unsigned)selm[1], (unsigned)(selm[1] >> 32)};
            u32x4 w1 = {(unsigned)selm[2], (unsigned)(selm[2] >> 32), (unsigned)selm[3], (unsigned)(selm[3] >> 32)};
            *(u32x4*)(SELM + (size_t)q * 8) = w0; *(u32x4*)(SELM + (size_t)q * 8 + 4) = w1;
        }
    }
    __syncthreads();
}
}

constexpr int NPH = 15;
struct Args { const float* in[22]; float* out; unsigned char* ws; int ph_lo, ph_hi; };
enum { I_X = 0, I_NMG, I_WIN, I_PEK, I_PEV, I_W1K, I_W2K, I_W1V, I_W2V, I_LQ1, I_LK1, I_LQ2, I_LK2, I_HG, I_WUPN, I_WUPD, I_WOUT, I_NFG, I_WFFI, I_WFFO, I_TAB, I_NFIN };
constexpr size_t OC_OFF = 0, OS_OFF = (size_t)TOK * 1024 * 2, OW_OFF = 2 * OS_OFF;

template <int KIND> __device__ __forceinline__ int srcmap(int n) {
    if (KIND == 1) { return n < 2560 ? n : (n < 9728 ? n + 24 : (n < 9752 ? n - 9728 + 2560 : -1)); }
    if (KIND == 2) { const int tile = n >> 8, half = (n >> 7) & 1, j = n & 127; return half * DFF + tile * 128 + j; }
    if (KIND == 3) { return n < 128 ? n : -1; }
    return n;
}
template <int KIND>
__device__ __forceinline__ void transpose_item(const float* W, int K, int N, bf16_t* WT, int nblk, LAS float* scr, int item, int lane) {
    const int kb = item / nblk, nb = item % nblk, k0 = 64 * kb, n0 = 32 * nb;
    const int src = srcmap<KIND>(n0 + (lane & 31));
#pragma unroll 8
    for (int i = 0; i < 32; ++i) { const int kk = 2 * i + (lane >> 5); scr[kk * 33 + (lane & 31)] = src >= 0 ? W[(size_t)(k0 + kk) * N + src] : 0.f; }
    asm volatile("s_waitcnt lgkmcnt(0)" ::: "memory");
    const int c = lane & 7;
#pragma unroll
    for (int j = 0; j < 4; ++j) { const int n = (lane >> 3) + 8 * j; const LAS float* s = scr + (8 * c) * 33 + n;
        u32x4 o; o.x = cvtpk(s[0 * 33], s[1 * 33]); o.y = cvtpk(s[2 * 33], s[3 * 33]); o.z = cvtpk(s[4 * 33], s[5 * 33]); o.w = cvtpk(s[6 * 33], s[7 * 33]);
        *(u32x4*)(WT + (size_t)(n0 + n) * K + k0 + 8 * c) = o; }
    asm volatile("s_waitcnt lgkmcnt(0)" ::: "memory");
}
template <bool BF>
__device__ __forceinline__ void rms_row(const float* xrow, const float* g, void* orow, int lane) {
    const f32x4* xr = (const f32x4*)xrow + lane; const f32x4* gr = (const f32x4*)g + lane;
    f32x4 v[8]; float s = 0.f;
#pragma unroll
    for (int j = 0; j < 8; ++j) { v[j] = xr[64 * j]; s += (v[j].x * v[j].x + v[j].y * v[j].y) + (v[j].z * v[j].z + v[j].w * v[j].w); }
    const float rstd = rsqrtf(wave_sum(s) * (1.f / DM) + RMS_EPS);
#pragma unroll
    for (int j = 0; j < 8; ++j) { const f32x4 gg = gr[64 * j]; const f32x4 y = v[j] * rstd * gg;
        if (BF) { u32x2 w; w.x = cvtpk(y.x, y.y); w.y = cvtpk(y.z, y.w); ((u32x2*)orow)[64 * j + lane] = w; }
        else ((f32x4*)orow)[64 * j + lane] = y; }
}
__device__ __forceinline__ int t5_bucket(int n) {
    if (n < 16) return n;
    int l = 16 + (int)(logf((float)n / 16.f) / 2.0794415416798357f * 16.f);
    return l < 31 ? l : 31;
}
__device__ __forceinline__ void load_bias_tables(char* lds, const float* table, int tid0, int tbx_off = att::LDS_TBX) {
    float* tb = (float*)(lds + att::LDS_TB);
    for (int i = tid0; i < 12 * 128; i += 512) { const int h = i >> 7, rel = i & 127;
        tb[i] = (table[t5_bucket(rel) * 12 + h] - table[31 * 12 + h]) * (1.f / SM_SCALE); }
    float* tbx = (float*)(lds + tbx_off);
    for (int i = tid0; i < 12 * att::TBXN; i += 512) { const int h = i / att::TBXN, rel = i % att::TBXN - att::TBX0;
        tbx[i] = (rel >= 0 && rel < att::BAND) ? (table[t5_bucket(rel) * 12 + h] - table[31 * 12 + h]) * (1.f / SM_SCALE) : 0.f; }
    __syncthreads();
}

__global__ void __launch_bounds__(512, 2) mega_fwd(Args args) {
    extern __shared__ __attribute__((aligned(16))) unsigned char lds[];
    LAS unsigned char* ldsl = (LAS unsigned char*)lds;
    const int wave = __builtin_amdgcn_readfirstlane(threadIdx.x >> 6) & 7;
#define lane lane_id()
#define tid (wave * 64 + lane_id())
    const int G = gridDim.x, bx = blockIdx.x;
    const int gw = bx * 8 + wave, NGW = G * 8;
    unsigned char* ws = args.ws;
    const int lo = args.ph_lo, hi = args.ph_hi;
#ifndef PHASE_MASK
#define PHASE_MASK 0x7fff
#endif
#define IN(k) (lo <= (k) && (k) < hi && ((PHASE_MASK >> (k)) & 1))
#define SEAM(k) do { if (IN(k) && IN((k) + 1)) cg::this_grid().sync(); } while (0)
#ifndef DUP_MASK
#define DUP_MASK 0
#endif
#define REPS(k) for (int rep_ = 0; rep_ <= ((DUP_MASK >> (k)) & 1); ++rep_)
#define REPSYNC() do { if (rep_ == 0 && false) {} } while (0)
    const float* x = args.in[I_X];
    float* out = args.out;
    bf16_t* XN = (bf16_t*)(ws + WS_XN);

    REPS(0) if (IN(0)) {
        if (rep_) cg::this_grid().sync();
        LAS float* scr = (LAS float*)(ldsl + wave * 16384);
        constexpr int I0 = 32 * (NPROJ / 32), I1 = I0 + 32 * (2 * DFF / 32), I2 = I1 + (DFF / 64) * (DM / 32), I3 = I2 + 32 * (DM / 32), I4 = I3 + 16 * (DM / 32), I5 = I4 + 16 * (DM / 32),
                      I6 = I5 + 64 * 8, I7 = I6 + 64 * 8, I8 = I7 + 4 * 8, I9 = I8 + 4 * 8;
        for (int it = gw; it < I9; it += NGW) {
            if (it < I0)      transpose_item<1>(args.in[I_WIN], DM, NPROJ_SRC, (bf16_t*)(ws + WS_WIN), NPROJ / 32, scr, it, lane);
            else if (it < I1) transpose_item<2>(args.in[I_WFFI], DM, 2 * DFF, (bf16_t*)(ws + WS_WFFI), 2 * DFF / 32, scr, it - I0, lane);
            else if (it < I2) transpose_item<0>(args.in[I_WFFO], DFF, DM, (bf16_t*)(ws + WS_WFFO), DM / 32, scr, it - I1, lane);
            else if (it < I3) transpose_item<0>(args.in[I_WOUT], DM, DM, (bf16_t*)(ws + WS_WOUT), DM / 32, scr, it - I2, lane);
            else if (it < I4) transpose_item<0>(args.in[I_WUPN], 1024, DM, (bf16_t*)(ws + WS_WUPN), DM / 32, scr, it - I3, lane);
            else if (it < I5) transpose_item<0>(args.in[I_WUPD], 1024, DM, (bf16_t*)(ws + WS_WUPD), DM / 32, scr, it - I4, lane);
            else if (it < I6) transpose_item<0>(args.in[I_W1K], 4096, 256, (bf16_t*)(ws + WS_W1K), 8, scr, it - I5, lane);
            else if (it < I7) transpose_item<0>(args.in[I_W1V], 4096, 256, (bf16_t*)(ws + WS_W1V), 8, scr, it - I6, lane);
            else if (it < I8) transpose_item<3>(args.in[I_W2K], 256, 128, (bf16_t*)(ws + WS_W2K), 8, scr, it - I7, lane);
            else              transpose_item<3>(args.in[I_W2V], 256, 128, (bf16_t*)(ws + WS_W2V), 8, scr, it - I8, lane);
        }
        for (int m = gw; m < TOK; m += NGW) rms_row<true>(x + (size_t)m * DM, args.in[I_NMG], XN + (size_t)m * DM, lane);
        for (int o = gw; o < 512; o += NGW) {
            const int kv = o >> 8, n = o & 255; const float* pe = args.in[kv ? I_PEV : I_PEK]; const float* w1 = args.in[kv ? I_W1V : I_W1K];
            float s = 0.f; for (int k = lane; k < 4096; k += 64) s += pe[k] * w1[(size_t)k * 256 + n];
            s = wave_sum(s); if (lane == 0) ((float*)(ws + (kv ? WS_BV : WS_BK)))[n] = s;
        }
        if (bx == 0 && tid < 32) ((unsigned*)ws)[tid] = 0u;
        { const int gt = bx * 512 + tid;
          if (gt < 2048) { const int slab = gt >> 8, off = (gt & 255) * 8; bf16_t* p = (bf16_t*)(ws + (slab < 4 ? WS_KC : WS_VC)) + ((size_t)(slab & 3) * KCROWS + SEQ) * 128 + off;
              *(u32x4*)p = (u32x4){0u, 0u, 0u, 0u}; } }
    }
    SEAM(0);
#ifdef EXTRA_SYNCS
    for (int es = 0; es < EXTRA_SYNCS; ++es) cg::this_grid().sync();
#endif
    REPS(1) if (IN(1)) {
        if (rep_) cg::this_grid().sync();
        pg8::Gemm g{XN, (const bf16_t*)(ws + WS_WIN), TOK, NPROJ, DM, DM, TOK / 256, 0};
        pg8::StaticOrder S; S.init(TOK, NPROJ, G, bx);
        pg8::EpiProj E{ws};
        pg8::gemm_phase(ldsl, g, S, E, wave);
    }
    SEAM(1);
    REPS(2) if (IN(2) && !CMP_IN_P4) {
        if (rep_) cg::this_grid().sync();
        for (int kv = 0; kv < 2; ++kv) {
            pg8::Gemm g{(const bf16_t*)(ws + (kv ? WS_VC : WS_KC)), (const bf16_t*)(ws + (kv ? WS_W1V : WS_W1K)), 4096, 256, 4096, 2048, 4, (size_t)KCROWS * 128};
            pg8::StaticOrder S; S.init(4096, 256, G, (bx + 128 * kv) % G);
            pg8::EpiCmp1 E{(bf16_t*)(ws + (kv ? WS_HV : WS_HK)), (const float*)(ws + (kv ? WS_BV : WS_BK))};
            pg8::gemm_phase(ldsl, g, S, E, wave);
        }
    }
    if (!CMP_IN_P4) SEAM(2);
    REPS(3) if (IN(3) && !CMP_IN_P4) {
        if (rep_) cg::this_grid().sync();
        for (int kv = 0; kv < 2; ++kv) {
            pg8::Gemm g{(const bf16_t*)(ws + (kv ? WS_HV : WS_HK)), (const bf16_t*)(ws + (kv ? WS_W2V : WS_W2K)), 4096, 256, 256, 256, 16, 0};
            pg8::StaticOrder S; S.init(4096, 256, G, (bx + 128 * kv) % G);
            pg8::EpiCmp2 E{(bf16_t*)(ws + (kv ? WS_VCMP : WS_KCMP))};
            pg8::gemm_phase(ldsl, g, S, E, wave);
        }
    }
    if (!CMP_IN_P4) SEAM(3);
    REPS(4) if (IN(4)) {
        if (rep_) cg::this_grid().sync();
        if (CMP_IN_P4) {
            for (int u = bx; u < 32; u += G) {
                const int kv = u >> 4, pm = u & 15;
                {
                    const bf16_t* A = (const bf16_t*)(ws + (kv ? WS_VC : WS_KC)) + (size_t)(pm >> 2) * KCROWS * 128 + (size_t)(pm & 3) * 256 * 2048;
                    pg8::Gemm g{A, (const bf16_t*)(ws + (kv ? WS_W1V : WS_W1K)), 256, 256, 4096, 2048, 1, 0};
                    pg8::StaticOrder S; S.init(256, 256, 1, 0);
                    pg8::EpiCmp1 E{(bf16_t*)(ws + (kv ? WS_HV : WS_HK)) + (size_t)pm * 256 * 256, (const float*)(ws + (kv ? WS_BV : WS_BK))};
                    pg8::gemm_phase(ldsl, g, S, E, wave);
                }
                __builtin_amdgcn_fence(__ATOMIC_RELEASE, "agent"); asm volatile("s_waitcnt vmcnt(0)" ::: "memory"); __syncthreads(); __builtin_amdgcn_fence(__ATOMIC_ACQUIRE, "agent");
                {
                    pg8::Gemm g{(const bf16_t*)(ws + (kv ? WS_HV : WS_HK)) + (size_t)pm * 256 * 256, (const bf16_t*)(ws + (kv ? WS_W2V : WS_W2K)), 256, 256, 256, 256, 1, 0};
                    pg8::StaticOrder S; S.init(256, 256, 1, 0);
                    pg8::EpiCmp2 E{(bf16_t*)(ws + (kv ? WS_VCMP : WS_KCMP)) + (size_t)pm * 256 * 128};
                    pg8::gemm_phase(ldsl, g, S, E, wave);
                }
            }
            __syncthreads();
        }
        load_bias_tables((char*)lds, args.in[I_TAB], wave * 64 + lane_id(), att::A3_TBX);
        const bf16_t* QD = (const bf16_t*)(ws + WS_QD); const bf16_t* KD = (const bf16_t*)(ws + WS_KD); const bf16_t* VD = (const bf16_t*)(ws + WS_VD);
        bf16_t* O12 = (bf16_t*)(ws + WS_O12);
        const int total = 16 * 32 * 2;
        auto ref = [&](int idx) { const int L = idx >> 1, pass = idx & 1, vq = (G == 256) ? (L >> 8) * 8 + (L & 7) : (L >> 5), xx = (G == 256) ? ((L >> 3) & 31) : (L & 31), qb = pass ? 63 - xx : xx;
            const int bh = vq >> 1;
            att::BlockRef r; r.Q = QD + ((size_t)vq * SEQ + (size_t)qb * 256) * 128; r.K = KD + (size_t)vq * SEQ * 128;
            r.V = VD + (size_t)(bh * 2) * SEQ * 128; r.V2 = VD + (size_t)(bh * 2 + 1) * SEQ * 128;
            r.O = O12 + ((size_t)(vq * 2) * SEQ + (size_t)qb * 256) * 128; r.O2 = O12 + ((size_t)(vq * 2 + 1) * SEQ + (size_t)qb * 256) * 128; r.P0 = qb * 256;
            r.tb = (const float*)(lds + att::A3_TBX) + (8 + (bh & 3)) * att::TBXN + att::TBX0; r.sel = nullptr; return r; };
        (void)total;
        auto refq = [&](int vq, int qb) { const int bh = vq >> 1;
            att::BlockRef r; r.Q = QD + ((size_t)vq * SEQ + (size_t)qb * 256) * 128; r.K = KD + (size_t)vq * SEQ * 128;
            r.V = VD + (size_t)(bh * 2) * SEQ * 128; r.V2 = VD + (size_t)(bh * 2 + 1) * SEQ * 128;
            r.O = O12 + ((size_t)(vq * 2) * SEQ + (size_t)qb * 256) * 128; r.O2 = O12 + ((size_t)(vq * 2 + 1) * SEQ + (size_t)qb * 256) * 128; r.P0 = qb * 256;
            r.tb = (const float*)(lds + att::A3_TBX) + (8 + (bh & 3)) * att::TBXN + att::TBX0; r.sel = nullptr; return r; };
        unsigned* qctr = (unsigned*)ws; volatile unsigned* qw = (volatile unsigned*)(lds + LDS_BYTES - 16);
        for (int rnd = 0; rnd < 2; ++rnd) {
            const int vq = rnd * 8 + (bx & 7);
            for (;;) {
                __syncthreads();
                if (tid == 0) *qw = atomicAdd(qctr + vq, 1u);
                __syncthreads();
                const unsigned w = (unsigned)__builtin_amdgcn_readfirstlane((int)*qw);
                if (w >= 64u) break;
                att::attn_block3(refq(vq, 63 - (int)w), (char*)lds, wave);
            }
        }
    }
    asm volatile("" ::: "memory");
    REPS(15) if (IN(4)) {
        if (rep_) cg::this_grid().sync();
        __syncthreads();
        load_bias_tables((char*)lds, args.in[I_TAB], wave * 64 + lane_id(), att::A2_TBX);
        const bf16_t* QN = (const bf16_t*)(ws + WS_QN);
#ifndef NO_WIN
        {
            const bf16_t* KW = (const bf16_t*)(ws + WS_KW); const bf16_t* VW = (const bf16_t*)(ws + WS_VW); bf16_t* OW = (bf16_t*)((char*)out + OW_OFF);
            const int total = 16 * 64;
            auto ref = [&](int L) { const int bh = L >> 6, qb = L & 63, kvh = (bh >> 3) * 2 + ((bh & 7) >> 2);
                att::BlockRef r; r.Q = QN + ((size_t)bh * SEQ + (size_t)qb * 256) * 128; r.K = KW + (size_t)kvh * SEQ * 128; r.V = VW + (size_t)kvh * SEQ * 128;
                r.O = OW + ((size_t)bh * SEQ + (size_t)qb * 256) * 128; r.P0 = qb * 256; r.tb = (const float*)(lds + att::A2_TBX) + (bh & 7) * att::TBXN + att::TBX0; r.sel = nullptr; r.V2 = nullptr; r.O2 = nullptr; return r; };
            {
                unsigned* qctr = (unsigned*)ws + 24; volatile unsigned* qw = (volatile unsigned*)(lds + LDS_BYTES - 16);
                for (;;) {
                    __syncthreads();
                    if (tid == 0) *qw = atomicAdd(qctr, 1u);
                    __syncthreads();
                    const unsigned w = (unsigned)__builtin_amdgcn_readfirstlane((int)*qw);
                    if (w >= (unsigned)total) break;
                    att::attn_block2<1, false>(ref((int)w), (char*)lds, wave);
                }
            }
        }
#endif
    }
    SEAM(4);
    REPS(5) if (IN(5)) {
        if (rep_) cg::this_grid().sync();
        load_bias_tables((char*)lds, args.in[I_TAB], wave * 64 + lane_id());
        {
            unsigned* qctr = (unsigned*)ws + 20; volatile unsigned* qw = (volatile unsigned*)(lds + LDS_BYTES - 16); const int bg = bx & 3;
            for (;;) {
                __syncthreads();
                if (tid == 0) *qw = atomicAdd(qctr + bg, 1u);
                __syncthreads();
                const unsigned w = (unsigned)__builtin_amdgcn_readfirstlane((int)*qw);
                if (w >= 256u) break;
                att::cmp_item((char*)lds, ws, (float*)((char*)out + OC_OFF), bg >> 1, bg & 1, 255 - (int)w, wave);
            }
        }
    }
    SEAM(5);
    REPS(6) if (IN(6)) {
        if (rep_) cg::this_grid().sync();
        load_bias_tables((char*)lds, args.in[I_TAB], wave * 64 + lane_id());
        const bf16_t* QN = (const bf16_t*)(ws + WS_QN);
        __syncthreads();
#ifndef NO_SEL
        {
            const bf16_t* KS = (const bf16_t*)(ws + WS_KSL); const bf16_t* VS = (const bf16_t*)(ws + WS_VSL); bf16_t* OS = (bf16_t*)((char*)out + OS_OFF);
            const unsigned* SELM = (const unsigned*)(ws + WS_SELM);
            const int total = 4 * 128 * 2;
            auto ref = [&](int idx) { const int L = idx >> 1, pass = idx & 1, bg = (G == 256) ? (L & 3) : (L >> 7), xx = (G == 256) ? ((((L >> 2) & 1) * 2 + (L >> 8)) * 32 + ((L >> 3) & 31)) : (L & 127), qb = pass ? 255 - xx : xx;
                const size_t qo = ((size_t)((bg >> 1) * 8 + (bg & 1) * 4) * SEQ + (size_t)qb * 64) * 128;
                att::BlockRef r; r.Q = QN + qo; r.K = KS + (size_t)bg * SEQ * 128; r.V = VS + (size_t)bg * SEQ * 128;
                r.O = OS + qo; r.P0 = qb * 64; r.tb = (const float*)(lds + att::LDS_TBX) + ((bg & 1) * 4) * att::TBXN + att::TBX0;
                r.sel = SELM + (size_t)bg * SEQ * 8; r.V2 = nullptr; r.O2 = nullptr; return r; };
            (void)total;
            unsigned* qctr = (unsigned*)ws + 16; volatile unsigned* qw = (volatile unsigned*)(lds + LDS_BYTES - 16); const int bgq = bx & 3;
            auto refs = [&](int qb) { const int bg = bgq; const size_t qo = ((size_t)((bg >> 1) * 8 + (bg & 1) * 4) * SEQ + (size_t)qb * 64) * 128;
                att::BlockRef r; r.Q = QN + qo; r.K = KS + (size_t)bg * SEQ * 128; r.V = VS + (size_t)bg * SEQ * 128;
                r.O = OS + qo; r.P0 = qb * 64; r.tb = (const float*)(lds + att::LDS_TBX) + ((bg & 1) * 4) * att::TBXN + att::TBX0;
                r.sel = SELM + (size_t)bg * SEQ * 8; r.V2 = nullptr; r.O2 = nullptr; return r; };
#define SEL_FETCH(dst) do { __syncthreads(); if (tid == 0) *qw = atomicAdd(qctr + bgq, 1u); __syncthreads(); dst = (unsigned)__builtin_amdgcn_readfirstlane((int)*qw); } while (0)
            unsigned w0; SEL_FETCH(w0);
            if (w0 < 256u) {
                att::BlockRef cur = refs(255 - (int)w0); att::Seam S; int par = 0;
                att::attn_prime<2>(cur, (char*)lds, S, par, wave);
                for (;;) {
                    unsigned wn; SEL_FETCH(wn);
                    const bool last = wn >= 256u;
                    const att::BlockRef nxt = last ? cur : refs(255 - (int)wn);
                    att::attn_block<2>(cur, nxt, (char*)lds, S, par, wave);
                    if (last) break;
                    cur = nxt; par ^= 1;
                }
            }
#undef SEL_FETCH
        }
#endif
    }
    SEAM(6);
    REPS(7) if (IN(7)) {
        if (rep_) cg::this_grid().sync();
        float lam;
        { const float* q1 = args.in[I_LQ1]; const float* k1 = args.in[I_LK1]; const float* q2 = args.in[I_LQ2]; const float* k2 = args.in[I_LK2];
          float s1 = q1[lane] * k1[lane] + q1[lane + 64] * k1[lane + 64], s2 = q2[lane] * k2[lane] + q2[lane + 64] * k2[lane + 64];
          s1 = wave_sum(s1); s2 = wave_sum(s2); lam = expf(s1) - expf(s2) + 0.2f; }
        const bf16_t* OC = (const bf16_t*)((char*)out + OC_OFF); const bf16_t* OS = (const bf16_t*)((char*)out + OS_OFF); const bf16_t* OW = (const bf16_t*)((char*)out + OW_OFF);
        const bf16_t* O12 = (const bf16_t*)(ws + WS_O12); const float* GN = (const float*)(ws + WS_GN); const float* hg = args.in[I_HG];
        bf16_t* ONSA = (bf16_t*)(ws + WS_ONSA); bf16_t* OD = (bf16_t*)(ws + WS_OD);
        for (int m = gw; m < TOK; m += NGW) {
            const int b = m >> 14, s = m & (SEQ - 1);
            {
                const int h = lane >> 3, d = (lane & 7) * 16; const size_t off = ((size_t)(b * 8 + h) * SEQ + s) * 128 + d;
                const float g0 = GN[(size_t)m * 24 + h * 3], g1 = GN[(size_t)m * 24 + h * 3 + 1], g2 = GN[(size_t)m * 24 + h * 3 + 2];
#pragma unroll
                for (int e = 0; e < 2; ++e) { f32x4 c0, c1, s0, s1, w0, w1;
                    pg8::unpack8(*(const u32x4*)(OC + off + e * 8), c0, c1); pg8::unpack8(*(const u32x4*)(OS + off + e * 8), s0, s1); pg8::unpack8(*(const u32x4*)(OW + off + e * 8), w0, w1);
                    *(u32x4*)(ONSA + (size_t)m * 1024 + h * 128 + d + e * 8) = pg8::pack8v(c0 * g0 + s0 * g1 + w0 * g2, c1 * g0 + s1 * g1 + w1 * g2); }
            }
            {
                const int h = lane >> 4, j = (lane & 15) * 16, vhalf = j >> 7, d = j & 127;
                const size_t o1 = ((size_t)(((b * 4 + h) * 2 + 0) * 2 + vhalf) * SEQ + s) * 128 + d, o2 = ((size_t)(((b * 4 + h) * 2 + 1) * 2 + vhalf) * SEQ + s) * 128 + d;
                f32x4 v[4]; float ss = 0.f;
#pragma unroll
                for (int e = 0; e < 2; ++e) { f32x4 a0, a1, b0, b1; pg8::unpack8(*(const u32x4*)(O12 + o1 + e * 8), a0, a1); pg8::unpack8(*(const u32x4*)(O12 + o2 + e * 8), b0, b1);
                    v[2 * e] = a0 - b0 * lam; v[2 * e + 1] = a1 - b1 * lam; }
#pragma unroll
                for (int e = 0; e < 4; ++e) ss += (v[e].x * v[e].x + v[e].y * v[e].y) + (v[e].z * v[e].z + v[e].w * v[e].w);
                ss = row16_sum(ss);
                const float rstd = rsqrtf(ss * (1.f / 256.f) + RMS_EPS) * 0.8f;
                const f32x4* gp = (const f32x4*)(hg + h * 256 + j);
#pragma unroll
                for (int e = 0; e < 2; ++e) *(u32x4*)(OD + (size_t)m * 1024 + h * 256 + j + e * 8) = pg8::pack8v(v[2 * e] * rstd * gp[2 * e], v[2 * e + 1] * rstd * gp[2 * e + 1]);
            }
        }
    }
    SEAM(7);
    REPS(8) if (IN(8)) {
        if (rep_) cg::this_grid().sync();
#ifdef PROBE8
        { pg8::Gemm g{(const bf16_t*)(ws + WS_ONSA), (const bf16_t*)(ws + WS_WUPN), TOK, DM, 1024, 1024, TOK / 256, 0};
          pg8::StaticOrder S; S.init(TOK, DM, G, bx); pg8::EpiUp<0> E{(bf16_t*)(ws + WS_QN), (const bf16_t*)(ws + WS_GM)}; pg8::gemm_phase(ldsl, g, S, E, wave); }
        { pg8::Gemm g{(const bf16_t*)(ws + WS_OD), (const bf16_t*)(ws + WS_WUPD), TOK, DM, 1024, 1024, TOK / 256, 0};
          pg8::StaticOrder S; S.init(TOK, DM, G, bx); pg8::EpiUp<1> E{(bf16_t*)(ws + WS_QN), (const bf16_t*)(ws + WS_GM)}; pg8::gemm_phase(ldsl, g, S, E, wave); }
        cg::this_grid().sync();
#endif
        pg8::Gemm g{(const bf16_t*)(ws + WS_ONSA), (const bf16_t*)(ws + WS_WUPN), TOK, DM, 1024, 1024, TOK / 256, 0};
        pg8::StaticOrder S; S.init(TOK, DM, G, bx);
        pg8::EpiUp<0> E{(bf16_t*)(ws + WS_MIX), (const bf16_t*)(ws + WS_GM)};
        pg8::gemm_phase(ldsl, g, S, E, wave);
    }
    if (IN(9)) {
        pg8::Gemm g{(const bf16_t*)(ws + WS_OD), (const bf16_t*)(ws + WS_WUPD), TOK, DM, 1024, 1024, TOK / 256, 0};
        pg8::StaticOrder S; S.init(TOK, DM, G, bx);
        pg8::EpiUp<1> E{(bf16_t*)(ws + WS_MIX), (const bf16_t*)(ws + WS_GM)};
        pg8::gemm_phase(ldsl, g, S, E, wave);
    }
    SEAM(9);
    REPS(10) if (IN(10)) {
        if (rep_) cg::this_grid().sync();
        pg8::Gemm g{(const bf16_t*)(ws + WS_MIX), (const bf16_t*)(ws + WS_WOUT), TOK, DM, DM, DM, TOK / 256, 0};
        pg8::StaticOrder S; S.init(TOK, DM, G, bx);
        pg8::EpiRes E{x, out};
        pg8::gemm_phase(ldsl, g, S, E, wave);
    }
    SEAM(10);
    REPS(11) if (IN(11)) { if (rep_) cg::this_grid().sync(); for (int m = gw; m < TOK; m += NGW) rms_row<true>(out + (size_t)m * DM, args.in[I_NFG], XN + (size_t)m * DM, lane); }
    SEAM(11);
    REPS(12) if (IN(12)) {
        if (rep_) cg::this_grid().sync();
        pg8::Gemm g{XN, (const bf16_t*)(ws + WS_WFFI), TOK, 2 * DFF, DM, DM, TOK / 256, 0};
        pg8::StaticOrder S; S.init(TOK, 2 * DFF, G, bx);
        pg8::EpiSwiglu E{(bf16_t*)(ws + WS_HID)};
        pg8::gemm_phase(ldsl, g, S, E, wave);
    }
    SEAM(12);
    if (IN(13)) {
        pg8::Gemm g{(const bf16_t*)(ws + WS_HID), (const bf16_t*)(ws + WS_WFFO), TOK, DM, DFF, DFF, TOK / 256, 0};
        pg8::StaticOrder S; S.init(TOK, DM, G, bx);
#ifdef PROBE13
        { pg8::EpiRes E0{out, (float*)(ws + WS_GM)}; pg8::gemm_phase(ldsl, g, S, E0, wave); cg::this_grid().sync(); }
#endif
        pg8::EpiRes E{out, out};
        pg8::gemm_phase(ldsl, g, S, E, wave);
    }
    SEAM(13);
#ifdef PROBE14
    if (IN(14)) { for (int m = gw; m < TOK; m += NGW) rms_row<false>(out + (size_t)m * DM, args.in[I_NFIN], (float*)(ws + WS_GM) + (size_t)m * DM, lane); cg::this_grid().sync(); }
#endif
    if (IN(14)) { for (int m = gw; m < TOK; m += NGW) rms_row<false>(out + (size_t)m * DM, args.in[I_NFIN], out + (size_t)m * DM, lane); }
#undef IN
#undef SEAM
#undef lane
#undef tid
}

extern "C" void kernel_launch(void* const* d_in, const int* in_sizes, int n_in, void* d_out, int out_size, void* d_ws, size_t ws_size, hipStream_t stream) {
    static int grid = 0;
    if (grid == 0) {
        if (n_in != 22 || out_size != TOK * DM || ws_size < WS_END) { fprintf(stderr, "kernel_launch: unexpected shapes (n_in %d out %d ws %zu need %zu)\n", n_in, out_size, ws_size, (size_t)WS_END); grid = -1; return; }
        int dev = 0, cus = 0, per_cu = 0;
        (void)hipGetDevice(&dev); (void)hipDeviceGetAttribute(&cus, hipDeviceAttributeMultiprocessorCount, dev);
        if (hipFuncSetAttribute((const void*)mega_fwd, hipFuncAttributeMaxDynamicSharedMemorySize, LDS_BYTES) != hipSuccess) { fprintf(stderr, "kernel_launch: hipFuncSetAttribute failed\n"); grid = -1; return; }
        (void)hipOccupancyMaxActiveBlocksPerMultiprocessor(&per_cu, (const void*)mega_fwd, 512, LDS_BYTES);
        (void)hipGetLastError();
        if (per_cu < 1) per_cu = 1;
        grid = cus > 0 ? cus : 256;
        fprintf(stderr, "kernel_launch: grid %d (per_cu %d)\n", grid, per_cu);
    }
    if (grid < 0) return;
    Args a{};
    for (int i = 0; i < 22; ++i) a.in[i] = (const float*)d_in[i];
    a.out = (float*)d_out; a.ws = (unsigned char*)d_ws;
#if MK_N_LAUNCHES == 1
    a.ph_lo = 0; a.ph_hi = NPH;
    void* kargs[] = {&a};
    hipError_t e = hipLaunchCooperativeKernel((const void*)mega_fwd, dim3(grid), dim3(512), kargs, LDS_BYTES, stream);
    if (e != hipSuccess) fprintf(stderr, "kernel_launch: cooperative launch failed: %s\n", hipGetErrorString(e));
#else
    for (int p = 0; p < NPH; ++p) { a.ph_lo = p; a.ph_hi = p + 1; hipLaunchKernelGGL(mega_fwd, dim3(grid), dim3(512), LDS_BYTES, stream, a); }
#endif
}
```

```cpp
#include <hip/hip_runtime.h>
#include <hip/hip_cooperative_groups.h>
#include <cstdio>
#include <cstdint>
namespace cg = cooperative_groups;

#ifndef MK_N_LAUNCHES
#define MK_N_LAUNCHES 1
#endif
#define CMP_IN_P4 1
#define DUP_MASK 0x0

#define LAS __attribute__((address_space(3)))
typedef unsigned short bf16_t;
typedef short bf16x8 __attribute__((ext_vector_type(8)));
typedef short s16x4 __attribute__((ext_vector_type(4)));
typedef float f32x4 __attribute__((ext_vector_type(4)));
typedef float f32x16 __attribute__((ext_vector_type(16)));
typedef unsigned u32x4 __attribute__((ext_vector_type(4)));
typedef unsigned u32x2 __attribute__((ext_vector_type(2)));

constexpr int SEQ = 16384, NBATCH = 2, TOK = NBATCH * SEQ, DM = 2048, DFF = 5632, HD = 128;
constexpr int NPROJ_SRC = 9752, NPROJ = 9984;
constexpr int KCROWS = SEQ + 16;
constexpr float SM_SCALE = 0.08838834764831845f;
constexpr float RMS_EPS = 1e-6f;

constexpr size_t WS_WIN  = 1u << 20;
constexpr size_t WS_WFFI = WS_WIN  + (size_t)NPROJ * DM * 2;
constexpr size_t WS_WFFO = WS_WFFI + (size_t)2 * DFF * DM * 2;
constexpr size_t WS_WOUT = WS_WFFO + (size_t)DM * DFF * 2;
constexpr size_t WS_WUPN = WS_WOUT + (size_t)DM * DM * 2;
constexpr size_t WS_WUPD = WS_WUPN + (size_t)DM * 1024 * 2;
constexpr size_t WS_W1K  = WS_WUPD + (size_t)DM * 1024 * 2;
constexpr size_t WS_W1V  = WS_W1K + (size_t)256 * 4096 * 2;
constexpr size_t WS_W2K  = WS_W1V + (size_t)256 * 4096 * 2;
constexpr size_t WS_W2V  = WS_W2K + (size_t)256 * 256 * 2;
constexpr size_t WS_BK   = WS_W2V + (size_t)256 * 256 * 2;
constexpr size_t WS_BV   = WS_BK + 1024;
constexpr size_t WS_XN   = WS_BV + 1024;
constexpr size_t WS_QN   = WS_XN + (size_t)TOK * DM * 2;
constexpr size_t WS_KC   = WS_QN + (size_t)TOK * 1024 * 2;
constexpr size_t WS_VC   = WS_KC + (size_t)4 * KCROWS * 128 * 2;
constexpr size_t WS_KSL  = WS_VC + (size_t)4 * KCROWS * 128 * 2;
constexpr size_t WS_VSL  = WS_KSL + (size_t)4 * SEQ * 128 * 2;
constexpr size_t WS_KW   = WS_VSL + (size_t)4 * SEQ * 128 * 2;
constexpr size_t WS_VW   = WS_KW + (size_t)4 * SEQ * 128 * 2;
constexpr size_t WS_QD   = WS_VW + (size_t)4 * SEQ * 128 * 2;
constexpr size_t WS_KD   = WS_QD + (size_t)TOK * 1024 * 2;
constexpr size_t WS_VD   = WS_KD + (size_t)TOK * 1024 * 2;
constexpr size_t WS_GM   = WS_VD + (size_t)TOK * 1024 * 2;
constexpr size_t WS_GN   = WS_GM + (size_t)TOK * 4096 * 2;
constexpr size_t WS_HK   = WS_GN + (size_t)TOK * 24 * 4;
constexpr size_t WS_HV   = WS_HK + (size_t)4096 * 256 * 2;
constexpr size_t WS_KCMP = WS_HV + (size_t)4096 * 256 * 2;
constexpr size_t WS_VCMP = WS_KCMP + (size_t)4096 * 128 * 2;
constexpr size_t WS_SELM = WS_VCMP + (size_t)4096 * 128 * 2;
constexpr size_t WS_END  = WS_SELM + (size_t)4 * SEQ * 8 * 4;
constexpr size_t WS_O12  = WS_XN;
constexpr size_t WS_ONSA = WS_QD;
constexpr size_t WS_OD   = WS_KD;
constexpr size_t WS_MIX  = WS_XN;
constexpr size_t WS_HID  = WS_QN;
static_assert(WS_HID + (size_t)TOK * DFF * 2 <= WS_GM, "HID overlay");
static_assert(WS_END <= (size_t)1 << 30, "workspace");

constexpr int LDS_BYTES = 163840;

__device__ __forceinline__ unsigned cvtpk(float lo, float hi) { unsigned r; asm volatile("v_cvt_pk_bf16_f32 %0, %1, %2" : "=v"(r) : "v"(lo), "v"(hi)); return r; }
__device__ __forceinline__ float bf2f(unsigned short h) { return __uint_as_float((unsigned)h << 16); }
__device__ __forceinline__ float sigmoidf_(float x) { return __builtin_amdgcn_rcpf(1.f + __builtin_amdgcn_exp2f(-1.4426950408889634f * x)); }
__device__ __forceinline__ int lane_id() {
    unsigned l; asm volatile("v_mbcnt_lo_u32_b32 %0, -1, 0\n\tv_mbcnt_hi_u32_b32 %0, -1, %0" : "=v"(l)); return (int)(l & 63u); }
__device__ __forceinline__ float xor1_(float v) { return __int_as_float(__builtin_amdgcn_update_dpp(0, __float_as_int(v), 0xB1, 0xf, 0xf, false)); }
#define DPP_F(v, ctrl) __int_as_float(__builtin_amdgcn_update_dpp(0, __float_as_int(v), ctrl, 0xf, 0xf, false))
__device__ __forceinline__ float row16_sum(float v) {
    v += DPP_F(v, 0xB1); v += DPP_F(v, 0x4E); v += DPP_F(v, 0x141); v += DPP_F(v, 0x140); return v; }
__device__ __forceinline__ float wave_sum(float v) {
    v = row16_sum(v);
    { auto rr = __builtin_amdgcn_permlane16_swap(__float_as_uint(v), __float_as_uint(v), false, false); v = __uint_as_float(rr[0]) + __uint_as_float(rr[1]); }
    { auto rr = __builtin_amdgcn_permlane32_swap(__float_as_uint(v), __float_as_uint(v), false, false); v = __uint_as_float(rr[0]) + __uint_as_float(rr[1]); }
    return v;
}

namespace pg8 {
constexpr int BM = 256, BK = 64, HALF = 128, HTB = HALF * BK * 2, STAGE_BYTES = 8 * HTB, NXCD = 8, WGM = 8;
__host__ __device__ __forceinline__ int lds_byte(int r, int c) { const int st = (r >> 4) * 2 + (c >> 5), rr = r & 15, cc = c & 31, ob = rr * 64 + cc * 2; return st * 1024 + (ob ^ (((ob >> 9) & 1) << 5)); }
__host__ __device__ __forceinline__ void stage_rc(int b, int& R, int& C) { const int st = b / 1024, sb = b % 1024, swz = sb ^ (((sb >> 9) & 1) << 5); R = (st >> 1) * 16 + swz / 64; C = (st & 1) * 32 + (swz % 64) / 2; }
__host__ __device__ __forceinline__ int perm32(int rho) { const int n = rho >> 4, i = rho & 15; return 8 * (i >> 2) + 4 * n + (i & 3); }
struct Unit { int pm, pn; };
struct Gemm { const bf16_t* A; const bf16_t* Bt; int M, N, K, lda, tps; size_t slab; };
struct StaticOrder {
    int nM, nN, nwg, G, c;
    __device__ void init(int M, int N, int G_, int c_) { nM = M / BM; nN = N / BM; nwg = nM * nN; G = G_; c = c_; }
    __device__ bool next(int i, Unit& u) const {
        const long L = (long)i * G + c; if (L >= nwg) return false;
        int wgid = (int)L; { const int q = nwg / NXCD, r = nwg % NXCD, xcd = wgid % NXCD, off = wgid / NXCD; wgid = (xcd < r ? xcd * (q + 1) : r * (q + 1) + (xcd - r) * q) + off; }
        const int nig = WGM * nN, gid = wgid / nig, fm = gid * WGM, gsz = (nM - fm) < WGM ? (nM - fm) : WGM;
        u.pm = fm + ((wgid % nig) % gsz); u.pn = (wgid % nig) / gsz; return true;
    }
};
template <class Epi>
__device__ __forceinline__ void gemm_phase(LAS unsigned char* lds, const Gemm g, const StaticOrder& S, const Epi& E, const int wid) {
    const int lane = lane_id(), tid = wid * 64 + lane, wr = wid >> 2, wc = wid & 3, fr = lane & 15, fq = lane >> 4;
    const int K = g.K, nt = K / BK, lda = g.lda;
    unsigned voffA[2], voffB[2];
#pragma unroll
    for (int i = 0; i < 2; ++i) { int R, C; stage_rc(tid * 16 + i * 8192, R, C); const int Rb = (R & ~31) + perm32(R & 31);
        voffA[i] = (unsigned)(R * lda + C) * 2u; voffB[i] = (unsigned)(Rb * K + C) * 2u; }
    const size_t kstep = (size_t)(BK * 2);
    const size_t hstepA = (size_t)HALF * lda * 2, hstepB = (size_t)HALF * K * 2;
    const unsigned ldsw = (unsigned)wid * 1024u;
    const int aoff = lds_byte(wr * 64 + fr, fq * 8), boff = lds_byte(wc * 32 + fr, fq * 8);
#define PG8_TILEA(pm) ((const char*)g.A + ((size_t)((pm) / g.tps) * g.slab + (size_t)((pm) % g.tps) * 256 * lda) * 2)
#define PG8_TILEB(pn) ((const char*)g.Bt + (size_t)(pn) * 2 * hstepB)
#define PG8_SA(b, h) (((b) * 2 + (h)) * HTB)
#define PG8_SB(b, h) ((4 + (b) * 2 + (h)) * HTB)
#define PG8_STAGE(bufoff, gbase, voff) do { _Pragma("unroll") for (int _i = 0; _i < 2; ++_i) \
        __builtin_amdgcn_global_load_lds((const unsigned*)((const char*)(gbase) + (voff)[_i]), (LAS unsigned*)(lds + (bufoff) + ldsw + _i * 8192), 16, 0, 0); } while (0)
#define PG8_LDA(dst, b, h) do { _Pragma("unroll") for (int m = 0; m < 4; ++m) _Pragma("unroll") for (int k = 0; k < 2; ++k) dst[m][k] = *(const LAS bf16x8*)(lds + PG8_SA(b, h) + aoff + m * 2048 + k * 1024); } while (0)
#define PG8_LDB(dst, b, h) do { _Pragma("unroll") for (int n = 0; n < 2; ++n) _Pragma("unroll") for (int k = 0; k < 2; ++k) dst[n][k] = *(const LAS bf16x8*)(lds + PG8_SB(b, h) + boff + n * 2048 + k * 1024); } while (0)
#define PG8_MMA(ai, bj, At, Bt) do { __builtin_amdgcn_s_setprio(1); _Pragma("unroll") for (int m = 0; m < 4; ++m) _Pragma("unroll") for (int n = 0; n < 2; ++n) _Pragma("unroll") for (int k = 0; k < 2; ++k) \
        acc[ai][bj][m][n] = __builtin_amdgcn_mfma_f32_16x16x32_bf16(Bt[n][k], At[m][k], acc[ai][bj][m][n], 0, 0, 0); __builtin_amdgcn_s_setprio(0); } while (0)
#define PG8_WAIT_V(n) asm volatile("s_waitcnt vmcnt(" #n ")" ::: "memory")
#define PG8_WAIT_L(n) asm volatile("s_waitcnt lgkmcnt(" #n ")" ::: "memory")
#define PG8_BAR __builtin_amdgcn_s_barrier()
#define PG8_SCHED __builtin_amdgcn_sched_barrier(0)
    Unit cur, nxt; int ui = 0;
    if (!S.next(0, cur)) return;
    f32x4 acc[2][2][4][2];
#pragma unroll
    for (int a = 0; a < 2; ++a)
#pragma unroll
        for (int b = 0; b < 2; ++b)
#pragma unroll
            for (int m = 0; m < 4; ++m)
#pragma unroll
                for (int n = 0; n < 2; ++n) acc[a][b][m][n] = (f32x4){0.f, 0.f, 0.f, 0.f};
    bf16x8 At[4][2], B0[2][2], B1[2][2];
    const char* cA = PG8_TILEA(cur.pm); const char* cB = PG8_TILEB(cur.pn);
    PG8_STAGE(PG8_SB(0, 0), cB, voffB); PG8_STAGE(PG8_SB(0, 1), cB + hstepB, voffB); PG8_STAGE(PG8_SA(0, 0), cA, voffA); PG8_STAGE(PG8_SA(0, 1), cA + hstepA, voffA);
    if (wr == 1) PG8_BAR;
    PG8_WAIT_V(2); PG8_BAR;
    PG8_STAGE(PG8_SB(1, 0), cB + kstep, voffB); PG8_STAGE(PG8_SA(1, 0), cA + kstep, voffA); PG8_STAGE(PG8_SB(1, 1), cB + hstepB + kstep, voffB);
    PG8_WAIT_V(6); PG8_BAR;
    for (;;) {
        const bool has_next = S.next(ui + 1, nxt);
        const char* nA = has_next ? PG8_TILEA(nxt.pm) : cA; const char* nB = has_next ? PG8_TILEB(nxt.pn) : cB;
        for (int t = 0; t < nt; t += 2) {
            const bool last = (t == nt - 2);
            const char* a1 = cA + (size_t)(t + 1) * kstep;
            const char* a2 = last ? nA : cA + (size_t)(t + 2) * kstep; const char* b2 = last ? nB : cB + (size_t)(t + 2) * kstep;
            const char* a3 = a2 + kstep; const char* b3 = b2 + kstep;
            PG8_LDB(B0, 0, 0); PG8_LDB(B1, 0, 1); PG8_SCHED; PG8_LDA(At, 0, 0); PG8_STAGE(PG8_SA(1, 1), a1 + hstepA, voffA);
            PG8_WAIT_V(8); PG8_WAIT_L(0); PG8_BAR; PG8_MMA(0, 0, At, B0); PG8_MMA(0, 1, At, B1); PG8_BAR; PG8_SCHED;
            PG8_LDA(At, 0, 1); PG8_STAGE(PG8_SB(0, 0), b2, voffB); PG8_STAGE(PG8_SB(0, 1), b2 + hstepB, voffB); PG8_STAGE(PG8_SA(0, 0), a2, voffA);
            PG8_WAIT_V(8); PG8_WAIT_L(0); PG8_BAR; PG8_MMA(1, 0, At, B0); PG8_MMA(1, 1, At, B1); PG8_BAR; PG8_SCHED;
            PG8_LDB(B0, 1, 0); PG8_LDB(B1, 1, 1); PG8_SCHED; PG8_LDA(At, 1, 0); PG8_STAGE(PG8_SA(0, 1), a2 + hstepA, voffA);
            PG8_WAIT_V(8); PG8_WAIT_L(0); PG8_BAR; PG8_MMA(0, 0, At, B0); PG8_MMA(0, 1, At, B1); PG8_BAR; PG8_SCHED;
            PG8_LDA(At, 1, 1); PG8_STAGE(PG8_SB(1, 0), b3, voffB); PG8_STAGE(PG8_SB(1, 1), b3 + hstepB, voffB); PG8_STAGE(PG8_SA(1, 0), a3, voffA);
            PG8_WAIT_V(8); PG8_WAIT_L(0); PG8_BAR; PG8_MMA(1, 0, At, B0); PG8_MMA(1, 1, At, B1); PG8_BAR; PG8_SCHED;
        }
        if (wr == 0) PG8_BAR;
        E(acc, cur, wr, wc, fr, fq);
        if (!has_next) break;
#pragma unroll
        for (int a = 0; a < 2; ++a)
#pragma unroll
            for (int b = 0; b < 2; ++b)
#pragma unroll
                for (int m = 0; m < 4; ++m)
#pragma unroll
                    for (int n = 0; n < 2; ++n) acc[a][b][m][n] = (f32x4){0.f, 0.f, 0.f, 0.f};
        cur = nxt; cA = nA; cB = nB; ++ui;
        if (wr == 1) PG8_BAR;
    }
    PG8_WAIT_V(0);
    PG8_BAR;
#undef PG8_TILEA
#undef PG8_TILEB
#undef PG8_SA
#undef PG8_SB
#undef PG8_STAGE
#undef PG8_LDA
#undef PG8_LDB
#undef PG8_MMA
#undef PG8_WAIT_V
#undef PG8_WAIT_L
#undef PG8_BAR
#undef PG8_SCHED
}

typedef f32x4 Acc[2][2][4][2];
__device__ __forceinline__ u32x4 pack8v(f32x4 a, f32x4 b) { u32x4 w; w.x = cvtpk(a[0], a[1]); w.y = cvtpk(a[2], a[3]); w.z = cvtpk(b[0], b[1]); w.w = cvtpk(b[2], b[3]); return w; }
__device__ __forceinline__ void unpack8(u32x4 w, f32x4& a, f32x4& b) {
    a[0] = __uint_as_float(w.x << 16); a[1] = __uint_as_float(w.x & 0xffff0000u); a[2] = __uint_as_float(w.y << 16); a[3] = __uint_as_float(w.y & 0xffff0000u);
    b[0] = __uint_as_float(w.z << 16); b[1] = __uint_as_float(w.z & 0xffff0000u); b[2] = __uint_as_float(w.w << 16); b[3] = __uint_as_float(w.w & 0xffff0000u);
}

struct EpiProj {
    unsigned char* ws;
    __device__ __forceinline__ void operator()(const Acc& acc, const Unit& u, int wr, int wc, int fr, int fq) const {
        const int d = wc * 32 + 8 * fq;
#pragma unroll
        for (int bj = 0; bj < 2; ++bj) {
            const int blk = u.pn * 2 + bj;
            if (blk >= 77) continue;
            bf16_t* base; size_t bstride; int kind = 0;
            if (blk < 8)       { base = (bf16_t*)(ws + WS_QN) + (size_t)blk * SEQ * 128; bstride = (size_t)8 * SEQ * 128; }
            else if (blk < 10) { base = (bf16_t*)(ws + WS_KC) + (size_t)(blk - 8) * KCROWS * 128; bstride = (size_t)2 * KCROWS * 128; }
            else if (blk < 12) { base = (bf16_t*)(ws + WS_VC) + (size_t)(blk - 10) * KCROWS * 128; bstride = (size_t)2 * KCROWS * 128; }
            else if (blk < 14) { base = (bf16_t*)(ws + WS_KSL) + (size_t)(blk - 12) * SEQ * 128; bstride = (size_t)2 * SEQ * 128; }
            else if (blk < 16) { base = (bf16_t*)(ws + WS_VSL) + (size_t)(blk - 14) * SEQ * 128; bstride = (size_t)2 * SEQ * 128; }
            else if (blk < 18) { base = (bf16_t*)(ws + WS_KW) + (size_t)(blk - 16) * SEQ * 128; bstride = (size_t)2 * SEQ * 128; }
            else if (blk < 20) { base = (bf16_t*)(ws + WS_VW) + (size_t)(blk - 18) * SEQ * 128; bstride = (size_t)2 * SEQ * 128; }
            else if (blk < 28) { base = (bf16_t*)(ws + WS_QD) + (size_t)(blk - 20) * SEQ * 128; bstride = (size_t)8 * SEQ * 128; }
            else if (blk < 36) { base = (bf16_t*)(ws + WS_KD) + (size_t)(blk - 28) * SEQ * 128; bstride = (size_t)8 * SEQ * 128; }
            else if (blk < 44) { base = (bf16_t*)(ws + WS_VD) + (size_t)(blk - 36) * SEQ * 128; bstride = (size_t)8 * SEQ * 128; }
            else if (blk < 76) { base = (bf16_t*)(ws + WS_GM) + (size_t)(blk - 44) * 128; bstride = 0; kind = 1; }
            else               { base = nullptr; bstride = 0; kind = 2; }
#pragma unroll
            for (int ai = 0; ai < 2; ++ai)
#pragma unroll
                for (int m = 0; m < 4; ++m) {
                    const int row = u.pm * 256 + ai * 128 + wr * 64 + m * 16 + fr;
                    f32x4 v0 = acc[ai][bj][m][0], v1 = acc[ai][bj][m][1];
                    if (kind == 0) {
                        const int b = row >> 14, s = row & (SEQ - 1);
                        *(u32x4*)(base + (size_t)b * bstride + (size_t)s * 128 + d) = pack8v(v0, v1);
                    } else if (kind == 1) {
#pragma unroll
                        for (int e = 0; e < 4; ++e) { v0[e] = sigmoidf_(v0[e]); v1[e] = sigmoidf_(v1[e]); }
                        *(u32x4*)(base + (size_t)row * 4096 + d) = pack8v(v0, v1);
                    } else {
                        if (d < 24) { float* gn = (float*)(ws + WS_GN) + (size_t)row * 24 + d;
#pragma unroll
                            for (int e = 0; e < 4; ++e) { v0[e] = sigmoidf_(v0[e]); v1[e] = sigmoidf_(v1[e]); }
                            *(f32x4*)gn = v0; *(f32x4*)(gn + 4) = v1; }
                    }
                }
        }
    }
};
struct EpiCmp1 {
    bf16_t* H; const float* bias;
    __device__ __forceinline__ void operator()(const Acc& acc, const Unit& u, int wr, int wc, int fr, int fq) const {
#pragma unroll
        for (int bj = 0; bj < 2; ++bj) {
            const int c = bj * 128 + wc * 32 + 8 * fq;
            const f32x4 b0 = *(const f32x4*)(bias + c), b1 = *(const f32x4*)(bias + c + 4);
#pragma unroll
            for (int ai = 0; ai < 2; ++ai)
#pragma unroll
                for (int m = 0; m < 4; ++m) {
                    const int row = u.pm * 256 + ai * 128 + wr * 64 + m * 16 + fr;
                    f32x4 v0 = acc[ai][bj][m][0] + b0, v1 = acc[ai][bj][m][1] + b1;
#pragma unroll
                    for (int e = 0; e < 4; ++e) {
                        float x = v0[e]; float t = 1.5957691216f * (x + 0.044715f * x * x * x); v0[e] = x * sigmoidf_(t);
                        x = v1[e]; t = 1.5957691216f * (x + 0.044715f * x * x * x); v1[e] = x * sigmoidf_(t); }
                    *(u32x4*)(H + (size_t)row * 256 + c) = pack8v(v0, v1);
                }
        }
    }
};
struct EpiCmp2 {
    bf16_t* O;
    __device__ __forceinline__ void operator()(const Acc& acc, const Unit& u, int wr, int wc, int fr, int fq) const {
        const int c = wc * 32 + 8 * fq;
#pragma unroll
        for (int ai = 0; ai < 2; ++ai)
#pragma unroll
            for (int m = 0; m < 4; ++m) {
                const int row = u.pm * 256 + ai * 128 + wr * 64 + m * 16 + fr;
                *(u32x4*)(O + (size_t)row * 128 + c) = pack8v(acc[ai][0][m][0], acc[ai][0][m][1]);
            }
    }
};
template <int MODE> struct EpiUp {
    bf16_t* T; const bf16_t* GM;
    __device__ __forceinline__ void operator()(const Acc& acc, const Unit& u, int wr, int wc, int fr, int fq) const {
#pragma unroll
        for (int bj = 0; bj < 2; ++bj) {
            const int c = u.pn * 256 + bj * 128 + wc * 32 + 8 * fq;
#pragma unroll
            for (int ai = 0; ai < 2; ++ai)
#pragma unroll
                for (int m = 0; m < 4; ++m) {
                    const int row = u.pm * 256 + ai * 128 + wr * 64 + m * 16 + fr;
                    f32x4 g0, g1; unpack8(*(const u32x4*)(GM + (size_t)row * 4096 + MODE * 2048 + c), g0, g1);
                    f32x4 v0 = acc[ai][bj][m][0] * g0, v1 = acc[ai][bj][m][1] * g1;
                    bf16_t* tp = T + (size_t)row * 2048 + c;
                    if (MODE == 1) { f32x4 t0, t1; unpack8(*(const u32x4*)tp, t0, t1); v0 += t0; v1 += t1; }
                    *(u32x4*)tp = pack8v(v0, v1);
                }
        }
    }
};
struct EpiRes {
    const float* res; float* out;
    __device__ __forceinline__ void operator()(const Acc& acc, const Unit& u, int wr, int wc, int fr, int fq) const {
#pragma unroll
        for (int bj = 0; bj < 2; ++bj) {
            const int c = u.pn * 256 + bj * 128 + wc * 32 + 8 * fq;
#pragma unroll
            for (int ai = 0; ai < 2; ++ai)
#pragma unroll
                for (int m = 0; m < 4; ++m) {
                    const size_t off = (size_t)(u.pm * 256 + ai * 128 + wr * 64 + m * 16 + fr) * DM + c;
                    const f32x4 r0 = *(const f32x4*)(res + off), r1 = *(const f32x4*)(res + off + 4);
                    *(f32x4*)(out + off) = r0 + acc[ai][bj][m][0]; *(f32x4*)(out + off + 4) = r1 + acc[ai][bj][m][1];
                }
        }
    }
};
struct EpiSwiglu {
    bf16_t* H;
    __device__ __forceinline__ void operator()(const Acc& acc, const Unit& u, int wr, int wc, int fr, int fq) const {
        const int c = u.pn * 128 + wc * 32 + 8 * fq;
#pragma unroll
        for (int ai = 0; ai < 2; ++ai)
#pragma unroll
            for (int m = 0; m < 4; ++m) {
                const int row = u.pm * 256 + ai * 128 + wr * 64 + m * 16 + fr;
                f32x4 v0, v1;
#pragma unroll
                for (int e = 0; e < 4; ++e) { const float a0 = acc[ai][0][m][0][e], a1 = acc[ai][0][m][1][e];
                    v0[e] = a0 * sigmoidf_(a0) * acc[ai][1][m][0][e]; v1[e] = a1 * sigmoidf_(a1) * acc[ai][1][m][1][e]; }
                *(u32x4*)(H + (size_t)row * DFF + c) = pack8v(v0, v1);
            }
    }
};
}

namespace att {
constexpr int D = 128, NW = 8, QBLK = 32, KVBLK = 64, QB = NW * QBLK;
constexpr int SHM_V = KVBLK * D * 2, SHM_K = KVBLK * D * 2;
constexpr int LDS_TB = 2 * SHM_V + 2 * SHM_K + NW * 64 * 4;
constexpr int LDS_TBX = LDS_TB + 12 * 128 * 4;
constexpr int TBXN = 544, TBX0 = 320;
constexpr int LDS_SEL = LDS_TBX + 12 * TBXN * 4;
constexpr int LDS_PSLC = LDS_TB + 12 * 128 * 4;
constexpr int BAND = 113;
constexpr float THR = 8.f;
#define KSWZ(row, colB) ((row) * 256 + ((colB) ^ (((row) & 7) << 4)))
#define SBAR() __builtin_amdgcn_sched_barrier(0)
__device__ __forceinline__ int v_st(int k, int c) { const int kk = (k & ~0xC) | ((k & 4) << 1) | ((k & 8) >> 1); return ((kk >> 3) * 4 + (c >> 5)) * 512 + ((kk & 7) * 32 + (c & 31)) * 2; }
__device__ __forceinline__ int v_rd_base(int lane) { return ((lane & 3) << 3) | (((lane >> 2) & 3) << 6) | (((lane >> 4) & 1) << 5) | (((lane >> 5) & 1) << 8); }
constexpr int v_rd_off(int d0, int ks, int half) { return d0 * 512 + ks * 4096 + half * 2048; }
__device__ __forceinline__ int crow(int r, int hi) { return (r & 3) + 8 * (r >> 2) + 4 * hi; }
__device__ __forceinline__ bf16x8 load8(const bf16_t* p) { return *reinterpret_cast<const bf16x8*>(p); }

__device__ __forceinline__ void bias_mask_tile(f32x16& p0, f32x16& p1, int dq, unsigned W, const float* tbx) {
    const float NEG = -__builtin_inff();
    const float* bp = tbx + (dq - 63);
#pragma unroll
    for (int r = 0; r < 16; ++r) {
        const int c = (r & 3) + 8 * (r >> 2);
        const unsigned r0 = (unsigned)(dq - c), r1 = (unsigned)(dq - c - 32);
        const float b0 = bp[63 - c], b1 = bp[31 - c];
        p0[r] = r0 >= W ? NEG : p0[r] + b0;
        p1[r] = r1 >= W ? NEG : p1[r] + b1;
        if ((r & 3) == 3) __builtin_amdgcn_sched_barrier(0);
    }
}
__device__ __forceinline__ void mask_tile(f32x16& p0, f32x16& p1, int dq, unsigned W) {
    const float NEG = -__builtin_inff();
#pragma unroll
    for (int r = 0; r < 16; ++r) {
        const int c = (r & 3) + 8 * (r >> 2);
        if ((unsigned)(dq - c) >= W) p0[r] = NEG;
        if ((unsigned)(dq - c - 32) >= W) p1[r] = NEG;
    }
}
__device__ __forceinline__ void partialSM(f32x16& p0, f32x16& p1, float& m_reg, float& mn, float& alpha) {
    float pmax = p0[0];
#pragma unroll
    for (int r = 1; r < 16; ++r) pmax = fmaxf(pmax, p0[r]);
#pragma unroll
    for (int r = 0; r < 16; ++r) pmax = fmaxf(pmax, p1[r]);
    { auto rr = __builtin_amdgcn_permlane32_swap(__float_as_uint(pmax), __float_as_uint(pmax), false, false);
      pmax = fmaxf(__uint_as_float(rr[0]), __uint_as_float(rr[1])); }
    constexpr float C2 = 1.4426950408889634f * SM_SCALE;
    if (__builtin_expect(__all((pmax - m_reg) * SM_SCALE <= THR), 1)) { mn = m_reg; alpha = 1.f; }
    else { mn = fmaxf(m_reg, pmax); alpha = __builtin_amdgcn_exp2f((m_reg - mn) * C2); m_reg = mn; }
    const float mnL = -mn * C2;
#pragma unroll
    for (int r = 0; r < 16; ++r) p0[r] = fmaf(p0[r], C2, mnL);
#pragma unroll
    for (int r = 0; r < 16; ++r) p1[r] = fmaf(p1[r], C2, mnL);
#pragma unroll
    for (int r = 0; r < 16; ++r) p0[r] = __builtin_amdgcn_exp2f(p0[r]);
}
#define PK4(P, B_, OUT) do { unsigned a0 = cvtpk(P[B_+0], P[B_+1]), a1 = cvtpk(P[B_+2], P[B_+3]);                          \
        unsigned b0 = cvtpk(P[B_+4], P[B_+5]), b1 = cvtpk(P[B_+6], P[B_+7]);                                             \
        auto r0 = __builtin_amdgcn_permlane32_swap(a0, b0, false, false); auto r1 = __builtin_amdgcn_permlane32_swap(a1, b1, false, false); \
        u32x4 w = {r0[0], r1[0], r0[1], r1[1]}; OUT = *reinterpret_cast<bf16x8*>(&w); } while (0)
__device__ __forceinline__ void finishSM(f32x16& p0, f32x16& p1, float alpha, float& l_reg, bf16x8& pa0, bf16x8& pa1, bf16x8& pa2, bf16x8& pa3) {
#pragma unroll
    for (int r = 0; r < 16; ++r) p1[r] = __builtin_amdgcn_exp2f(p1[r]);
    float ps = 0;
#pragma unroll
    for (int r = 0; r < 16; ++r) ps += p0[r];
#pragma unroll
    for (int r = 0; r < 16; ++r) ps += p1[r];
    { auto rr = __builtin_amdgcn_permlane32_swap(__float_as_uint(ps), __float_as_uint(ps), false, false);
      ps = __uint_as_float(rr[0]) + __uint_as_float(rr[1]); }
    l_reg = l_reg * alpha + ps;
    PK4(p0, 0, pa0); PK4(p0, 8, pa1); PK4(p1, 0, pa2); PK4(p1, 8, pa3);
}
template <int KB, bool SK>
__device__ __forceinline__ void qkt(f32x16& p0, f32x16& p1, const char* K_lds, int r32, int hi, const bf16x8* qr, bool act) {
    if (SK && !act) return;
    p0 = f32x16{}; p1 = f32x16{};
    const char* kb[4];
#pragma unroll
    for (int dd = 0; dd < 4; ++dd) kb[dd] = K_lds + KB * SHM_K + KSWZ(r32, (dd * 16 + hi * 8) * 2);
#pragma unroll
    for (int d0 = 0; d0 < 8; ++d0) { const char* a = kb[d0 & 3] + (d0 >> 2) * 128;
        bf16x8 b0 = *reinterpret_cast<const bf16x8*>(a);
        bf16x8 b1 = *reinterpret_cast<const bf16x8*>(a + 32 * 256);
        p0 = __builtin_amdgcn_mfma_f32_32x32x16_bf16(b0, qr[d0], p0, 0, 0, 0);
        p1 = __builtin_amdgcn_mfma_f32_32x32x16_bf16(b1, qr[d0], p1, 0, 0, 0); }
}
template <int VB, bool SK>
__device__ __forceinline__ void pv_tile(f32x16* o, int vb0, bf16x8 pa0, bf16x8 pa1, bf16x8 pa2, bf16x8 pa3, bool act) {
    if (SK && !act) return;
#define TRRD(dst, off) asm volatile("ds_read_b64_tr_b16 %0, %1 offset:%2" : "=&v"(dst) : "v"(vb0), "i"(off) : "memory")
#define PV_D0(d0) do { s16x4 l0, l1, l2, l3, h0, h1, h2, h3; constexpr int b_ = VB * SHM_V + v_rd_off(d0, 0, 0); \
        TRRD(l0, b_); TRRD(h0, b_ + 2048); TRRD(l1, b_ + 4096); TRRD(h1, b_ + 6144); TRRD(l2, b_ + 8192); TRRD(h2, b_ + 10240); TRRD(l3, b_ + 12288); TRRD(h3, b_ + 14336); \
        asm volatile("s_waitcnt lgkmcnt(0)" ::: "memory"); SBAR();   \
        o[d0] = __builtin_amdgcn_mfma_f32_32x32x16_bf16(pa0, (bf16x8){l0[0], l0[1], l0[2], l0[3], h0[0], h0[1], h0[2], h0[3]}, o[d0], 0, 0, 0);   \
        o[d0] = __builtin_amdgcn_mfma_f32_32x32x16_bf16(pa1, (bf16x8){l1[0], l1[1], l1[2], l1[3], h1[0], h1[1], h1[2], h1[3]}, o[d0], 0, 0, 0);   \
        o[d0] = __builtin_amdgcn_mfma_f32_32x32x16_bf16(pa2, (bf16x8){l2[0], l2[1], l2[2], l2[3], h2[0], h2[1], h2[2], h2[3]}, o[d0], 0, 0, 0);   \
        o[d0] = __builtin_amdgcn_mfma_f32_32x32x16_bf16(pa3, (bf16x8){l3[0], l3[1], l3[2], l3[3], h3[0], h3[1], h3[2], h3[3]}, o[d0], 0, 0, 0); } while (0)
    PV_D0(0); PV_D0(1); PV_D0(2); PV_D0(3);
#undef PV_D0
#undef TRRD
}

__device__ __forceinline__ void pv_tile2(f32x16* o, f32x16* o2, int vb0, bf16x8 pa0, bf16x8 pa1, bf16x8 pa2, bf16x8 pa3) {
#define TRRD(dst, off) asm volatile("ds_read_b64_tr_b16 %0, %1 offset:%2" : "=&v"(dst) : "v"(vb0), "i"(off) : "memory")
#define PV2_D0(d0) do { s16x4 l0, l1, l2, l3, h0, h1, h2, h3, L0, L1, L2, L3, H0, H1, H2, H3; constexpr int b_ = v_rd_off(d0, 0, 0), c_ = SHM_V + v_rd_off(d0, 0, 0); \
        TRRD(l0, b_); TRRD(h0, b_ + 2048); TRRD(L0, c_); TRRD(H0, c_ + 2048); TRRD(l1, b_ + 4096); TRRD(h1, b_ + 6144); TRRD(L1, c_ + 4096); TRRD(H1, c_ + 6144); \
        TRRD(l2, b_ + 8192); TRRD(h2, b_ + 10240); TRRD(L2, c_ + 8192); TRRD(H2, c_ + 10240); TRRD(l3, b_ + 12288); TRRD(h3, b_ + 14336); TRRD(L3, c_ + 12288); TRRD(H3, c_ + 14336); \
        asm volatile("s_waitcnt lgkmcnt(0)" ::: "memory"); SBAR();   \
        o[d0]  = __builtin_amdgcn_mfma_f32_32x32x16_bf16(pa0, (bf16x8){l0[0], l0[1], l0[2], l0[3], h0[0], h0[1], h0[2], h0[3]}, o[d0], 0, 0, 0);   \
        o2[d0] = __builtin_amdgcn_mfma_f32_32x32x16_bf16(pa0, (bf16x8){L0[0], L0[1], L0[2], L0[3], H0[0], H0[1], H0[2], H0[3]}, o2[d0], 0, 0, 0);  \
        o[d0]  = __builtin_amdgcn_mfma_f32_32x32x16_bf16(pa1, (bf16x8){l1[0], l1[1], l1[2], l1[3], h1[0], h1[1], h1[2], h1[3]}, o[d0], 0, 0, 0);   \
        o2[d0] = __builtin_amdgcn_mfma_f32_32x32x16_bf16(pa1, (bf16x8){L1[0], L1[1], L1[2], L1[3], H1[0], H1[1], H1[2], H1[3]}, o2[d0], 0, 0, 0);  \
        o[d0]  = __builtin_amdgcn_mfma_f32_32x32x16_bf16(pa2, (bf16x8){l2[0], l2[1], l2[2], l2[3], h2[0], h2[1], h2[2], h2[3]}, o[d0], 0, 0, 0);   \
        o2[d0] = __builtin_amdgcn_mfma_f32_32x32x16_bf16(pa2, (bf16x8){L2[0], L2[1], L2[2], L2[3], H2[0], H2[1], H2[2], H2[3]}, o2[d0], 0, 0, 0);  \
        o[d0]  = __builtin_amdgcn_mfma_f32_32x32x16_bf16(pa3, (bf16x8){l3[0], l3[1], l3[2], l3[3], h3[0], h3[1], h3[2], h3[3]}, o[d0], 0, 0, 0);   \
        o2[d0] = __builtin_amdgcn_mfma_f32_32x32x16_bf16(pa3, (bf16x8){L3[0], L3[1], L3[2], L3[3], H3[0], H3[1], H3[2], H3[3]}, o2[d0], 0, 0, 0); } while (0)
    PV2_D0(0); PV2_D0(1); PV2_D0(2); PV2_D0(3);
#undef PV2_D0
#undef TRRD
}

struct BlockRef { const bf16_t* Q; const bf16_t* K; const bf16_t* V; bf16_t* O; int P0; const float* tb; const unsigned* sel; const bf16_t* V2; bf16_t* O2; };
struct Seam { bf16x8 qr[8]; bf16x8 st_v0, st_v1, st_k0, st_k1; };
__device__ __forceinline__ int swa_jlo(int P0, int W) { const int lowk = P0 - W + 1; return lowk > 0 ? lowk / KVBLK : 0; }
#define ROW(p, k0, rr) ((const bf16_t*)((const char*)((p) + (size_t)((k0) + ((rr) - sr)) * D) + loff))
#define VMW() asm volatile("s_waitcnt vmcnt(0)" ::: "memory")
#define VMWN(n) asm volatile("s_waitcnt vmcnt(%0)" :: "i"(n) : "memory")
#define SLOAD_H(Kp, Vp, k0) do { S.st_v0 = load8(ROW(Vp, k0, sr)); S.st_v1 = load8(ROW(Vp, k0, 32 + sr));              \
                         S.st_k0 = load8(ROW(Kp, k0, sr)); S.st_k1 = load8(ROW(Kp, k0, 32 + sr)); } while (0)
#define SWRITE_HK(bf) do { *(bf16x8*)(K_lds + (bf) * SHM_K + kws) = S.st_k0; *(bf16x8*)(K_lds + (bf) * SHM_K + kws + 32 * 256) = S.st_k1; } while (0)
#define SWRITE_HV(bf) do { *(bf16x8*)(V_lds + (bf) * SHM_V + vst0) = S.st_v0; *(bf16x8*)(V_lds + (bf) * SHM_V + vst1) = S.st_v1; } while (0)
#define SWRITE_H(bf) do { SWRITE_HV(bf); SWRITE_HK(bf); } while (0)
template <int MODE> __device__ __forceinline__ int mode_w() { return MODE == 1 ? 512 : (1 << 30); }
template <int MODE> __device__ __forceinline__ size_t qrow_off(int wid, int r) { return MODE == 2 ? ((size_t)(r >> 3) * SEQ + wid * 8 + (r & 7)) * D : (size_t)(wid * QBLK + r) * D; }
__device__ __forceinline__ void sel_stage(const BlockRef& b, char* lds, int par, int wid) {
    const int tid = wid * 64 + lane_id();
    if (tid < 128) { const u32x4 w = *(const u32x4*)(b.sel + (size_t)(b.P0 + (tid >> 1)) * 8 + (tid & 1) * 4);
        *(u32x4*)(lds + LDS_SEL + par * 2048 + (tid >> 1) * 32 + (tid & 1) * 16) = w; }
}
template <int MODE>
__device__ __forceinline__ void attn_prime(const BlockRef& cur, char* lds, Seam& S, int par, const int wid) {
    const int W = mode_w<MODE>();
    const int lane = lane_id(), tid = wid * 64 + lane, r32 = lane & 31, hi = lane >> 5;
    const int sr = tid >> 4, sc = (tid & 15) * 8, kws = KSWZ(sr, sc * 2); char* K_lds = lds + 2 * SHM_V;
    const unsigned loff = (unsigned)(sr * D + sc) * 2u;
    const int kb0 = swa_jlo(cur.P0, W) * KVBLK;
#pragma unroll
    for (int d0 = 0; d0 < 8; ++d0) S.qr[d0] = load8(cur.Q + qrow_off<MODE>(wid, r32) + d0 * 16 + hi * 8);
    if (MODE == 2) sel_stage(cur, lds, par, wid);
    SLOAD_H(cur.K, cur.V, kb0); VMW(); SWRITE_HK(0);
    __syncthreads();
}
template <int MODE>
__device__ __forceinline__ void attn_block(const BlockRef& cur, const BlockRef& nxt, char* lds, Seam& S, int par, const int wid) {
    constexpr bool SK = MODE == 2;
    const int W = mode_w<MODE>();
    const int lane = lane_id(), tid = wid * 64 + lane, r32 = lane & 31, hi = lane >> 5;
    const int j_lo = swa_jlo(cur.P0, W);
    constexpr int WROWS = MODE == 2 ? 8 : QBLK, BROWS = MODE == 2 ? 64 : QB;
    const int j_hi = (cur.P0 + BROWS - 1) / KVBLK + 1;
    const int NT = j_hi - j_lo;
    const int kbn = swa_jlo(nxt.P0, W) * KVBLK;
    const int qlo = cur.P0 + wid * WROWS, qm = qlo + (MODE == 2 ? (r32 & 7) : r32) - 4 * hi;
    char* V_lds = lds; char* K_lds = lds + 2 * SHM_V;
    float* ws = (float*)(lds + 2 * SHM_V + 2 * SHM_K) + wid * 64; float* li_l = ws, * al_l = ws + 32;
    const float* tb = cur.tb + (MODE == 2 ? (r32 >> 3) * TBXN : 0);
    const unsigned* selrow = (const unsigned*)(lds + LDS_SEL + par * 2048) + (wid * 8 + (r32 & 7)) * 8;
    unsigned selw = 0u;
    float m_reg = -1e30f, l_reg = 0; f32x16 o[4] = {};
    const int sr = tid >> 4, sc = (tid & 15) * 8, vst0 = v_st(sr, sc), vst1 = v_st(32 + sr, sc), kws = KSWZ(sr, sc * 2);
    const unsigned loff = (unsigned)(sr * D + sc) * 2u;
    const int vb0 = (int)(uintptr_t)V_lds + v_rd_base(lane);
    const bf16_t* Kh = cur.K; const bf16_t* Vh = cur.V;
#define RESC(a) do { if (__any((a) < 1.f)) { if (hi == 0) al_l[r32] = (a); asm volatile("s_waitcnt lgkmcnt(0)" ::: "memory");              \
                     for (int d_ = 0; d_ < 4; ++d_) for (int r = 0; r < 16; ++r) o[d_][r] *= al_l[crow(r, hi)]; } } while (0)
#define KBASE(t) ((j_lo + (t)) * KVBLK)
#define GEOACT(t) (KBASE(t) <= qlo + WROWS - 1 && KBASE(t) + KVBLK - 1 >= qlo - W + 1)
#define SETACT(actX, bitX, t) do { if (MODE == 2) { const int j_ = j_lo + (t); if ((j_ & 31) == 0 || (t) == 0) selw = selrow[j_ >> 5]; \
                                   actX = GEOACT(t) && __any(((selw >> (j_ & 31)) & 1u) != 0u); } else { actX = GEOACT(t); } } while (0)
#define MASKT(P0_, P1_, actX, bitX, t) do { const int kb_ = KBASE(t); if (!SK || actX) {                                             \
        if (kb_ + KVBLK - 1 + BAND > qlo) bias_mask_tile(P0_, P1_, qm - kb_, (unsigned)W, tb);                                        \
        else if (MODE == 1 && kb_ <= qlo + WROWS - 1 - W) mask_tile(P0_, P1_, qm - kb_, (unsigned)W);                                  \
        if (MODE == 2) { if (((selw >> ((j_lo + (t)) & 31)) & 1u) == 0u) { const float NEG_ = -__builtin_inff(); _Pragma("unroll") for (int r_ = 0; r_ < 16; ++r_) { P0_[r_] = NEG_; P1_[r_] = NEG_; } } } } } while (0)
    constexpr int NQL = 8;
#define SEAM_K0() do { VMWN(NQL); SWRITE_HK(0); SBAR(); } while (0)
    f32x16 pA0, pA1, pB0, pB1; float mnA, mnB, alA, alB; bf16x8 pa0, pa1, pa2, pa3;
    bool actA = true, actB = true; unsigned bitA = 1u, bitB = 1u;
    SWRITE_HV(0); SBAR();
    if (NT > 1) { SLOAD_H(Kh, Vh, KBASE(1)); }
    SETACT(actA, bitA, 0);
    SBAR(); qkt<0, SK>(pA0, pA1, K_lds, r32, hi, S.qr, actA);
    if (!SK || actA) { MASKT(pA0, pA1, actA, bitA, 0); partialSM(pA0, pA1, m_reg, mnA, alA); } else alA = 1.f;
    if (NT > 1) { VMW(); SWRITE_H(1); }
    __syncthreads();
#define HALF_STEP(PX0, PX1, mnX, alX, actX, bitX, PY0, PY1, alY, actY, t, KB, VB, SB) do {                                    \
        SETACT(actX, bitX, t);                                                                                                \
        SBAR(); qkt<KB, SK>(PX0, PX1, K_lds, r32, hi, S.qr, actX);                                                            \
        if (!SK || actY) finishSM(PY0, PY1, alY, l_reg, pa0, pa1, pa2, pa3); SBAR();                                          \
        if ((t) + 1 < NT) { SLOAD_H(Kh, Vh, KBASE((t) + 1)); SBAR(); }                                                        \
        pv_tile<VB, SK>(o, vb0, pa0, pa1, pa2, pa3, actY);                                                                    \
        if (!SK || actX) { MASKT(PX0, PX1, actX, bitX, (t)); partialSM(PX0, PX1, m_reg, mnX, alX); } else alX = 1.f;          \
        __syncthreads();                                                                                                      \
        if ((t) + 1 < NT) { VMW(); SWRITE_H(SB); }                                                                            \
        RESC(alX); __syncthreads(); } while (0)
    for (int t = 1; t + 1 < NT; t += 2) {
        HALF_STEP(pB0, pB1, mnB, alB, actB, bitB, pA0, pA1, alA, actA, t, 1, 0, 0);
        HALF_STEP(pA0, pA1, mnA, alA, actA, bitA, pB0, pB1, alB, actB, t + 1, 0, 1, 1);
    }
    const bool even = (NT & 1) == 0;
    if (even) { SETACT(actB, bitB, NT - 1); SBAR(); qkt<1, SK>(pB0, pB1, K_lds, r32, hi, S.qr, actB); SBAR(); }
    SLOAD_H(nxt.K, nxt.V, kbn); SBAR();
#pragma unroll
    for (int d0 = 0; d0 < 8; ++d0) S.qr[d0] = load8(nxt.Q + qrow_off<MODE>(wid, r32) + d0 * 16 + hi * 8);
    SBAR();
    if (!SK || actA) finishSM(pA0, pA1, alA, l_reg, pa0, pa1, pa2, pa3); SBAR();
    pv_tile<0, SK>(o, vb0, pa0, pa1, pa2, pa3, actA);
    if (even) { if (!SK || actB) { MASKT(pB0, pB1, actB, bitB, NT - 1); partialSM(pB0, pB1, m_reg, mnB, alB); } else alB = 1.f; __syncthreads(); RESC(alB);
        if (!SK || actB) finishSM(pB0, pB1, alB, l_reg, pa0, pa1, pa2, pa3); SBAR(); pv_tile<1, SK>(o, vb0, pa0, pa1, pa2, pa3, actB); }
    SBAR(); SEAM_K0();
    if (hi == 0) li_l[r32] = l_reg; asm volatile("s_waitcnt lgkmcnt(0)" ::: "memory");
    float rli[16];
#pragma unroll
    for (int r = 0; r < 16; ++r) rli[r] = __builtin_amdgcn_rcpf(li_l[crow(r, hi)]);
#pragma unroll
    for (int r = 0; r < 16; ++r) { const int orow = crow(r, hi); bf16_t* Ow = cur.O + qrow_off<MODE>(wid, orow) - (size_t)orow * D;
#pragma unroll
        for (int d0 = 0; d0 < 4; ++d0) { const float v = o[d0][r] * rli[r];
            const float vn = xor1_(v);
            if ((r32 & 1) == 0) *(unsigned*)(Ow + (size_t)orow * D + d0 * 32 + r32) = cvtpk(v, vn); } }
    if (MODE == 2) sel_stage(nxt, lds, par ^ 1, wid);
    __syncthreads();
#undef RESC
#undef KBASE
#undef GEOACT
#undef SETACT
#undef MASKT
#undef SEAM_K0
#undef HALF_STEP
}
}


namespace att {
constexpr int A2_V = 0, A2_K = 3 * SHM_V, A2_WS = A2_K + 2 * SHM_K;
constexpr int A2_TBX = A2_WS + NW * 64 * 4;
constexpr int A2D_TBX = 3 * 2 * SHM_V + 2 * SHM_K + NW * 64 * 4;
constexpr int A2_SEL = A2_TBX + 12 * TBXN * 4;
__device__ __forceinline__ int swap23(int k) { return (k & ~0xC) | ((k & 4) << 1) | ((k & 8) >> 1); }
template <int MODE, bool DV2>
__device__ __forceinline__ void attn_block2(const BlockRef& cur, char* lds, const int wid) {
    constexpr int VST = DV2 ? 2 * SHM_V : SHM_V;
    constexpr int A2K = 3 * VST, A2WS = A2K + 2 * SHM_K, A2SEL = A2WS + NW * 64 * 4 + 12 * TBXN * 4;
    constexpr bool SK = MODE == 2;
    const int W = mode_w<MODE>();
    const int lane = lane_id(), tid = wid * 64 + lane, r32 = lane & 31, hi = lane >> 5;
    constexpr int WROWS = MODE == 2 ? 8 : QBLK, BROWS = MODE == 2 ? 64 : QB;
    const int j_lo = swa_jlo(cur.P0, W);
    const int j_hi = (cur.P0 + BROWS - 1) / KVBLK + 1;
    const int NT = j_hi - j_lo;
    const int qlo = cur.P0 + wid * WROWS, qm = qlo + (MODE == 2 ? (r32 & 7) : r32) - 4 * hi;
    char* V_lds = lds + A2_V; char* K_lds = lds + A2K;
    float* ws = (float*)(lds + A2WS) + wid * 64; float* li_l = ws, * al_l = ws + 32;
    const float* tb = cur.tb + (MODE == 2 ? (r32 >> 3) * TBXN : 0);
    const unsigned* selrow = (const unsigned*)(lds + A2SEL) + (wid * 8 + (r32 & 7)) * 8;
    unsigned selw = 0u;
    unsigned kgo[2], vgo[2];
#pragma unroll
    for (int i = 0; i < 2; ++i) { const int pc = 2 * wid + i;
        const int row = 4 * pc + (lane >> 4), c = (lane & 15) ^ (row & 7); kgo[i] = (unsigned)(row * 256 + c * 16);
        const int sub = 2 * pc + (lane >> 5), kk = (sub >> 2) * 8 + ((lane & 31) >> 2), k = swap23(kk), cc = (sub & 3) * 32 + (lane & 3) * 8; vgo[i] = (unsigned)(k * 256 + cc * 2); }
    bf16x8 qr[8];
#pragma unroll
    for (int d0 = 0; d0 < 8; ++d0) qr[d0] = load8(cur.Q + qrow_off<MODE>(wid, r32) + d0 * 16 + hi * 8);
    if (MODE == 2) { if (tid < 128) { const u32x4 w = *(const u32x4*)(cur.sel + (size_t)(cur.P0 + (tid >> 1)) * 8 + (tid & 1) * 4);
        *(u32x4*)(lds + A2SEL + (tid >> 1) * 32 + (tid & 1) * 16) = w; } }
    LAS unsigned char* ldsl = (LAS unsigned char*)lds;
    const char* Kg = (const char*)cur.K; const char* Vg = (const char*)cur.V; const char* Vg2 = (const char*)cur.V2;
#define A2_DMA(t_) do { const int t__ = (t_); const size_t go_ = (size_t)(j_lo + t__) * (KVBLK * D * 2);                                           \
        LAS unsigned char* kd_ = ldsl + A2K + (t__ & 1) * SHM_K + wid * 2048; LAS unsigned char* vd_ = ldsl + A2_V + (t__ % 3) * VST + wid * 2048;      \
        _Pragma("unroll") for (int i_ = 0; i_ < 2; ++i_) {                                                                                         \
            __builtin_amdgcn_global_load_lds((const unsigned*)(Kg + go_ + kgo[i_]), (LAS unsigned*)(kd_ + i_ * 1024), 16, 0, 0);                  \
            __builtin_amdgcn_global_load_lds((const unsigned*)(Vg + go_ + vgo[i_]), (LAS unsigned*)(vd_ + i_ * 1024), 16, 0, 0);                  \
            if (DV2) __builtin_amdgcn_global_load_lds((const unsigned*)(Vg2 + go_ + vgo[i_]), (LAS unsigned*)(vd_ + SHM_V + i_ * 1024), 16, 0, 0); } } while (0)
#define A2_BAR() do { asm volatile("s_waitcnt vmcnt(0) lgkmcnt(0)" ::: "memory"); __builtin_amdgcn_s_barrier(); asm volatile("" ::: "memory"); } while (0)
    A2_DMA(0);
    A2_BAR();
    float m_reg = -1e30f, l_reg = 0; f32x16 o[4] = {}; f32x16 o2[DV2 ? 4 : 1] = {};
    const int vbase = (int)(uintptr_t)V_lds + v_rd_base(lane);
#define RESC(a) do { if (__any((a) < 1.f)) { if (hi == 0) al_l[r32] = (a); asm volatile("s_waitcnt lgkmcnt(0)" ::: "memory");              \
                     for (int d_ = 0; d_ < 4; ++d_) for (int r = 0; r < 16; ++r) { const float f_ = al_l[crow(r, hi)]; o[d_][r] *= f_; if (DV2) o2[d_][r] *= f_; } } } while (0)
#define KBASE(t) ((j_lo + (t)) * KVBLK)
#define GEOACT(t) (KBASE(t) <= qlo + WROWS - 1 && KBASE(t) + KVBLK - 1 >= qlo - W + 1)
#define SETACT(actX, t) do { if (MODE == 2) { const int j_ = j_lo + (t); if ((j_ & 31) == 0 || (t) == 0) selw = selrow[j_ >> 5]; \
                                   actX = GEOACT(t) && __any(((selw >> (j_ & 31)) & 1u) != 0u); } else { actX = GEOACT(t); } } while (0)
#define MASKT(P0_, P1_, t) do { const int kb_ = KBASE(t);                                                                             \
        if (kb_ + KVBLK - 1 + BAND > qlo) bias_mask_tile(P0_, P1_, qm - kb_, (unsigned)W, tb);                                        \
        else if (MODE == 1 && kb_ <= qlo + WROWS - 1 - W) mask_tile(P0_, P1_, qm - kb_, (unsigned)W);                                  \
        if (MODE == 2) { if (((selw >> ((j_lo + (t)) & 31)) & 1u) == 0u) { const float NEG_ = -__builtin_inff(); _Pragma("unroll") for (int r_ = 0; r_ < 16; ++r_) { P0_[r_] = NEG_; P1_[r_] = NEG_; } } } } while (0)
    f32x16 pA0, pA1, pB0, pB1; float mnA, mnB, alA = 1.f, alB = 1.f; bf16x8 pa0, pa1, pa2, pa3;
    bool actA = true, actB = true;
    if (NT > 1) A2_DMA(1);
    SETACT(actA, 0);
    SBAR(); qkt<0, SK>(pA0, pA1, K_lds, r32, hi, qr, actA);
    if (!SK || actA) { MASKT(pA0, pA1, 0); partialSM(pA0, pA1, m_reg, mnA, alA); } else alA = 1.f;
    A2_BAR();
#define STEP2(PX0, PX1, mnX, alX, actX, PY0, PY1, alY, actY, t) do {                                                          \
        if ((t) + 1 < NT) A2_DMA((t) + 1);                                                                                    \
        SETACT(actX, t);                                                                                                      \
        SBAR(); qkt<0, SK>(PX0, PX1, K_lds + ((t) & 1) * SHM_K, r32, hi, qr, actX);                                           \
        if (!SK || actY) finishSM(PY0, PY1, alY, l_reg, pa0, pa1, pa2, pa3); SBAR();                                          \
        pv_tile<0, SK>(o, vbase + (((t) - 1) % 3) * VST, pa0, pa1, pa2, pa3, actY);                                           \
        if (DV2) pv_tile<0, SK>(o2, vbase + (((t) - 1) % 3) * VST + SHM_V, pa0, pa1, pa2, pa3, actY);                         \
        if (!SK || actX) { MASKT(PX0, PX1, (t)); partialSM(PX0, PX1, m_reg, mnX, alX); } else alX = 1.f;                      \
        RESC(alX);                                                                                                            \
        A2_BAR(); } while (0)
    int t = 1;
    for (; t + 1 < NT; t += 2) {
        STEP2(pB0, pB1, mnB, alB, actB, pA0, pA1, alA, actA, t);
        STEP2(pA0, pA1, mnA, alA, actA, pB0, pB1, alB, actB, t + 1);
    }
    if (t < NT) {
        STEP2(pB0, pB1, mnB, alB, actB, pA0, pA1, alA, actA, t);
        if (!SK || actB) finishSM(pB0, pB1, alB, l_reg, pa0, pa1, pa2, pa3); SBAR();
        pv_tile<0, SK>(o, vbase + ((NT - 1) % 3) * VST, pa0, pa1, pa2, pa3, actB);
        if (DV2) pv_tile<0, SK>(o2, vbase + ((NT - 1) % 3) * VST + SHM_V, pa0, pa1, pa2, pa3, actB);
    } else {
        if (!SK || actA) finishSM(pA0, pA1, alA, l_reg, pa0, pa1, pa2, pa3); SBAR();
        pv_tile<0, SK>(o, vbase + ((NT - 1) % 3) * VST, pa0, pa1, pa2, pa3, actA);
        if (DV2) pv_tile<0, SK>(o2, vbase + ((NT - 1) % 3) * VST + SHM_V, pa0, pa1, pa2, pa3, actA);
    }
    if (hi == 0) li_l[r32] = l_reg; asm volatile("s_waitcnt lgkmcnt(0)" ::: "memory");
    float rli[16];
#pragma unroll
    for (int r = 0; r < 16; ++r) rli[r] = __builtin_amdgcn_rcpf(li_l[crow(r, hi)]);
#pragma unroll
    for (int r = 0; r < 16; ++r) { const int orow = crow(r, hi); bf16_t* Ow = cur.O + qrow_off<MODE>(wid, orow);
#pragma unroll
        for (int d0 = 0; d0 < 4; ++d0) { const float v = o[d0][r] * rli[r];
            const float vn = xor1_(v);
            if ((r32 & 1) == 0) *(unsigned*)(Ow + d0 * 32 + r32) = cvtpk(v, vn);
            if (DV2) { const float v2 = o2[d0][r] * rli[r]; const float vn2 = xor1_(v2);
                if ((r32 & 1) == 0) *(unsigned*)(cur.O2 + qrow_off<MODE>(wid, orow) + d0 * 32 + r32) = cvtpk(v2, vn2); } } }
    A2_BAR();
#undef A2_DMA
#undef A2_BAR
#undef RESC
#undef KBASE
#undef GEOACT
#undef SETACT
#undef MASKT
#undef STEP2
}
}


namespace att {
constexpr int A3_V = 0, A3_K = 2 * 2 * SHM_V, A3_WS = A3_K + 2 * SHM_K;
constexpr int A3_TBX = A3_WS + NW * 64 * 4;
__device__ __forceinline__ void attn_block3(const BlockRef& cur, char* lds, const int wid) {
    const int lane = lane_id(), r32 = lane & 31, hi = lane >> 5;
    const int NT = (cur.P0 + QB - 1) / KVBLK + 1;
    const int qlo = cur.P0 + wid * QBLK, qm = qlo + r32 - 4 * hi;
    char* V_lds = lds + A3_V; char* K_lds = lds + A3_K;
    float* ws = (float*)(lds + A3_WS) + wid * 64; float* li_l = ws, * al_l = ws + 32;
    const float* tb = cur.tb;
    unsigned kgo[2], vgo[2];
#pragma unroll
    for (int i = 0; i < 2; ++i) { const int pc = 2 * wid + i;
        const int row = 4 * pc + (lane >> 4), c = (lane & 15) ^ (row & 7); kgo[i] = (unsigned)(row * 256 + c * 16);
        const int sub = 2 * pc + (lane >> 5), kk = (sub >> 2) * 8 + ((lane & 31) >> 2), k = swap23(kk), cc = (sub & 3) * 32 + (lane & 3) * 8; vgo[i] = (unsigned)(k * 256 + cc * 2); }
    bf16x8 qr[8];
#pragma unroll
    for (int d0 = 0; d0 < 8; ++d0) qr[d0] = load8(cur.Q + (size_t)(wid * QBLK + r32) * D + d0 * 16 + hi * 8);
    LAS unsigned char* ldsl = (LAS unsigned char*)lds;
    const char* Kg = (const char*)cur.K; const char* Vg = (const char*)cur.V; const char* Vg2 = (const char*)cur.V2;
#define A3_DMA(t_) do { const int t__ = (t_); const size_t go_ = (size_t)t__ * (KVBLK * D * 2);                                                   \
        LAS unsigned char* kd_ = ldsl + A3_K + (t__ & 1) * SHM_K + wid * 2048; LAS unsigned char* vd_ = ldsl + A3_V + (t__ & 1) * 2 * SHM_V + wid * 2048; \
        _Pragma("unroll") for (int i_ = 0; i_ < 2; ++i_) {                                                                                         \
            __builtin_amdgcn_global_load_lds((const unsigned*)(Kg + go_ + kgo[i_]), (LAS unsigned*)(kd_ + i_ * 1024), 16, 0, 0);                  \
            __builtin_amdgcn_global_load_lds((const unsigned*)(Vg + go_ + vgo[i_]), (LAS unsigned*)(vd_ + i_ * 1024), 16, 0, 0);                  \
            __builtin_amdgcn_global_load_lds((const unsigned*)(Vg2 + go_ + vgo[i_]), (LAS unsigned*)(vd_ + SHM_V + i_ * 1024), 16, 0, 0); } } while (0)
#define A3_BAR() do { asm volatile("s_waitcnt vmcnt(0) lgkmcnt(0)" ::: "memory"); __builtin_amdgcn_s_barrier(); asm volatile("" ::: "memory"); } while (0)
    A3_DMA(0);
    A3_BAR();
    float m_reg = -1e30f, l_reg = 0; f32x16 o[4] = {}, o2[4] = {};
    const int vbase = (int)(uintptr_t)V_lds + v_rd_base(lane);
    for (int t = 0; t < NT; ++t) {
        f32x16 p0, p1; float mn, alpha; bf16x8 pa0, pa1, pa2, pa3;
        const int kb = t * KVBLK;
        qkt<0, false>(p0, p1, K_lds + (t & 1) * SHM_K, r32, hi, qr, true);
        SBAR(); if (t + 1 < NT) A3_DMA(t + 1);
        SBAR();
        if (kb + KVBLK - 1 + BAND > qlo) bias_mask_tile(p0, p1, qm - kb, 1u << 30, tb);
        partialSM(p0, p1, m_reg, mn, alpha);
        if (__any(alpha < 1.f)) { if (hi == 0) al_l[r32] = alpha; asm volatile("s_waitcnt lgkmcnt(0)" ::: "memory");
#pragma unroll
            for (int d_ = 0; d_ < 4; ++d_)
#pragma unroll
                for (int r = 0; r < 16; ++r) { const float f_ = al_l[crow(r, hi)]; o[d_][r] *= f_; o2[d_][r] *= f_; } }
        finishSM(p0, p1, alpha, l_reg, pa0, pa1, pa2, pa3); SBAR();
        pv_tile2(o, o2, vbase + (t & 1) * 2 * SHM_V, pa0, pa1, pa2, pa3);
        A3_BAR();
    }
    if (hi == 0) li_l[r32] = l_reg; asm volatile("s_waitcnt lgkmcnt(0)" ::: "memory");
#pragma unroll
    for (int r = 0; r < 16; ++r) { const int orow = crow(r, hi); const float rli = __builtin_amdgcn_rcpf(li_l[orow]);
        const size_t ro = (size_t)(wid * QBLK + orow) * D;
#pragma unroll
        for (int d0 = 0; d0 < 4; ++d0) { const float v = o[d0][r] * rli, v2 = o2[d0][r] * rli; const float vn = xor1_(v), vn2 = xor1_(v2);
            if ((r32 & 1) == 0) { *(unsigned*)(cur.O + ro + d0 * 32 + r32) = cvtpk(v, vn); *(unsigned*)(cur.O2 + ro + d0 * 32 + r32) = cvtpk(v2, vn2); } } }
    A3_BAR();
#undef A3_DMA
#undef A3_BAR
}
}

namespace att {
__device__ __forceinline__ void cmp_bias_mask(f32x16& p0, f32x16& p1, int dq16, const float* tb) {
    const float NEG = -__builtin_inff();
#pragma unroll
    for (int r = 0; r < 16; ++r) {
        const int c = (r & 3) + 8 * (r >> 2);
        const int r0 = dq16 - 16 * c, r1 = dq16 - 16 * (c + 32);
        const float b0 = tb[(unsigned)r0 < 127u ? r0 : 127], b1 = tb[(unsigned)r1 < 127u ? r1 : 127];
        p0[r] = r0 < 0 ? NEG : p0[r] + b0;
        p1[r] = r1 < 0 ? NEG : p1[r] + b1;
    }
}
__device__ __forceinline__ void cmp_item(char* lds, unsigned char* wsb, float* d_oc_, int b, int g, int qb, const int wid) {
    constexpr float C2 = 1.4426950408889634f * SM_SCALE;
    const int lane = lane_id(), tid = wid * 64 + lane, r32 = lane & 31, hi = lane >> 5;
    const int t0 = qb * 64, head = r32 >> 3, ql = r32 & 7, h = g * 4 + head, t = t0 + wid * 8 + ql;
    const bf16_t* Q = (const bf16_t*)(wsb + WS_QN) + ((size_t)(b * 8 + h) * SEQ + t) * 128;
    const bf16_t* Kc = (const bf16_t*)(wsb + WS_KCMP) + (size_t)(b * 2 + g) * 1024 * 128;
    const bf16_t* Vc = (const bf16_t*)(wsb + WS_VCMP) + (size_t)(b * 2 + g) * 1024 * 128;
    char* V_lds = lds; char* K_lds = lds + 2 * SHM_V;
    float* pslc = (float*)(lds + LDS_PSLC);
    const float* tb = (const float*)(lds + LDS_TB) + h * 128;
    const int sr = tid >> 4, sc = (tid & 15) * 8, vst0 = v_st(sr, sc), vst1 = v_st(32 + sr, sc), kws = KSWZ(sr, sc * 2);
    const int vb0 = (int)(uintptr_t)V_lds + v_rd_base(lane);
    bf16x8 qr[8];
#pragma unroll
    for (int d0 = 0; d0 < 8; ++d0) qr[d0] = load8(Q + d0 * 16 + hi * 8);
    int nk = t0 / 16 + 3; if (nk > 1024) nk = 1024;
    const int NT = (nk + 63) >> 6;
    constexpr int PSS = 257;
    for (int i = tid; i < 64 * PSS; i += 512) pslc[i] = 0.f;
    float m = -1e30f, l = 0.f;
    bf16x8 k0 = load8(Kc + (size_t)sr * 128 + sc), k1 = load8(Kc + (size_t)(32 + sr) * 128 + sc), v0, v1;
#ifdef PROBE_CA
    for (int rp_ = 0; rp_ < 2; ++rp_) { m = -1e30f; l = 0.f;
#endif
    for (int j = 0; j < NT; ++j) {
        __syncthreads();
        *(bf16x8*)(K_lds + kws) = k0; *(bf16x8*)(K_lds + kws + 32 * 256) = k1;
        __syncthreads();
        { const int jn = j + 1 < NT ? j + 1 : 0;
          k0 = load8(Kc + (size_t)(64 * jn + sr) * 128 + sc); k1 = load8(Kc + (size_t)(64 * jn + 32 + sr) * 128 + sc); }
        f32x16 p0, p1;
        qkt<0, false>(p0, p1, K_lds, r32, hi, qr, true);
        if (1024 * j + 1152 > t0 + wid * 8) cmp_bias_mask(p0, p1, t - 31 - 16 * (64 * j + 4 * hi), tb);
        float pmax = p0[0];
#pragma unroll
        for (int r = 1; r < 16; ++r) pmax = fmaxf(pmax, p0[r]);
#pragma unroll
        for (int r = 0; r < 16; ++r) pmax = fmaxf(pmax, p1[r]);
        { auto rr = __builtin_amdgcn_permlane32_swap(__float_as_uint(pmax), __float_as_uint(pmax), false, false);
          pmax = fmaxf(__uint_as_float(rr[0]), __uint_as_float(rr[1])); }
        const float mn = fmaxf(m, pmax), mnL = -mn * C2;
        float ps = 0.f;
#pragma unroll
        for (int r = 0; r < 16; ++r) ps += __builtin_amdgcn_exp2f(fmaf(p0[r], C2, mnL)) + __builtin_amdgcn_exp2f(fmaf(p1[r], C2, mnL));
        { auto rr = __builtin_amdgcn_permlane32_swap(__float_as_uint(ps), __float_as_uint(ps), false, false);
          ps = __uint_as_float(rr[0]) + __uint_as_float(rr[1]); }
        l = l * __builtin_amdgcn_exp2f((m - mn) * C2) + ps; m = mn;
    }
#ifdef PROBE_CA
    }
#endif
    const float rl = l > 0.f ? 1.f / l : 0.f, mL = -m * C2;
    float pend = 0.f;
    f32x16 o[4] = {};
    v0 = load8(Vc + (size_t)sr * 128 + sc); v1 = load8(Vc + (size_t)(32 + sr) * 128 + sc);
#ifdef PROBE_CB
    for (int rp_ = 0; rp_ < 2; ++rp_) {
    if (rp_) { __syncthreads(); for (int i = tid; i < 64 * PSS; i += 512) pslc[i] = 0.f;
#pragma unroll
        for (int d_ = 0; d_ < 4; ++d_) o[d_] = f32x16{};
        k0 = load8(Kc + (size_t)sr * 128 + sc); k1 = load8(Kc + (size_t)(32 + sr) * 128 + sc); v0 = load8(Vc + (size_t)sr * 128 + sc); v1 = load8(Vc + (size_t)(32 + sr) * 128 + sc); }
#endif
    for (int j = 0; j < NT; ++j) {
        __syncthreads();
        *(bf16x8*)(K_lds + kws) = k0; *(bf16x8*)(K_lds + kws + 32 * 256) = k1;
        *(bf16x8*)(V_lds + vst0) = v0; *(bf16x8*)(V_lds + vst1) = v1;
        __syncthreads();
        if (j + 1 < NT) { k0 = load8(Kc + (size_t)(64 * (j + 1) + sr) * 128 + sc); k1 = load8(Kc + (size_t)(64 * (j + 1) + 32 + sr) * 128 + sc);
                          v0 = load8(Vc + (size_t)(64 * (j + 1) + sr) * 128 + sc); v1 = load8(Vc + (size_t)(64 * (j + 1) + 32 + sr) * 128 + sc); }
        f32x16 p0, p1;
        qkt<0, false>(p0, p1, K_lds, r32, hi, qr, true);
        if (1024 * j + 1152 > t0 + wid * 8) cmp_bias_mask(p0, p1, t - 31 - 16 * (64 * j + 4 * hi), tb);
#pragma unroll
        for (int r = 0; r < 16; ++r) { p0[r] = __builtin_amdgcn_exp2f(fmaf(p0[r], C2, mL)) * rl; p1[r] = __builtin_amdgcn_exp2f(fmaf(p1[r], C2, mL)) * rl; }
        float own[8], a1[8];
#pragma unroll
        for (int gi = 0; gi < 8; ++gi) {
            float a = gi < 4 ? p0[4 * gi] : p1[4 * (gi - 4)];
            float bs = gi < 4 ? (p0[4 * gi + 1] + p0[4 * gi + 2] + p0[4 * gi + 3]) : (p1[4 * (gi - 4) + 1] + p1[4 * (gi - 4) + 2] + p1[4 * (gi - 4) + 3]);
            float ow = a + 2.f * bs;
            ow += __int_as_float(__builtin_amdgcn_update_dpp(0, __float_as_int(ow), 0x128, 0xf, 0xf, false));
            a  += __int_as_float(__builtin_amdgcn_update_dpp(0, __float_as_int(a), 0x128, 0xf, 0xf, false));
            { auto rr = __builtin_amdgcn_permlane16_swap(__float_as_uint(ow), __float_as_uint(ow), false, false); ow = __uint_as_float(rr[0]) + __uint_as_float(rr[1]); }
            { auto rr = __builtin_amdgcn_permlane16_swap(__float_as_uint(a), __float_as_uint(a), false, false); a = __uint_as_float(rr[0]) + __uint_as_float(rr[1]); }
            own[gi] = ow; a1[gi] = a;
        }
        {
            float* prow = pslc + (wid * 8 + ql) * PSS + 16 * j + hi;
            float T[8];
#pragma unroll
            for (int gi = 0; gi < 8; ++gi) {
                auto rr = __builtin_amdgcn_permlane32_swap(__float_as_uint(a1[gi]), __float_as_uint(a1[gi < 7 ? gi + 1 : 7]), false, false);
                T[gi] = own[gi] + (hi == 0 ? __uint_as_float(rr[1]) : __uint_as_float(rr[0]));
            }
            { auto r0 = __builtin_amdgcn_permlane32_swap(0u, __float_as_uint(a1[0]), false, false);
              if (j > 0 && hi == 1 && head == 3) prow[-2] = pend + __uint_as_float(r0[0]); }
            const float t0_ = head == 0 ? T[0] : (head == 1 ? T[2] : (head == 2 ? T[4] : T[6]));
            const float t1_ = head == 0 ? T[1] : (head == 1 ? T[3] : (head == 2 ? T[5] : T[7]));
            const int g0 = 2 * head, bo0 = 2 * (g0 & 3) + 8 * (g0 >> 2);
            prow[bo0] = t0_;
            if (!(head == 3 && hi == 1)) prow[bo0 + 2] = t1_;
            pend = own[7];
        }
        bf16x8 pa0, pa1, pa2, pa3;
        PK4(p0, 0, pa0); PK4(p0, 8, pa1); PK4(p1, 0, pa2); PK4(p1, 8, pa3);
        pv_tile<0, false>(o, vb0, pa0, pa1, pa2, pa3, true);
    }
#ifdef PROBE_CB
    }
#endif
    if (hi == 1 && head == 3) pslc[(wid * 8 + ql) * PSS + 16 * (NT - 1) + 15] = pend;
    bf16_t* OC = (bf16_t*)d_oc_;
#pragma unroll
    for (int r = 0; r < 16; ++r) { const int orow = crow(r, hi), hr = orow >> 3, qr_ = orow & 7;
        bf16_t* dst = OC + ((size_t)(b * 8 + g * 4 + hr) * SEQ + t0 + wid * 8 + qr_) * 128;
#pragma unroll
        for (int d0 = 0; d0 < 4; ++d0) { const float v = o[d0][r]; const float vn = xor1_(v);
            if ((r32 & 1) == 0) *(unsigned*)(dst + d0 * 32 + r32) = cvtpk(v, vn); } }
    __syncthreads();
    unsigned* SELM = (unsigned*)(wsb + WS_SELM) + ((size_t)(b * 2 + g) * SEQ + t0) * 8;
    for (int qi = 0; qi < 8; ++qi) {
        const int q = wid * 8 + qi, jt = qb;
        unsigned key[4];
#pragma unroll
        for (int i4 = 0; i4 < 4; ++i4) { const int blk = lane + 64 * i4;
            const bool forced = (blk == 0) | (blk == jt) | (blk == jt - 1);
            const float v = forced ? 1e30f : (blk > jt ? -1e30f : pslc[q * PSS + blk]);
            key[i4] = v < 0.f ? 0u : __float_as_uint(v) + 1u; }
        unsigned prefix = 0u; int need = 16, matches = 256, sh = 0;
        for (int bit = 31; bit >= 0; --bit) {
            const unsigned cand = (prefix | (1u << bit)) >> bit;
            int c = 0;
#pragma unroll
            for (int i4 = 0; i4 < 4; ++i4) c += __popcll(__ballot((key[i4] >> bit) == cand));
            if (c >= need) { prefix |= 1u << bit; matches = c; } else { need -= c; matches -= c; }
            if (matches == need) { sh = bit; break; }
        }
        const unsigned pfx = prefix >> sh;
        unsigned long long selm[4]; int seen = 0;
#pragma unroll
        for (int i4 = 0; i4 < 4; ++i4) {
            const unsigned ks = key[i4] >> sh;
            const unsigned long long tie = __ballot(ks == pfx);
            const int rank = seen + __popcll(tie & ((1ull << lane) - 1ull));
            selm[i4] = __ballot(ks > pfx || (ks == pfx && rank < need));
            seen += __popcll(tie);
        }
        if (lane == 0) {
            u32x4 w0 = {(unsigned)selm[0], (unsigned)(selm[0] >> 32), (unsigned)selm[1], (unsigned)(selm[1] >> 32)};
            u32x4 w1 = {(unsigned)selm[2], (unsigned)(selm[2] >> 32), (unsigned)selm[3], (unsigned)(selm[3] >> 32)};
            *(u32x4*)(SELM + (size_t)q * 8) = w0; *(u32x4*)(SELM + (size_t)q * 8 + 4) = w1;
        }
    }
    __syncthreads();
}
}

constexpr int NPH = 15;
struct Args { const float* in[22]; float* out; unsigned char* ws; int ph_lo, ph_hi; };
enum { I_X = 0, I_NMG, I_WIN, I_PEK, I_PEV, I_W1K, I_W2K, I_W1V, I_W2V, I_LQ1, I_LK1, I_LQ2, I_LK2, I_HG, I_WUPN, I_WUPD, I_WOUT, I_NFG, I_WFFI, I_WFFO, I_TAB, I_NFIN };
constexpr size_t OC_OFF = 0, OS_OFF = (size_t)TOK * 1024 * 2, OW_OFF = 2 * OS_OFF;

template <int KIND> __device__ __forceinline__ int srcmap(int n) {
    if (KIND == 1) { return n < 2560 ? n : (n < 9728 ? n + 24 : (n < 9752 ? n - 9728 + 2560 : -1)); }
    if (KIND == 2) { const int tile = n >> 8, half = (n >> 7) & 1, j = n & 127; return half * DFF + tile * 128 + j; }
    if (KIND == 3) { return n < 128 ? n : -1; }
    return n;
}
template <int KIND>
__device__ __forceinline__ void transpose_item(const float* W, int K, int N, bf16_t* WT, int nblk, LAS float* scr, int item, int lane) {
    const int kb = item / nblk, nb = item % nblk, k0 = 64 * kb, n0 = 32 * nb;
    const int src = srcmap<KIND>(n0 + (lane & 31));
#pragma unroll 8
    for (int i = 0; i < 32; ++i) { const int kk = 2 * i + (lane >> 5); scr[kk * 33 + (lane & 31)] = src >= 0 ? W[(size_t)(k0 + kk) * N + src] : 0.f; }
    asm volatile("s_waitcnt lgkmcnt(0)" ::: "memory");
    const int c = lane & 7;
#pragma unroll
    for (int j = 0; j < 4; ++j) { const int n = (lane >> 3) + 8 * j; const LAS float* s = scr + (8 * c) * 33 + n;
        u32x4 o; o.x = cvtpk(s[0 * 33], s[1 * 33]); o.y = cvtpk(s[2 * 33], s[3 * 33]); o.z = cvtpk(s[4 * 33], s[5 * 33]); o.w = cvtpk(s[6 * 33], s[7 * 33]);
        *(u32x4*)(WT + (size_t)(n0 + n) * K + k0 + 8 * c) = o; }
    asm volatile("s_waitcnt lgkmcnt(0)" ::: "memory");
}
template <bool BF>
__device__ __forceinline__ void rms_row(const float* xrow, const float* g, void* orow, int lane) {
    const f32x4* xr = (const f32x4*)xrow + lane; const f32x4* gr = (const f32x4*)g + lane;
    f32x4 v[8]; float s = 0.f;
#pragma unroll
    for (int j = 0; j < 8; ++j) { v[j] = xr[64 * j]; s += (v[j].x * v[j].x + v[j].y * v[j].y) + (v[j].z * v[j].z + v[j].w * v[j].w); }
    const float rstd = rsqrtf(wave_sum(s) * (1.f / DM) + RMS_EPS);
#pragma unroll
    for (int j = 0; j < 8; ++j) { const f32x4 gg = gr[64 * j]; const f32x4 y = v[j] * rstd * gg;
        if (BF) { u32x2 w; w.x = cvtpk(y.x, y.y); w.y = cvtpk(y.z, y.w); ((u32x2*)orow)[64 * j + lane] = w; }
        else ((f32x4*)orow)[64 * j + lane] = y; }
}
__device__ __forceinline__ int t5_bucket(int n) {
    if (n < 16) return n;
    int l = 16 + (int)(logf((float)n / 16.f) / 2.0794415416798357f * 16.f);
    return l < 31 ? l : 31;
}
__device__ __forceinline__ void load_bias_tables(char* lds, const float* table, int tid0, int tbx_off = att::LDS_TBX) {
    float* tb = (float*)(lds + att::LDS_TB);
    for (int i = tid0; i < 12 * 128; i += 512) { const int h = i >> 7, rel = i & 127;
        tb[i] = (table[t5_bucket(rel) * 12 + h] - table[31 * 12 + h]) * (1.f / SM_SCALE); }
    float* tbx = (float*)(lds + tbx_off);
    for (int i = tid0; i < 12 * att::TBXN; i += 512) { const int h = i / att::TBXN, rel = i % att::TBXN - att::TBX0;
        tbx[i] = (rel >= 0 && rel < att::BAND) ? (table[t5_bucket(rel) * 12 + h] - table[31 * 12 + h]) * (1.f / SM_SCALE) : 0.f; }
    __syncthreads();
}

__global__ void __launch_bounds__(512, 2) mega_fwd(Args args) {
    extern __shared__ __attribute__((aligned(16))) unsigned char lds[];
    LAS unsigned char* ldsl = (LAS unsigned char*)lds;
    const int wave = __builtin_amdgcn_readfirstlane(threadIdx.x >> 6) & 7;
#define lane lane_id()
#define tid (wave * 64 + lane_id())
    const int G = gridDim.x, bx = blockIdx.x;
    const int gw = bx * 8 + wave, NGW = G * 8;
    unsigned char* ws = args.ws;
    const int lo = args.ph_lo, hi = args.ph_hi;
#ifndef PHASE_MASK
#define PHASE_MASK 0x7fff
#endif
#define IN(k) (lo <= (k) && (k) < hi && ((PHASE_MASK >> (k)) & 1))
#define SEAM(k) do { if (IN(k) && IN((k) + 1)) cg::this_grid().sync(); } while (0)
#ifndef DUP_MASK
#define DUP_MASK 0
#endif
#define REPS(k) for (int rep_ = 0; rep_ <= ((DUP_MASK >> (k)) & 1); ++rep_)
#define REPSYNC() do { if (rep_ == 0 && false) {} } while (0)
    const float* x = args.in[I_X];
    float* out = args.out;
    bf16_t* XN = (bf16_t*)(ws + WS_XN);

    REPS(0) if (IN(0)) {
        if (rep_) cg::this_grid().sync();
        LAS float* scr = (LAS float*)(ldsl + wave * 16384);
        constexpr int I0 = 32 * (NPROJ / 32), I1 = I0 + 32 * (2 * DFF / 32), I2 = I1 + (DFF / 64) * (DM / 32), I3 = I2 + 32 * (DM / 32), I4 = I3 + 16 * (DM / 32), I5 = I4 + 16 * (DM / 32),
                      I6 = I5 + 64 * 8, I7 = I6 + 64 * 8, I8 = I7 + 4 * 8, I9 = I8 + 4 * 8;
        for (int it = gw; it < I9; it += NGW) {
            if (it < I0)      transpose_item<1>(args.in[I_WIN], DM, NPROJ_SRC, (bf16_t*)(ws + WS_WIN), NPROJ / 32, scr, it, lane);
            else if (it < I1) transpose_item<2>(args.in[I_WFFI], DM, 2 * DFF, (bf16_t*)(ws + WS_WFFI), 2 * DFF / 32, scr, it - I0, lane);
            else if (it < I2) transpose_item<0>(args.in[I_WFFO], DFF, DM, (bf16_t*)(ws + WS_WFFO), DM / 32, scr, it - I1, lane);
            else if (it < I3) transpose_item<0>(args.in[I_WOUT], DM, DM, (bf16_t*)(ws + WS_WOUT), DM / 32, scr, it - I2, lane);
            else if (it < I4) transpose_item<0>(args.in[I_WUPN], 1024, DM, (bf16_t*)(ws + WS_WUPN), DM / 32, scr, it - I3, lane);
            else if (it < I5) transpose_item<0>(args.in[I_WUPD], 1024, DM, (bf16_t*)(ws + WS_WUPD), DM / 32, scr, it - I4, lane);
            else if (it < I6) transpose_item<0>(args.in[I_W1K], 4096, 256, (bf16_t*)(ws + WS_W1K), 8, scr, it - I5, lane);
            else if (it < I7) transpose_item<0>(args.in[I_W1V], 4096, 256, (bf16_t*)(ws + WS_W1V), 8, scr, it - I6, lane);
            else if (it < I8) transpose_item<3>(args.in[I_W2K], 256, 128, (bf16_t*)(ws + WS_W2K), 8, scr, it - I7, lane);
            else              transpose_item<3>(args.in[I_W2V], 256, 128, (bf16_t*)(ws + WS_W2V), 8, scr, it - I8, lane);
        }
        for (int m = gw; m < TOK; m += NGW) rms_row<true>(x + (size_t)m * DM, args.in[I_NMG], XN + (size_t)m * DM, lane);
        for (int o = gw; o < 512; o += NGW) {
            const int kv = o >> 8, n = o & 255; const float* pe = args.in[kv ? I_PEV : I_PEK]; const float* w1 = args.in[kv ? I_W1V : I_W1K];
            float s = 0.f; for (int k = lane; k < 4096; k += 64) s += pe[k] * w1[(size_t)k * 256 + n];
            s = wave_sum(s); if (lane == 0) ((float*)(ws + (kv ? WS_BV : WS_BK)))[n] = s;
        }
        if (bx == 0 && tid < 32) ((unsigned*)ws)[tid] = 0u;
        { const int gt = bx * 512 + tid;
          if (gt < 2048) { const int slab = gt >> 8, off = (gt & 255) * 8; bf16_t* p = (bf16_t*)(ws + (slab < 4 ? WS_KC : WS_VC)) + ((size_t)(slab & 3) * KCROWS + SEQ) * 128 + off;
              *(u32x4*)p = (u32x4){0u, 0u, 0u, 0u}; } }
    }
    SEAM(0);
#ifdef EXTRA_SYNCS
    for (int es = 0; es < EXTRA_SYNCS; ++es) cg::this_grid().sync();
#endif
    REPS(1) if (IN(1)) {
        if (rep_) cg::this_grid().sync();
        pg8::Gemm g{XN, (const bf16_t*)(ws + WS_WIN), TOK, NPROJ, DM, DM, TOK / 256, 0};
        pg8::StaticOrder S; S.init(TOK, NPROJ, G, bx);
        pg8::EpiProj E{ws};
        pg8::gemm_phase(ldsl, g, S, E, wave);
    }
    SEAM(1);
    REPS(2) if (IN(2) && !CMP_IN_P4) {
        if (rep_) cg::this_grid().sync();
        for (int kv = 0; kv < 2; ++kv) {
            pg8::Gemm g{(const bf16_t*)(ws + (kv ? WS_VC : WS_KC)), (const bf16_t*)(ws + (kv ? WS_W1V : WS_W1K)), 4096, 256, 4096, 2048, 4, (size_t)KCROWS * 128};
            pg8::StaticOrder S; S.init(4096, 256, G, (bx + 128 * kv) % G);
            pg8::EpiCmp1 E{(bf16_t*)(ws + (kv ? WS_HV : WS_HK)), (const float*)(ws + (kv ? WS_BV : WS_BK))};
            pg8::gemm_phase(ldsl, g, S, E, wave);
        }
    }
    if (!CMP_IN_P4) SEAM(2);
    REPS(3) if (IN(3) && !CMP_IN_P4) {
        if (rep_) cg::this_grid().sync();
        for (int kv = 0; kv < 2; ++kv) {
            pg8::Gemm g{(const bf16_t*)(ws + (kv ? WS_HV : WS_HK)), (const bf16_t*)(ws + (kv ? WS_W2V : WS_W2K)), 4096, 256, 256, 256, 16, 0};
            pg8::StaticOrder S; S.init(4096, 256, G, (bx + 128 * kv) % G);
            pg8::EpiCmp2 E{(bf16_t*)(ws + (kv ? WS_VCMP : WS_KCMP))};
            pg8::gemm_phase(ldsl, g, S, E, wave);
        }
    }
    if (!CMP_IN_P4) SEAM(3);
    REPS(4) if (IN(4)) {
        if (rep_) cg::this_grid().sync();
        if (CMP_IN_P4) {
            for (int u = bx; u < 32; u += G) {
                const int kv = u >> 4, pm = u & 15;
                {
                    const bf16_t* A = (const bf16_t*)(ws + (kv ? WS_VC : WS_KC)) + (size_t)(pm >> 2) * KCROWS * 128 + (size_t)(pm & 3) * 256 * 2048;
                    pg8::Gemm g{A, (const bf16_t*)(ws + (kv ? WS_W1V : WS_W1K)), 256, 256, 4096, 2048, 1, 0};
                    pg8::StaticOrder S; S.init(256, 256, 1, 0);
                    pg8::EpiCmp1 E{(bf16_t*)(ws + (kv ? WS_HV : WS_HK)) + (size_t)pm * 256 * 256, (const float*)(ws + (kv ? WS_BV : WS_BK))};
                    pg8::gemm_phase(ldsl, g, S, E, wave);
                }
                __builtin_amdgcn_fence(__ATOMIC_RELEASE, "agent"); asm volatile("s_waitcnt vmcnt(0)" ::: "memory"); __syncthreads(); __builtin_amdgcn_fence(__ATOMIC_ACQUIRE, "agent");
                {
                    pg8::Gemm g{(const bf16_t*)(ws + (kv ? WS_HV : WS_HK)) + (size_t)pm * 256 * 256, (const bf16_t*)(ws + (kv ? WS_W2V : WS_W2K)), 256, 256, 256, 256, 1, 0};
                    pg8::StaticOrder S; S.init(256, 256, 1, 0);
                    pg8::EpiCmp2 E{(bf16_t*)(ws + (kv ? WS_VCMP : WS_KCMP)) + (size_t)pm * 256 * 128};
                    pg8::gemm_phase(ldsl, g, S, E, wave);
                }
            }
            __syncthreads();
        }
        load_bias_tables((char*)lds, args.in[I_TAB], wave * 64 + lane_id(), att::A3_TBX);
        const bf16_t* QD = (const bf16_t*)(ws + WS_QD); const bf16_t* KD = (const bf16_t*)(ws + WS_KD); const bf16_t* VD = (const bf16_t*)(ws + WS_VD);
        bf16_t* O12 = (bf16_t*)(ws + WS_O12);
        const int total = 16 * 32 * 2;
        auto ref = [&](int idx) { const int L = idx >> 1, pass = idx & 1, vq = (G == 256) ? (L >> 8) * 8 + (L & 7) : (L >> 5), xx = (G == 256) ? ((L >> 3) & 31) : (L & 31), qb = pass ? 63 - xx : xx;
            const int bh = vq >> 1;
            att::BlockRef r; r.Q = QD + ((size_t)vq * SEQ + (size_t)qb * 256) * 128; r.K = KD + (size_t)vq * SEQ * 128;
            r.V = VD + (size_t)(bh * 2) * SEQ * 128; r.V2 = VD + (size_t)(bh * 2 + 1) * SEQ * 128;
            r.O = O12 + ((size_t)(vq * 2) * SEQ + (size_t)qb * 256) * 128; r.O2 = O12 + ((size_t)(vq * 2 + 1) * SEQ + (size_t)qb * 256) * 128; r.P0 = qb * 256;
            r.tb = (const float*)(lds + att::A3_TBX) + (8 + (bh & 3)) * att::TBXN + att::TBX0; r.sel = nullptr; return r; };
        (void)total;
        auto refq = [&](int vq, int qb) { const int bh = vq >> 1;
            att::BlockRef r; r.Q = QD + ((size_t)vq * SEQ + (size_t)qb * 256) * 128; r.K = KD + (size_t)vq * SEQ * 128;
            r.V = VD + (size_t)(bh * 2) * SEQ * 128; r.V2 = VD + (size_t)(bh * 2 + 1) * SEQ * 128;
            r.O = O12 + ((size_t)(vq * 2) * SEQ + (size_t)qb * 256) * 128; r.O2 = O12 + ((size_t)(vq * 2 + 1) * SEQ + (size_t)qb * 256) * 128; r.P0 = qb * 256;
            r.tb = (const float*)(lds + att::A3_TBX) + (8 + (bh & 3)) * att::TBXN + att::TBX0; r.sel = nullptr; return r; };
        unsigned* qctr = (unsigned*)ws; volatile unsigned* qw = (volatile unsigned*)(lds + LDS_BYTES - 16);
        for (int qi = 0; qi < 16; ++qi) {
            const int vq = qi == 0 ? (bx & 7) : (qi == 1 ? 8 + (bx & 7) : ((qi & 1) ? 0 : 8) + (((bx & 7) + (qi >> 1)) & 7));
            for (;;) {
                __syncthreads();
                if (tid == 0) *qw = atomicAdd(qctr + vq, 1u);
                __syncthreads();
                const unsigned w = (unsigned)__builtin_amdgcn_readfirstlane((int)*qw);
                if (w >= 64u) break;
                att::attn_block3(refq(vq, 63 - (int)w), (char*)lds, wave);
            }
        }
    }
    asm volatile("" ::: "memory");
    REPS(15) if (IN(4)) {
        if (rep_) cg::this_grid().sync();
        __syncthreads();
        load_bias_tables((char*)lds, args.in[I_TAB], wave * 64 + lane_id(), att::A2_TBX);
        const bf16_t* QN = (const bf16_t*)(ws + WS_QN);
#ifndef NO_WIN
        {
            const bf16_t* KW = (const bf16_t*)(ws + WS_KW); const bf16_t* VW = (const bf16_t*)(ws + WS_VW); bf16_t* OW = (bf16_t*)((char*)out + OW_OFF);
            const int total = 16 * 64;
            auto ref = [&](int L) { const int bh = L >> 6, qb = L & 63, kvh = (bh >> 3) * 2 + ((bh & 7) >> 2);
                att::BlockRef r; r.Q = QN + ((size_t)bh * SEQ + (size_t)qb * 256) * 128; r.K = KW + (size_t)kvh * SEQ * 128; r.V = VW + (size_t)kvh * SEQ * 128;
                r.O = OW + ((size_t)bh * SEQ + (size_t)qb * 256) * 128; r.P0 = qb * 256; r.tb = (const float*)(lds + att::A2_TBX) + (bh & 7) * att::TBXN + att::TBX0; r.sel = nullptr; r.V2 = nullptr; r.O2 = nullptr; return r; };
            {
                unsigned* qctr = (unsigned*)ws + 24; volatile unsigned* qw = (volatile unsigned*)(lds + LDS_BYTES - 16);
                for (;;) {
                    __syncthreads();
                    if (tid == 0) *qw = atomicAdd(qctr, 1u);
                    __syncthreads();
                    const unsigned w = (unsigned)__builtin_amdgcn_readfirstlane((int)*qw);
                    if (w >= (unsigned)total) break;
                    att::attn_block2<1, false>(ref((int)w), (char*)lds, wave);
                }
            }
        }
#endif
    }
    SEAM(4);
    REPS(5) if (IN(5)) {
        if (rep_) cg::this_grid().sync();
        load_bias_tables((char*)lds, args.in[I_TAB], wave * 64 + lane_id());
        {
            unsigned* qctr = (unsigned*)ws + 20; volatile unsigned* qw = (volatile unsigned*)(lds + LDS_BYTES - 16);
            for (int qi = 0; qi < 4; ++qi) {
                const int bg = ((bx & 3) + qi) & 3;
                for (;;) {
                    __syncthreads();
                    if (tid == 0) *qw = atomicAdd(qctr + bg, 1u);
                    __syncthreads();
                    const unsigned w = (unsigned)__builtin_amdgcn_readfirstlane((int)*qw);
                    if (w >= 256u) break;
                    att::cmp_item((char*)lds, ws, (float*)((char*)out + OC_OFF), bg >> 1, bg & 1, 255 - (int)w, wave);
                }
            }
        }
    }
    SEAM(5);
    REPS(6) if (IN(6)) {
        if (rep_) cg::this_grid().sync();
        load_bias_tables((char*)lds, args.in[I_TAB], wave * 64 + lane_id());
        const bf16_t* QN = (const bf16_t*)(ws + WS_QN);
        __syncthreads();
#ifndef NO_SEL
        {
            const bf16_t* KS = (const bf16_t*)(ws + WS_KSL); const bf16_t* VS = (const bf16_t*)(ws + WS_VSL); bf16_t* OS = (bf16_t*)((char*)out + OS_OFF);
            const unsigned* SELM = (const unsigned*)(ws + WS_SELM);
            const int total = 4 * 128 * 2;
            auto ref = [&](int idx) { const int L = idx >> 1, pass = idx & 1, bg = (G == 256) ? (L & 3) : (L >> 7), xx = (G == 256) ? ((((L >> 2) & 1) * 2 + (L >> 8)) * 32 + ((L >> 3) & 31)) : (L & 127), qb = pass ? 255 - xx : xx;
                const size_t qo = ((size_t)((bg >> 1) * 8 + (bg & 1) * 4) * SEQ + (size_t)qb * 64) * 128;
                att::BlockRef r; r.Q = QN + qo; r.K = KS + (size_t)bg * SEQ * 128; r.V = VS + (size_t)bg * SEQ * 128;
                r.O = OS + qo; r.P0 = qb * 64; r.tb = (const float*)(lds + att::LDS_TBX) + ((bg & 1) * 4) * att::TBXN + att::TBX0;
                r.sel = SELM + (size_t)bg * SEQ * 8; r.V2 = nullptr; r.O2 = nullptr; return r; };
            (void)total;
            unsigned* qctr = (unsigned*)ws + 16; volatile unsigned* qw = (volatile unsigned*)(lds + LDS_BYTES - 16); const int bgq = bx & 3;
            auto refs = [&](int code) { const int bg = code >> 8, qb = code & 255; const size_t qo = ((size_t)((bg >> 1) * 8 + (bg & 1) * 4) * SEQ + (size_t)qb * 64) * 128;
                att::BlockRef r; r.Q = QN + qo; r.K = KS + (size_t)bg * SEQ * 128; r.V = VS + (size_t)bg * SEQ * 128;
                r.O = OS + qo; r.P0 = qb * 64; r.tb = (const float*)(lds + att::LDS_TBX) + ((bg & 1) * 4) * att::TBXN + att::TBX0;
                r.sel = SELM + (size_t)bg * SEQ * 8; r.V2 = nullptr; r.O2 = nullptr; return r; };
            int sqi = 0;
#define SEL_FETCH(dst) do { dst = -1; while (sqi < 4) { const int bg_ = (bgq + sqi) & 3; __syncthreads(); if (tid == 0) *qw = atomicAdd(qctr + bg_, 1u); __syncthreads(); \
                const unsigned w_ = (unsigned)__builtin_amdgcn_readfirstlane((int)*qw); if (w_ < 256u) { dst = (bg_ << 8) | (255 - (int)w_); break; } ++sqi; } } while (0)
            int w0; SEL_FETCH(w0);
            if (w0 >= 0) {
                att::BlockRef cur = refs(w0); att::Seam S; int par = 0;
                att::attn_prime<2>(cur, (char*)lds, S, par, wave);
                for (;;) {
                    int wn; SEL_FETCH(wn);
                    const bool last = wn < 0;
                    const att::BlockRef nxt = last ? cur : refs(wn);
                    att::attn_block<2>(cur, nxt, (char*)lds, S, par, wave);
                    if (last) break;
                    cur = nxt; par ^= 1;
                }
            }
#undef SEL_FETCH
        }
#endif
    }
    SEAM(6);
    REPS(7) if (IN(7)) {
        if (rep_) cg::this_grid().sync();
        float lam;
        { const float* q1 = args.in[I_LQ1]; const float* k1 = args.in[I_LK1]; const float* q2 = args.in[I_LQ2]; const float* k2 = args.in[I_LK2];
          float s1 = q1[lane] * k1[lane] + q1[lane + 64] * k1[lane + 64], s2 = q2[lane] * k2[lane] + q2[lane + 64] * k2[lane + 64];
          s1 = wave_sum(s1); s2 = wave_sum(s2); lam = expf(s1) - expf(s2) + 0.2f; }
        const bf16_t* OC = (const bf16_t*)((char*)out + OC_OFF); const bf16_t* OS = (const bf16_t*)((char*)out + OS_OFF); const bf16_t* OW = (const bf16_t*)((char*)out + OW_OFF);
        const bf16_t* O12 = (const bf16_t*)(ws + WS_O12); const float* GN = (const float*)(ws + WS_GN); const float* hg = args.in[I_HG];
        bf16_t* ONSA = (bf16_t*)(ws + WS_ONSA); bf16_t* OD = (bf16_t*)(ws + WS_OD);
        for (int m = gw; m < TOK; m += NGW) {
            const int b = m >> 14, s = m & (SEQ - 1);
            {
                const int h = lane >> 3, d = (lane & 7) * 16; const size_t off = ((size_t)(b * 8 + h) * SEQ + s) * 128 + d;
                const float g0 = GN[(size_t)m * 24 + h * 3], g1 = GN[(size_t)m * 24 + h * 3 + 1], g2 = GN[(size_t)m * 24 + h * 3 + 2];
#pragma unroll
                for (int e = 0; e < 2; ++e) { f32x4 c0, c1, s0, s1, w0, w1;
                    pg8::unpack8(*(const u32x4*)(OC + off + e * 8), c0, c1); pg8::unpack8(*(const u32x4*)(OS + off + e * 8), s0, s1); pg8::unpack8(*(const u32x4*)(OW + off + e * 8), w0, w1);
                    *(u32x4*)(ONSA + (size_t)m * 1024 + h * 128 + d + e * 8) = pg8::pack8v(c0 * g0 + s0 * g1 + w0 * g2, c1 * g0 + s1 * g1 + w1 * g2); }
            }
            {
                const int h = lane >> 4, j = (lane & 15) * 16, vhalf = j >> 7, d = j & 127;
                const size_t o1 = ((size_t)(((b * 4 + h) * 2 + 0) * 2 + vhalf) * SEQ + s) * 128 + d, o2 = ((size_t)(((b * 4 + h) * 2 + 1) * 2 + vhalf) * SEQ + s) * 128 + d;
                f32x4 v[4]; float ss = 0.f;
#pragma unroll
                for (int e = 0; e < 2; ++e) { f32x4 a0, a1, b0, b1; pg8::unpack8(*(const u32x4*)(O12 + o1 + e * 8), a0, a1); pg8::unpack8(*(const u32x4*)(O12 + o2 + e * 8), b0, b1);
                    v[2 * e] = a0 - b0 * lam; v[2 * e + 1] = a1 - b1 * lam; }
#pragma unroll
                for (int e = 0; e < 4; ++e) ss += (v[e].x * v[e].x + v[e].y * v[e].y) + (v[e].z * v[e].z + v[e].w * v[e].w);
                ss = row16_sum(ss);
                const float rstd = rsqrtf(ss * (1.f / 256.f) + RMS_EPS) * 0.8f;
                const f32x4* gp = (const f32x4*)(hg + h * 256 + j);
#pragma unroll
                for (int e = 0; e < 2; ++e) *(u32x4*)(OD + (size_t)m * 1024 + h * 256 + j + e * 8) = pg8::pack8v(v[2 * e] * rstd * gp[2 * e], v[2 * e + 1] * rstd * gp[2 * e + 1]);
            }
        }
    }
    SEAM(7);
    REPS(8) if (IN(8)) {
        if (rep_) cg::this_grid().sync();
#ifdef PROBE8
        { pg8::Gemm g{(const bf16_t*)(ws + WS_ONSA), (const bf16_t*)(ws + WS_WUPN), TOK, DM, 1024, 1024, TOK / 256, 0};
          pg8::StaticOrder S; S.init(TOK, DM, G, bx); pg8::EpiUp<0> E{(bf16_t*)(ws + WS_QN), (const bf16_t*)(ws + WS_GM)}; pg8::gemm_phase(ldsl, g, S, E, wave); }
        { pg8::Gemm g{(const bf16_t*)(ws + WS_OD), (const bf16_t*)(ws + WS_WUPD), TOK, DM, 1024, 1024, TOK / 256, 0};
          pg8::StaticOrder S; S.init(TOK, DM, G, bx); pg8::EpiUp<1> E{(bf16_t*)(ws + WS_QN), (const bf16_t*)(ws + WS_GM)}; pg8::gemm_phase(ldsl, g, S, E, wave); }
        cg::this_grid().sync();
#endif
        pg8::Gemm g{(const bf16_t*)(ws + WS_ONSA), (const bf16_t*)(ws + WS_WUPN), TOK, DM, 1024, 1024, TOK / 256, 0};
        pg8::StaticOrder S; S.init(TOK, DM, G, bx);
        pg8::EpiUp<0> E{(bf16_t*)(ws + WS_MIX), (const bf16_t*)(ws + WS_GM)};
        pg8::gemm_phase(ldsl, g, S, E, wave);
    }
    if (IN(9)) {
        pg8::Gemm g{(const bf16_t*)(ws + WS_OD), (const bf16_t*)(ws + WS_WUPD), TOK, DM, 1024, 1024, TOK / 256, 0};
        pg8::StaticOrder S; S.init(TOK, DM, G, bx);
        pg8::EpiUp<1> E{(bf16_t*)(ws + WS_MIX), (const bf16_t*)(ws + WS_GM)};
        pg8::gemm_phase(ldsl, g, S, E, wave);
    }
    SEAM(9);
    REPS(10) if (IN(10)) {
        if (rep_) cg::this_grid().sync();
        pg8::Gemm g{(const bf16_t*)(ws + WS_MIX), (const bf16_t*)(ws + WS_WOUT), TOK, DM, DM, DM, TOK / 256, 0};
        pg8::StaticOrder S; S.init(TOK, DM, G, bx);
        pg8::EpiRes E{x, out};
        pg8::gemm_phase(ldsl, g, S, E, wave);
    }
    SEAM(10);
    REPS(11) if (IN(11)) { if (rep_) cg::this_grid().sync(); for (int m = gw; m < TOK; m += NGW) rms_row<true>(out + (size_t)m * DM, args.in[I_NFG], XN + (size_t)m * DM, lane); }
    SEAM(11);
    REPS(12) if (IN(12)) {
        if (rep_) cg::this_grid().sync();
        pg8::Gemm g{XN, (const bf16_t*)(ws + WS_WFFI), TOK, 2 * DFF, DM, DM, TOK / 256, 0};
        pg8::StaticOrder S; S.init(TOK, 2 * DFF, G, bx);
        pg8::EpiSwiglu E{(bf16_t*)(ws + WS_HID)};
        pg8::gemm_phase(ldsl, g, S, E, wave);
    }
    SEAM(12);
    if (IN(13)) {
        pg8::Gemm g{(const bf16_t*)(ws + WS_HID), (const bf16_t*)(ws + WS_WFFO), TOK, DM, DFF, DFF, TOK / 256, 0};
        pg8::StaticOrder S; S.init(TOK, DM, G, bx);
#ifdef PROBE13
        { pg8::EpiRes E0{out, (float*)(ws + WS_GM)}; pg8::gemm_phase(ldsl, g, S, E0, wave); cg::this_grid().sync(); }
#endif
        pg8::EpiRes E{out, out};
        pg8::gemm_phase(ldsl, g, S, E, wave);
    }
    SEAM(13);
#ifdef PROBE14
    if (IN(14)) { for (int m = gw; m < TOK; m += NGW) rms_row<false>(out + (size_t)m * DM, args.in[I_NFIN], (float*)(ws + WS_GM) + (size_t)m * DM, lane); cg::this_grid().sync(); }
#endif
    if (IN(14)) { for (int m = gw; m < TOK; m += NGW) rms_row<false>(out + (size_t)m * DM, args.in[I_NFIN], out + (size_t)m * DM, lane); }
#undef IN
#undef SEAM
#undef lane
#undef tid
}

extern "C" void kernel_launch(void* const* d_in, const int* in_sizes, int n_in, void* d_out, int out_size, void* d_ws, size_t ws_size, hipStream_t stream) {
    static int grid = 0;
    if (grid == 0) {
        if (n_in != 22 || out_size != TOK * DM || ws_size < WS_END) { fprintf(stderr, "kernel_launch: unexpected shapes (n_in %d out %d ws %zu need %zu)\n", n_in, out_size, ws_size, (size_t)WS_END); grid = -1; return; }
        int dev = 0, cus = 0, per_cu = 0;
        (void)hipGetDevice(&dev); (void)hipDeviceGetAttribute(&cus, hipDeviceAttributeMultiprocessorCount, dev);
        if (hipFuncSetAttribute((const void*)mega_fwd, hipFuncAttributeMaxDynamicSharedMemorySize, LDS_BYTES) != hipSuccess) { fprintf(stderr, "kernel_launch: hipFuncSetAttribute failed\n"); grid = -1; return; }
        (void)hipOccupancyMaxActiveBlocksPerMultiprocessor(&per_cu, (const void*)mega_fwd, 512, LDS_BYTES);
        (void)hipGetLastError();
        if (per_cu < 1) per_cu = 1;
        grid = cus > 0 ? cus : 256;
        fprintf(stderr, "kernel_launch: grid %d (per_cu %d)\n", grid, per_cu);
    }
    if (grid < 0) return;
    Args a{};
    for (int i = 0; i < 22; ++i) a.in[i] = (const float*)d_in[i];
    a.out = (float*)d_out; a.ws = (unsigned char*)d_ws;
#if MK_N_LAUNCHES == 1
    a.ph_lo = 0; a.ph_hi = NPH;
    void* kargs[] = {&a};
    hipError_t e = hipLaunchCooperativeKernel((const void*)mega_fwd, dim3(grid), dim3(512), kargs, LDS_BYTES, stream);
    if (e != hipSuccess) fprintf(stderr, "kernel_launch: cooperative launch failed: %s\n", hipGetErrorString(e));
#else
    for (int p = 0; p < NPH; ++p) { a.ph_lo = p; a.ph_hi = p + 1; hipLaunchKernelGGL(mega_fwd, dim3(grid), dim3(512), LDS_BYTES, stream, a); }
#endif
}
```

```cpp
#include <hip/hip_runtime.h>
#include <hip/hip_cooperative_groups.h>
#include <cstdio>
#include <cstdint>
namespace cg = cooperative_groups;

#ifndef MK_N_LAUNCHES
#define MK_N_LAUNCHES 1
#endif
#define CMP_IN_P4 1
#define DUP_MASK 0x0

#define LAS __attribute__((address_space(3)))
typedef unsigned short bf16_t;
typedef short bf16x8 __attribute__((ext_vector_type(8)));
typedef short s16x4 __attribute__((ext_vector_type(4)));
typedef float f32x4 __attribute__((ext_vector_type(4)));
typedef float f32x16 __attribute__((ext_vector_type(16)));
typedef unsigned u32x4 __attribute__((ext_vector_type(4)));
typedef unsigned u32x2 __attribute__((ext_vector_type(2)));

constexpr int SEQ = 16384, NBATCH = 2, TOK = NBATCH * SEQ, DM = 2048, DFF = 5632, HD = 128;
constexpr int NPROJ_SRC = 9752, NPROJ = 9984;
constexpr int KCROWS = SEQ + 16;
constexpr float SM_SCALE = 0.08838834764831845f;
constexpr float RMS_EPS = 1e-6f;

constexpr size_t WS_WIN  = 1u << 20;
constexpr size_t WS_WFFI = WS_WIN  + (size_t)NPROJ * DM * 2;
constexpr size_t WS_WFFO = WS_WFFI + (size_t)2 * DFF * DM * 2;
constexpr size_t WS_WOUT = WS_WFFO + (size_t)DM * DFF * 2;
constexpr size_t WS_WUPN = WS_WOUT + (size_t)DM * DM * 2;
constexpr size_t WS_WUPD = WS_WUPN + (size_t)DM * 1024 * 2;
constexpr size_t WS_W1K  = WS_WUPD + (size_t)DM * 1024 * 2;
constexpr size_t WS_W1V  = WS_W1K + (size_t)256 * 4096 * 2;
constexpr size_t WS_W2K  = WS_W1V + (size_t)256 * 4096 * 2;
constexpr size_t WS_W2V  = WS_W2K + (size_t)256 * 256 * 2;
constexpr size_t WS_BK   = WS_W2V + (size_t)256 * 256 * 2;
constexpr size_t WS_BV   = WS_BK + 1024;
constexpr size_t WS_XN   = WS_BV + 1024;
constexpr size_t WS_QN   = WS_XN + (size_t)TOK * DM * 2;
constexpr size_t WS_KC   = WS_QN + (size_t)TOK * 1024 * 2;
constexpr size_t WS_VC   = WS_KC + (size_t)4 * KCROWS * 128 * 2;
constexpr size_t WS_KSL  = WS_VC + (size_t)4 * KCROWS * 128 * 2;
constexpr size_t WS_VSL  = WS_KSL + (size_t)4 * SEQ * 128 * 2;
constexpr size_t WS_KW   = WS_VSL + (size_t)4 * SEQ * 128 * 2;
constexpr size_t WS_VW   = WS_KW + (size_t)4 * SEQ * 128 * 2;
constexpr size_t WS_QD   = WS_VW + (size_t)4 * SEQ * 128 * 2;
constexpr size_t WS_KD   = WS_QD + (size_t)TOK * 1024 * 2;
constexpr size_t WS_VD   = WS_KD + (size_t)TOK * 1024 * 2;
constexpr size_t WS_GM   = WS_VD + (size_t)TOK * 1024 * 2;
constexpr size_t WS_GN   = WS_GM + (size_t)TOK * 4096 * 2;
constexpr size_t WS_HK   = WS_GN + (size_t)TOK * 24 * 4;
constexpr size_t WS_HV   = WS_HK + (size_t)4096 * 256 * 2;
constexpr size_t WS_KCMP = WS_HV + (size_t)4096 * 256 * 2;
constexpr size_t WS_VCMP = WS_KCMP + (size_t)4096 * 128 * 2;
constexpr size_t WS_SELM = WS_VCMP + (size_t)4096 * 128 * 2;
constexpr size_t WS_END  = WS_SELM + (size_t)4 * SEQ * 8 * 4;
constexpr size_t WS_O12  = WS_XN;
constexpr size_t WS_ONSA = WS_QD;
constexpr size_t WS_OD   = WS_KD;
constexpr size_t WS_MIX  = WS_XN;
constexpr size_t WS_HID  = WS_QN;
static_assert(WS_HID + (size_t)TOK * DFF * 2 <= WS_GM, "HID overlay");
static_assert(WS_END <= (size_t)1 << 30, "workspace");

constexpr int LDS_BYTES = 163840;

__device__ __forceinline__ unsigned cvtpk(float lo, float hi) { unsigned r; asm volatile("v_cvt_pk_bf16_f32 %0, %1, %2" : "=v"(r) : "v"(lo), "v"(hi)); return r; }
__device__ __forceinline__ float bf2f(unsigned short h) { return __uint_as_float((unsigned)h << 16); }
__device__ __forceinline__ float sigmoidf_(float x) { return __builtin_amdgcn_rcpf(1.f + __builtin_amdgcn_exp2f(-1.4426950408889634f * x)); }
__device__ __forceinline__ int lane_id() {
    unsigned l; asm volatile("v_mbcnt_lo_u32_b32 %0, -1, 0\n\tv_mbcnt_hi_u32_b32 %0, -1, %0" : "=v"(l)); return (int)(l & 63u); }
__device__ __forceinline__ float xor1_(float v) { return __int_as_float(__builtin_amdgcn_update_dpp(0, __float_as_int(v), 0xB1, 0xf, 0xf, false)); }
#define DPP_F(v, ctrl) __int_as_float(__builtin_amdgcn_update_dpp(0, __float_as_int(v), ctrl, 0xf, 0xf, false))
__device__ __forceinline__ float row16_sum(float v) {
    v += DPP_F(v, 0xB1); v += DPP_F(v, 0x4E); v += DPP_F(v, 0x141); v += DPP_F(v, 0x140); return v; }
__device__ __forceinline__ float wave_sum(float v) {
    v = row16_sum(v);
    { auto rr = __builtin_amdgcn_permlane16_swap(__float_as_uint(v), __float_as_uint(v), false, false); v = __uint_as_float(rr[0]) + __uint_as_float(rr[1]); }
    { auto rr = __builtin_amdgcn_permlane32_swap(__float_as_uint(v), __float_as_uint(v), false, false); v = __uint_as_float(rr[0]) + __uint_as_float(rr[1]); }
    return v;
}

namespace pg8 {
constexpr int BM = 256, BK = 64, HALF = 128, HTB = HALF * BK * 2, STAGE_BYTES = 8 * HTB, NXCD = 8, WGM = 8;
__host__ __device__ __forceinline__ int lds_byte(int r, int c) { const int st = (r >> 4) * 2 + (c >> 5), rr = r & 15, cc = c & 31, ob = rr * 64 + cc * 2; return st * 1024 + (ob ^ (((ob >> 9) & 1) << 5)); }
__host__ __device__ __forceinline__ void stage_rc(int b, int& R, int& C) { const int st = b / 1024, sb = b % 1024, swz = sb ^ (((sb >> 9) & 1) << 5); R = (st >> 1) * 16 + swz / 64; C = (st & 1) * 32 + (swz % 64) / 2; }
__host__ __device__ __forceinline__ int perm32(int rho) { const int n = rho >> 4, i = rho & 15; return 8 * (i >> 2) + 4 * n + (i & 3); }
struct Unit { int pm, pn; };
struct Gemm { const bf16_t* A; const bf16_t* Bt; int M, N, K, lda, tps; size_t slab; };
struct StaticOrder {
    int nM, nN, nwg, G, c;
    __device__ void init(int M, int N, int G_, int c_) { nM = M / BM; nN = N / BM; nwg = nM * nN; G = G_; c = c_; }
    __device__ bool next(int i, Unit& u) const {
        const long L = (long)i * G + c; if (L >= nwg) return false;
        int wgid = (int)L; { const int q = nwg / NXCD, r = nwg % NXCD, xcd = wgid % NXCD, off = wgid / NXCD; wgid = (xcd < r ? xcd * (q + 1) : r * (q + 1) + (xcd - r) * q) + off; }
        const int nig = WGM * nN, gid = wgid / nig, fm = gid * WGM, gsz = (nM - fm) < WGM ? (nM - fm) : WGM;
        u.pm = fm + ((wgid % nig) % gsz); u.pn = (wgid % nig) / gsz; return true;
    }
};
template <class Epi>
__device__ __forceinline__ void gemm_phase(LAS unsigned char* lds, const Gemm g, const StaticOrder& S, const Epi& E, const int wid) {
    const int lane = lane_id(), tid = wid * 64 + lane, wr = wid >> 2, wc = wid & 3, fr = lane & 15, fq = lane >> 4;
    const int K = g.K, nt = K / BK, lda = g.lda;
    unsigned voffA[2], voffB[2];
#pragma unroll
    for (int i = 0; i < 2; ++i) { int R, C; stage_rc(tid * 16 + i * 8192, R, C); const int Rb = (R & ~31) + perm32(R & 31);
        voffA[i] = (unsigned)(R * lda + C) * 2u; voffB[i] = (unsigned)(Rb * K + C) * 2u; }
    const size_t kstep = (size_t)(BK * 2);
    const size_t hstepA = (size_t)HALF * lda * 2, hstepB = (size_t)HALF * K * 2;
    const unsigned ldsw = (unsigned)wid * 1024u;
    const int aoff = lds_byte(wr * 64 + fr, fq * 8), boff = lds_byte(wc * 32 + fr, fq * 8);
#define PG8_TILEA(pm) ((const char*)g.A + ((size_t)((pm) / g.tps) * g.slab + (size_t)((pm) % g.tps) * 256 * lda) * 2)
#define PG8_TILEB(pn) ((const char*)g.Bt + (size_t)(pn) * 2 * hstepB)
#define PG8_SA(b, h) (((b) * 2 + (h)) * HTB)
#define PG8_SB(b, h) ((4 + (b) * 2 + (h)) * HTB)
#define PG8_STAGE(bufoff, gbase, voff) do { _Pragma("unroll") for (int _i = 0; _i < 2; ++_i) \
        __builtin_amdgcn_global_load_lds((const unsigned*)((const char*)(gbase) + (voff)[_i]), (LAS unsigned*)(lds + (bufoff) + ldsw + _i * 8192), 16, 0, 0); } while (0)
#define PG8_LDA(dst, b, h) do { _Pragma("unroll") for (int m = 0; m < 4; ++m) _Pragma("unroll") for (int k = 0; k < 2; ++k) dst[m][k] = *(const LAS bf16x8*)(lds + PG8_SA(b, h) + aoff + m * 2048 + k * 1024); } while (0)
#define PG8_LDB(dst, b, h) do { _Pragma("unroll") for (int n = 0; n < 2; ++n) _Pragma("unroll") for (int k = 0; k < 2; ++k) dst[n][k] = *(const LAS bf16x8*)(lds + PG8_SB(b, h) + boff + n * 2048 + k * 1024); } while (0)
#define PG8_MMA(ai, bj, At, Bt) do { __builtin_amdgcn_s_setprio(1); _Pragma("unroll") for (int m = 0; m < 4; ++m) _Pragma("unroll") for (int n = 0; n < 2; ++n) _Pragma("unroll") for (int k = 0; k < 2; ++k) \
        acc[ai][bj][m][n] = __builtin_amdgcn_mfma_f32_16x16x32_bf16(Bt[n][k], At[m][k], acc[ai][bj][m][n], 0, 0, 0); __builtin_amdgcn_s_setprio(0); } while (0)
#define PG8_WAIT_V(n) asm volatile("s_waitcnt vmcnt(" #n ")" ::: "memory")
#define PG8_WAIT_L(n) asm volatile("s_waitcnt lgkmcnt(" #n ")" ::: "memory")
#define PG8_BAR __builtin_amdgcn_s_barrier()
#define PG8_SCHED __builtin_amdgcn_sched_barrier(0)
    Unit cur, nxt; int ui = 0;
    if (!S.next(0, cur)) return;
    f32x4 acc[2][2][4][2];
#pragma unroll
    for (int a = 0; a < 2; ++a)
#pragma unroll
        for (int b = 0; b < 2; ++b)
#pragma unroll
            for (int m = 0; m < 4; ++m)
#pragma unroll
                for (int n = 0; n < 2; ++n) acc[a][b][m][n] = (f32x4){0.f, 0.f, 0.f, 0.f};
    bf16x8 At[4][2], B0[2][2], B1[2][2];
    const char* cA = PG8_TILEA(cur.pm); const char* cB = PG8_TILEB(cur.pn);
    PG8_STAGE(PG8_SB(0, 0), cB, voffB); PG8_STAGE(PG8_SB(0, 1), cB + hstepB, voffB); PG8_STAGE(PG8_SA(0, 0), cA, voffA); PG8_STAGE(PG8_SA(0, 1), cA + hstepA, voffA);
    if (wr == 1) PG8_BAR;
    PG8_WAIT_V(2); PG8_BAR;
    PG8_STAGE(PG8_SB(1, 0), cB + kstep, voffB); PG8_STAGE(PG8_SA(1, 0), cA + kstep, voffA); PG8_STAGE(PG8_SB(1, 1), cB + hstepB + kstep, voffB);
    PG8_WAIT_V(6); PG8_BAR;
    for (;;) {
        const bool has_next = S.next(ui + 1, nxt);
        const char* nA = has_next ? PG8_TILEA(nxt.pm) : cA; const char* nB = has_next ? PG8_TILEB(nxt.pn) : cB;
        for (int t = 0; t < nt; t += 2) {
            const bool last = (t == nt - 2);
            const char* a1 = cA + (size_t)(t + 1) * kstep;
            const char* a2 = last ? nA : cA + (size_t)(t + 2) * kstep; const char* b2 = last ? nB : cB + (size_t)(t + 2) * kstep;
            const char* a3 = a2 + kstep; const char* b3 = b2 + kstep;
            PG8_LDB(B0, 0, 0); PG8_LDB(B1, 0, 1); PG8_SCHED; PG8_LDA(At, 0, 0); PG8_STAGE(PG8_SA(1, 1), a1 + hstepA, voffA);
            PG8_WAIT_V(8); PG8_WAIT_L(0); PG8_BAR; PG8_MMA(0, 0, At, B0); PG8_MMA(0, 1, At, B1); PG8_BAR; PG8_SCHED;
            PG8_LDA(At, 0, 1); PG8_STAGE(PG8_SB(0, 0), b2, voffB); PG8_STAGE(PG8_SB(0, 1), b2 + hstepB, voffB); PG8_STAGE(PG8_SA(0, 0), a2, voffA);
            PG8_WAIT_V(8); PG8_WAIT_L(0); PG8_BAR; PG8_MMA(1, 0, At, B0); PG8_MMA(1, 1, At, B1); PG8_BAR; PG8_SCHED;
            PG8_LDB(B0, 1, 0); PG8_LDB(B1, 1, 1); PG8_SCHED; PG8_LDA(At, 1, 0); PG8_STAGE(PG8_SA(0, 1), a2 + hstepA, voffA);
            PG8_WAIT_V(8); PG8_WAIT_L(0); PG8_BAR; PG8_MMA(0, 0, At, B0); PG8_MMA(0, 1, At, B1); PG8_BAR; PG8_SCHED;
            PG8_LDA(At, 1, 1); PG8_STAGE(PG8_SB(1, 0), b3, voffB); PG8_STAGE(PG8_SB(1, 1), b3 + hstepB, voffB); PG8_STAGE(PG8_SA(1, 0), a3, voffA);
            PG8_WAIT_V(8); PG8_WAIT_L(0); PG8_BAR; PG8_MMA(1, 0, At, B0); PG8_MMA(1, 1, At, B1); PG8_BAR; PG8_SCHED;
        }
        if (wr == 0) PG8_BAR;
        E(acc, cur, wr, wc, fr, fq);
        if (!has_next) break;
#pragma unroll
        for (int a = 0; a < 2; ++a)
#pragma unroll
            for (int b = 0; b < 2; ++b)
#pragma unroll
                for (int m = 0; m < 4; ++m)
#pragma unroll
                    for (int n = 0; n < 2; ++n) acc[a][b][m][n] = (f32x4){0.f, 0.f, 0.f, 0.f};
        cur = nxt; cA = nA; cB = nB; ++ui;
        if (wr == 1) PG8_BAR;
    }
    PG8_WAIT_V(0);
    PG8_BAR;
#undef PG8_TILEA
#undef PG8_TILEB
#undef PG8_SA
#undef PG8_SB
#undef PG8_STAGE
#undef PG8_LDA
#undef PG8_LDB
#undef PG8_MMA
#undef PG8_WAIT_V
#undef PG8_WAIT_L
#undef PG8_BAR
#undef PG8_SCHED
}

typedef f32x4 Acc[2][2][4][2];
__device__ __forceinline__ u32x4 pack8v(f32x4 a, f32x4 b) { u32x4 w; w.x = cvtpk(a[0], a[1]); w.y = cvtpk(a[2], a[3]); w.z = cvtpk(b[0], b[1]); w.w = cvtpk(b[2], b[3]); return w; }
__device__ __forceinline__ void unpack8(u32x4 w, f32x4& a, f32x4& b) {
    a[0] = __uint_as_float(w.x << 16); a[1] = __uint_as_float(w.x & 0xffff0000u); a[2] = __uint_as_float(w.y << 16); a[3] = __uint_as_float(w.y & 0xffff0000u);
    b[0] = __uint_as_float(w.z << 16); b[1] = __uint_as_float(w.z & 0xffff0000u); b[2] = __uint_as_float(w.w << 16); b[3] = __uint_as_float(w.w & 0xffff0000u);
}

struct EpiProj {
    unsigned char* ws;
    __device__ __forceinline__ void operator()(const Acc& acc, const Unit& u, int wr, int wc, int fr, int fq) const {
        const int d = wc * 32 + 8 * fq;
#pragma unroll
        for (int bj = 0; bj < 2; ++bj) {
            const int blk = u.pn * 2 + bj;
            if (blk >= 77) continue;
            bf16_t* base; size_t bstride; int kind = 0;
            if (blk < 8)       { base = (bf16_t*)(ws + WS_QN) + (size_t)blk * SEQ * 128; bstride = (size_t)8 * SEQ * 128; }
            else if (blk < 10) { base = (bf16_t*)(ws + WS_KC) + (size_t)(blk - 8) * KCROWS * 128; bstride = (size_t)2 * KCROWS * 128; }
            else if (blk < 12) { base = (bf16_t*)(ws + WS_VC) + (size_t)(blk - 10) * KCROWS * 128; bstride = (size_t)2 * KCROWS * 128; }
            else if (blk < 14) { base = (bf16_t*)(ws + WS_KSL) + (size_t)(blk - 12) * SEQ * 128; bstride = (size_t)2 * SEQ * 128; }
            else if (blk < 16) { base = (bf16_t*)(ws + WS_VSL) + (size_t)(blk - 14) * SEQ * 128; bstride = (size_t)2 * SEQ * 128; }
            else if (blk < 18) { base = (bf16_t*)(ws + WS_KW) + (size_t)(blk - 16) * SEQ * 128; bstride = (size_t)2 * SEQ * 128; }
            else if (blk < 20) { base = (bf16_t*)(ws + WS_VW) + (size_t)(blk - 18) * SEQ * 128; bstride = (size_t)2 * SEQ * 128; }
            else if (blk < 28) { base = (bf16_t*)(ws + WS_QD) + (size_t)(blk - 20) * SEQ * 128; bstride = (size_t)8 * SEQ * 128; }
            else if (blk < 36) { base = (bf16_t*)(ws + WS_KD) + (size_t)(blk - 28) * SEQ * 128; bstride = (size_t)8 * SEQ * 128; }
            else if (blk < 44) { base = (bf16_t*)(ws + WS_VD) + (size_t)(blk - 36) * SEQ * 128; bstride = (size_t)8 * SEQ * 128; }
            else if (blk < 76) { base = (bf16_t*)(ws + WS_GM) + (size_t)(blk - 44) * 128; bstride = 0; kind = 1; }
            else               { base = nullptr; bstride = 0; kind = 2; }
#pragma unroll
            for (int ai = 0; ai < 2; ++ai)
#pragma unroll
                for (int m = 0; m < 4; ++m) {
                    const int row = u.pm * 256 + ai * 128 + wr * 64 + m * 16 + fr;
                    f32x4 v0 = acc[ai][bj][m][0], v1 = acc[ai][bj][m][1];
                    if (kind == 0) {
                        const int b = row >> 14, s = row & (SEQ - 1);
                        *(u32x4*)(base + (size_t)b * bstride + (size_t)s * 128 + d) = pack8v(v0, v1);
                    } else if (kind == 1) {
#pragma unroll
                        for (int e = 0; e < 4; ++e) { v0[e] = sigmoidf_(v0[e]); v1[e] = sigmoidf_(v1[e]); }
                        __builtin_nontemporal_store(pack8v(v0, v1), (u32x4*)(base + (size_t)row * 4096 + d));
                    } else {
                        if (d < 24) { float* gn = (float*)(ws + WS_GN) + (size_t)row * 24 + d;
#pragma unroll
                            for (int e = 0; e < 4; ++e) { v0[e] = sigmoidf_(v0[e]); v1[e] = sigmoidf_(v1[e]); }
                            *(f32x4*)gn = v0; *(f32x4*)(gn + 4) = v1; }
                    }
                }
        }
    }
};
struct EpiCmp1 {
    bf16_t* H; const float* bias;
    __device__ __forceinline__ void operator()(const Acc& acc, const Unit& u, int wr, int wc, int fr, int fq) const {
#pragma unroll
        for (int bj = 0; bj < 2; ++bj) {
            const int c = bj * 128 + wc * 32 + 8 * fq;
            const f32x4 b0 = *(const f32x4*)(bias + c), b1 = *(const f32x4*)(bias + c + 4);
#pragma unroll
            for (int ai = 0; ai < 2; ++ai)
#pragma unroll
                for (int m = 0; m < 4; ++m) {
                    const int row = u.pm * 256 + ai * 128 + wr * 64 + m * 16 + fr;
                    f32x4 v0 = acc[ai][bj][m][0] + b0, v1 = acc[ai][bj][m][1] + b1;
#pragma unroll
                    for (int e = 0; e < 4; ++e) {
                        float x = v0[e]; float t = 1.5957691216f * (x + 0.044715f * x * x * x); v0[e] = x * sigmoidf_(t);
                        x = v1[e]; t = 1.5957691216f * (x + 0.044715f * x * x * x); v1[e] = x * sigmoidf_(t); }
                    *(u32x4*)(H + (size_t)row * 256 + c) = pack8v(v0, v1);
                }
        }
    }
};
struct EpiCmp2 {
    bf16_t* O;
    __device__ __forceinline__ void operator()(const Acc& acc, const Unit& u, int wr, int wc, int fr, int fq) const {
        const int c = wc * 32 + 8 * fq;
#pragma unroll
        for (int ai = 0; ai < 2; ++ai)
#pragma unroll
            for (int m = 0; m < 4; ++m) {
                const int row = u.pm * 256 + ai * 128 + wr * 64 + m * 16 + fr;
                *(u32x4*)(O + (size_t)row * 128 + c) = pack8v(acc[ai][0][m][0], acc[ai][0][m][1]);
            }
    }
};
template <int MODE> struct EpiUp {
    bf16_t* T; const bf16_t* GM;
    __device__ __forceinline__ void operator()(const Acc& acc, const Unit& u, int wr, int wc, int fr, int fq) const {
#pragma unroll
        for (int bj = 0; bj < 2; ++bj) {
            const int c = u.pn * 256 + bj * 128 + wc * 32 + 8 * fq;
#pragma unroll
            for (int ai = 0; ai < 2; ++ai)
#pragma unroll
                for (int m = 0; m < 4; ++m) {
                    const int row = u.pm * 256 + ai * 128 + wr * 64 + m * 16 + fr;
                    f32x4 g0, g1; unpack8(*(const u32x4*)(GM + (size_t)row * 4096 + MODE * 2048 + c), g0, g1);
                    f32x4 v0 = acc[ai][bj][m][0] * g0, v1 = acc[ai][bj][m][1] * g1;
                    bf16_t* tp = T + (size_t)row * 2048 + c;
                    if (MODE == 1) { f32x4 t0, t1; unpack8(*(const u32x4*)tp, t0, t1); v0 += t0; v1 += t1; }
                    *(u32x4*)tp = pack8v(v0, v1);
                }
        }
    }
};
struct EpiRes {
    const float* res; float* out;
    __device__ __forceinline__ void operator()(const Acc& acc, const Unit& u, int wr, int wc, int fr, int fq) const {
#pragma unroll
        for (int bj = 0; bj < 2; ++bj) {
            const int c = u.pn * 256 + bj * 128 + wc * 32 + 8 * fq;
#pragma unroll
            for (int ai = 0; ai < 2; ++ai)
#pragma unroll
                for (int m = 0; m < 4; ++m) {
                    const size_t off = (size_t)(u.pm * 256 + ai * 128 + wr * 64 + m * 16 + fr) * DM + c;
                    const f32x4 r0 = *(const f32x4*)(res + off), r1 = *(const f32x4*)(res + off + 4);
                    *(f32x4*)(out + off) = r0 + acc[ai][bj][m][0]; *(f32x4*)(out + off + 4) = r1 + acc[ai][bj][m][1];
                }
        }
    }
};
struct EpiSwiglu {
    bf16_t* H;
    __device__ __forceinline__ void operator()(const Acc& acc, const Unit& u, int wr, int wc, int fr, int fq) const {
        const int c = u.pn * 128 + wc * 32 + 8 * fq;
#pragma unroll
        for (int ai = 0; ai < 2; ++ai)
#pragma unroll
            for (int m = 0; m < 4; ++m) {
                const int row = u.pm * 256 + ai * 128 + wr * 64 + m * 16 + fr;
                f32x4 v0, v1;
#pragma unroll
                for (int e = 0; e < 4; ++e) { const float a0 = acc[ai][0][m][0][e], a1 = acc[ai][0][m][1][e];
                    v0[e] = a0 * sigmoidf_(a0) * acc[ai][1][m][0][e]; v1[e] = a1 * sigmoidf_(a1) * acc[ai][1][m][1][e]; }
                *(u32x4*)(H + (size_t)row * DFF + c) = pack8v(v0, v1);
            }
    }
};
}

namespace att {
constexpr int D = 128, NW = 8, QBLK = 32, KVBLK = 64, QB = NW * QBLK;
constexpr int SHM_V = KVBLK * D * 2, SHM_K = KVBLK * D * 2;
constexpr int LDS_TB = 2 * SHM_V + 2 * SHM_K + NW * 64 * 4;
constexpr int LDS_TBX = LDS_TB + 12 * 128 * 4;
constexpr int TBXN = 544, TBX0 = 320;
constexpr int LDS_SEL = LDS_TBX + 12 * TBXN * 4;
constexpr int LDS_PSLC = LDS_TB + 12 * 128 * 4;
constexpr int BAND = 113;
constexpr float THR = 8.f;
#define KSWZ(row, colB) ((row) * 256 + ((colB) ^ (((row) & 7) << 4)))
#define SBAR() __builtin_amdgcn_sched_barrier(0)
__device__ __forceinline__ int v_st(int k, int c) { const int kk = (k & ~0xC) | ((k & 4) << 1) | ((k & 8) >> 1); return ((kk >> 3) * 4 + (c >> 5)) * 512 + ((kk & 7) * 32 + (c & 31)) * 2; }
__device__ __forceinline__ int v_rd_base(int lane) { return ((lane & 3) << 3) | (((lane >> 2) & 3) << 6) | (((lane >> 4) & 1) << 5) | (((lane >> 5) & 1) << 8); }
constexpr int v_rd_off(int d0, int ks, int half) { return d0 * 512 + ks * 4096 + half * 2048; }
__device__ __forceinline__ int crow(int r, int hi) { return (r & 3) + 8 * (r >> 2) + 4 * hi; }
__device__ __forceinline__ bf16x8 load8(const bf16_t* p) { return *reinterpret_cast<const bf16x8*>(p); }

__device__ __forceinline__ void bias_mask_tile(f32x16& p0, f32x16& p1, int dq, unsigned W, const float* tbx) {
    const float NEG = -__builtin_inff();
    const float* bp = tbx + (dq - 63);
#pragma unroll
    for (int r = 0; r < 16; ++r) {
        const int c = (r & 3) + 8 * (r >> 2);
        const unsigned r0 = (unsigned)(dq - c), r1 = (unsigned)(dq - c - 32);
        const float b0 = bp[63 - c], b1 = bp[31 - c];
        p0[r] = r0 >= W ? NEG : p0[r] + b0;
        p1[r] = r1 >= W ? NEG : p1[r] + b1;
        if ((r & 3) == 3) __builtin_amdgcn_sched_barrier(0);
    }
}
__device__ __forceinline__ void mask_tile(f32x16& p0, f32x16& p1, int dq, unsigned W) {
    const float NEG = -__builtin_inff();
#pragma unroll
    for (int r = 0; r < 16; ++r) {
        const int c = (r & 3) + 8 * (r >> 2);
        if ((unsigned)(dq - c) >= W) p0[r] = NEG;
        if ((unsigned)(dq - c - 32) >= W) p1[r] = NEG;
    }
}
__device__ __forceinline__ void partialSM(f32x16& p0, f32x16& p1, float& m_reg, float& mn, float& alpha) {
    float pmax = p0[0];
#pragma unroll
    for (int r = 1; r < 16; ++r) pmax = fmaxf(pmax, p0[r]);
#pragma unroll
    for (int r = 0; r < 16; ++r) pmax = fmaxf(pmax, p1[r]);
    { auto rr = __builtin_amdgcn_permlane32_swap(__float_as_uint(pmax), __float_as_uint(pmax), false, false);
      pmax = fmaxf(__uint_as_float(rr[0]), __uint_as_float(rr[1])); }
    constexpr float C2 = 1.4426950408889634f * SM_SCALE;
    if (__builtin_expect(__all((pmax - m_reg) * SM_SCALE <= THR), 1)) { mn = m_reg; alpha = 1.f; }
    else { mn = fmaxf(m_reg, pmax); alpha = __builtin_amdgcn_exp2f((m_reg - mn) * C2); m_reg = mn; }
    const float mnL = -mn * C2;
#pragma unroll
    for (int r = 0; r < 16; ++r) p0[r] = fmaf(p0[r], C2, mnL);
#pragma unroll
    for (int r = 0; r < 16; ++r) p1[r] = fmaf(p1[r], C2, mnL);
#pragma unroll
    for (int r = 0; r < 16; ++r) p0[r] = __builtin_amdgcn_exp2f(p0[r]);
}
#define PK4(P, B_, OUT) do { unsigned a0 = cvtpk(P[B_+0], P[B_+1]), a1 = cvtpk(P[B_+2], P[B_+3]);                          \
        unsigned b0 = cvtpk(P[B_+4], P[B_+5]), b1 = cvtpk(P[B_+6], P[B_+7]);                                             \
        auto r0 = __builtin_amdgcn_permlane32_swap(a0, b0, false, false); auto r1 = __builtin_amdgcn_permlane32_swap(a1, b1, false, false); \
        u32x4 w = {r0[0], r1[0], r0[1], r1[1]}; OUT = *reinterpret_cast<bf16x8*>(&w); } while (0)
__device__ __forceinline__ void finishSM(f32x16& p0, f32x16& p1, float alpha, float& l_reg, bf16x8& pa0, bf16x8& pa1, bf16x8& pa2, bf16x8& pa3) {
#pragma unroll
    for (int r = 0; r < 16; ++r) p1[r] = __builtin_amdgcn_exp2f(p1[r]);
    float ps = 0;
#pragma unroll
    for (int r = 0; r < 16; ++r) ps += p0[r];
#pragma unroll
    for (int r = 0; r < 16; ++r) ps += p1[r];
    { auto rr = __builtin_amdgcn_permlane32_swap(__float_as_uint(ps), __float_as_uint(ps), false, false);
      ps = __uint_as_float(rr[0]) + __uint_as_float(rr[1]); }
    l_reg = l_reg * alpha + ps;
    PK4(p0, 0, pa0); PK4(p0, 8, pa1); PK4(p1, 0, pa2); PK4(p1, 8, pa3);
}
template <int KB, bool SK>
__device__ __forceinline__ void qkt(f32x16& p0, f32x16& p1, const char* K_lds, int r32, int hi, const bf16x8* qr, bool act) {
    if (SK && !act) return;
    p0 = f32x16{}; p1 = f32x16{};
    const char* kb[4];
#pragma unroll
    for (int dd = 0; dd < 4; ++dd) kb[dd] = K_lds + KB * SHM_K + KSWZ(r32, (dd * 16 + hi * 8) * 2);
#pragma unroll
    for (int d0 = 0; d0 < 8; ++d0) { const char* a = kb[d0 & 3] + (d0 >> 2) * 128;
        bf16x8 b0 = *reinterpret_cast<const bf16x8*>(a);
        bf16x8 b1 = *reinterpret_cast<const bf16x8*>(a + 32 * 256);
        p0 = __builtin_amdgcn_mfma_f32_32x32x16_bf16(b0, qr[d0], p0, 0, 0, 0);
        p1 = __builtin_amdgcn_mfma_f32_32x32x16_bf16(b1, qr[d0], p1, 0, 0, 0); }
}
template <int VB, bool SK>
__device__ __forceinline__ void pv_tile(f32x16* o, int vb0, bf16x8 pa0, bf16x8 pa1, bf16x8 pa2, bf16x8 pa3, bool act) {
    if (SK && !act) return;
#define TRRD(dst, off) asm volatile("ds_read_b64_tr_b16 %0, %1 offset:%2" : "=&v"(dst) : "v"(vb0), "i"(off) : "memory")
#define PV_D0(d0) do { s16x4 l0, l1, l2, l3, h0, h1, h2, h3; constexpr int b_ = VB * SHM_V + v_rd_off(d0, 0, 0); \
        TRRD(l0, b_); TRRD(h0, b_ + 2048); TRRD(l1, b_ + 4096); TRRD(h1, b_ + 6144); TRRD(l2, b_ + 8192); TRRD(h2, b_ + 10240); TRRD(l3, b_ + 12288); TRRD(h3, b_ + 14336); \
        asm volatile("s_waitcnt lgkmcnt(0)" ::: "memory"); SBAR();   \
        o[d0] = __builtin_amdgcn_mfma_f32_32x32x16_bf16(pa0, (bf16x8){l0[0], l0[1], l0[2], l0[3], h0[0], h0[1], h0[2], h0[3]}, o[d0], 0, 0, 0);   \
        o[d0] = __builtin_amdgcn_mfma_f32_32x32x16_bf16(pa1, (bf16x8){l1[0], l1[1], l1[2], l1[3], h1[0], h1[1], h1[2], h1[3]}, o[d0], 0, 0, 0);   \
        o[d0] = __builtin_amdgcn_mfma_f32_32x32x16_bf16(pa2, (bf16x8){l2[0], l2[1], l2[2], l2[3], h2[0], h2[1], h2[2], h2[3]}, o[d0], 0, 0, 0);   \
        o[d0] = __builtin_amdgcn_mfma_f32_32x32x16_bf16(pa3, (bf16x8){l3[0], l3[1], l3[2], l3[3], h3[0], h3[1], h3[2], h3[3]}, o[d0], 0, 0, 0); } while (0)
    PV_D0(0); PV_D0(1); PV_D0(2); PV_D0(3);
#undef PV_D0
#undef TRRD
}

__device__ __forceinline__ void pv_tile2(f32x16* o, f32x16* o2, int vb0, bf16x8 pa0, bf16x8 pa1, bf16x8 pa2, bf16x8 pa3) {
#define TRRD(dst, off) asm volatile("ds_read_b64_tr_b16 %0, %1 offset:%2" : "=&v"(dst) : "v"(vb0), "i"(off) : "memory")
#define PV2_D0(d0) do { s16x4 l0, l1, l2, l3, h0, h1, h2, h3, L0, L1, L2, L3, H0, H1, H2, H3; constexpr int b_ = v_rd_off(d0, 0, 0), c_ = SHM_V + v_rd_off(d0, 0, 0); \
        TRRD(l0, b_); TRRD(h0, b_ + 2048); TRRD(L0, c_); TRRD(H0, c_ + 2048); TRRD(l1, b_ + 4096); TRRD(h1, b_ + 6144); TRRD(L1, c_ + 4096); TRRD(H1, c_ + 6144); \
        TRRD(l2, b_ + 8192); TRRD(h2, b_ + 10240); TRRD(L2, c_ + 8192); TRRD(H2, c_ + 10240); TRRD(l3, b_ + 12288); TRRD(h3, b_ + 14336); TRRD(L3, c_ + 12288); TRRD(H3, c_ + 14336); \
        asm volatile("s_waitcnt lgkmcnt(0)" ::: "memory"); SBAR();   \
        o[d0]  = __builtin_amdgcn_mfma_f32_32x32x16_bf16(pa0, (bf16x8){l0[0], l0[1], l0[2], l0[3], h0[0], h0[1], h0[2], h0[3]}, o[d0], 0, 0, 0);   \
        o2[d0] = __builtin_amdgcn_mfma_f32_32x32x16_bf16(pa0, (bf16x8){L0[0], L0[1], L0[2], L0[3], H0[0], H0[1], H0[2], H0[3]}, o2[d0], 0, 0, 0);  \
        o[d0]  = __builtin_amdgcn_mfma_f32_32x32x16_bf16(pa1, (bf16x8){l1[0], l1[1], l1[2], l1[3], h1[0], h1[1], h1[2], h1[3]}, o[d0], 0, 0, 0);   \
        o2[d0] = __builtin_amdgcn_mfma_f32_32x32x16_bf16(pa1, (bf16x8){L1[0], L1[1], L1[2], L1[3], H1[0], H1[1], H1[2], H1[3]}, o2[d0], 0, 0, 0);  \
        o[d0]  = __builtin_amdgcn_mfma_f32_32x32x16_bf16(pa2, (bf16x8){l2[0], l2[1], l2[2], l2[3], h2[0], h2[1], h2[2], h2[3]}, o[d0], 0, 0, 0);   \
        o2[d0] = __builtin_amdgcn_mfma_f32_32x32x16_bf16(pa2, (bf16x8){L2[0], L2[1], L2[2], L2[3], H2[0], H2[1], H2[2], H2[3]}, o2[d0], 0, 0, 0);  \
        o[d0]  = __builtin_amdgcn_mfma_f32_32x32x16_bf16(pa3, (bf16x8){l3[0], l3[1], l3[2], l3[3], h3[0], h3[1], h3[2], h3[3]}, o[d0], 0, 0, 0);   \
        o2[d0] = __builtin_amdgcn_mfma_f32_32x32x16_bf16(pa3, (bf16x8){L3[0], L3[1], L3[2], L3[3], H3[0], H3[1], H3[2], H3[3]}, o2[d0], 0, 0, 0); } while (0)
    PV2_D0(0); PV2_D0(1); PV2_D0(2); PV2_D0(3);
#undef PV2_D0
#undef TRRD
}

struct BlockRef { const bf16_t* Q; const bf16_t* K; const bf16_t* V; bf16_t* O; int P0; const float* tb; const unsigned* sel; const bf16_t* V2; bf16_t* O2; };
struct Seam { bf16x8 qr[8]; bf16x8 st_v0, st_v1, st_k0, st_k1; };
__device__ __forceinline__ int swa_jlo(int P0, int W) { const int lowk = P0 - W + 1; return lowk > 0 ? lowk / KVBLK : 0; }
#define ROW(p, k0, rr) ((const bf16_t*)((const char*)((p) + (size_t)((k0) + ((rr) - sr)) * D) + loff))
#define VMW() asm volatile("s_waitcnt vmcnt(0)" ::: "memory")
#define VMWN(n) asm volatile("s_waitcnt vmcnt(%0)" :: "i"(n) : "memory")
#define SLOAD_H(Kp, Vp, k0) do { S.st_v0 = load8(ROW(Vp, k0, sr)); S.st_v1 = load8(ROW(Vp, k0, 32 + sr));              \
                         S.st_k0 = load8(ROW(Kp, k0, sr)); S.st_k1 = load8(ROW(Kp, k0, 32 + sr)); } while (0)
#define SWRITE_HK(bf) do { *(bf16x8*)(K_lds + (bf) * SHM_K + kws) = S.st_k0; *(bf16x8*)(K_lds + (bf) * SHM_K + kws + 32 * 256) = S.st_k1; } while (0)
#define SWRITE_HV(bf) do { *(bf16x8*)(V_lds + (bf) * SHM_V + vst0) = S.st_v0; *(bf16x8*)(V_lds + (bf) * SHM_V + vst1) = S.st_v1; } while (0)
#define SWRITE_H(bf) do { SWRITE_HV(bf); SWRITE_HK(bf); } while (0)
template <int MODE> __device__ __forceinline__ int mode_w() { return MODE == 1 ? 512 : (1 << 30); }
template <int MODE> __device__ __forceinline__ size_t qrow_off(int wid, int r) { return MODE == 2 ? ((size_t)(r >> 3) * SEQ + wid * 8 + (r & 7)) * D : (size_t)(wid * QBLK + r) * D; }
__device__ __forceinline__ void sel_stage(const BlockRef& b, char* lds, int par, int wid) {
    const int tid = wid * 64 + lane_id();
    if (tid < 128) { const u32x4 w = *(const u32x4*)(b.sel + (size_t)(b.P0 + (tid >> 1)) * 8 + (tid & 1) * 4);
        *(u32x4*)(lds + LDS_SEL + par * 2048 + (tid >> 1) * 32 + (tid & 1) * 16) = w; }
}
template <int MODE>
__device__ __forceinline__ void attn_prime(const BlockRef& cur, char* lds, Seam& S, int par, const int wid) {
    const int W = mode_w<MODE>();
    const int lane = lane_id(), tid = wid * 64 + lane, r32 = lane & 31, hi = lane >> 5;
    const int sr = tid >> 4, sc = (tid & 15) * 8, kws = KSWZ(sr, sc * 2); char* K_lds = lds + 2 * SHM_V;
    const unsigned loff = (unsigned)(sr * D + sc) * 2u;
    const int kb0 = swa_jlo(cur.P0, W) * KVBLK;
#pragma unroll
    for (int d0 = 0; d0 < 8; ++d0) S.qr[d0] = load8(cur.Q + qrow_off<MODE>(wid, r32) + d0 * 16 + hi * 8);
    if (MODE == 2) sel_stage(cur, lds, par, wid);
    SLOAD_H(cur.K, cur.V, kb0); VMW(); SWRITE_HK(0);
    __syncthreads();
}
template <int MODE>
__device__ __forceinline__ void attn_block(const BlockRef& cur, const BlockRef& nxt, char* lds, Seam& S, int par, const int wid) {
    constexpr bool SK = MODE == 2;
    const int W = mode_w<MODE>();
    const int lane = lane_id(), tid = wid * 64 + lane, r32 = lane & 31, hi = lane >> 5;
    const int j_lo = swa_jlo(cur.P0, W);
    constexpr int WROWS = MODE == 2 ? 8 : QBLK, BROWS = MODE == 2 ? 64 : QB;
    const int j_hi = (cur.P0 + BROWS - 1) / KVBLK + 1;
    const int NT = j_hi - j_lo;
    const int kbn = swa_jlo(nxt.P0, W) * KVBLK;
    const int qlo = cur.P0 + wid * WROWS, qm = qlo + (MODE == 2 ? (r32 & 7) : r32) - 4 * hi;
    char* V_lds = lds; char* K_lds = lds + 2 * SHM_V;
    float* ws = (float*)(lds + 2 * SHM_V + 2 * SHM_K) + wid * 64; float* li_l = ws, * al_l = ws + 32;
    const float* tb = cur.tb + (MODE == 2 ? (r32 >> 3) * TBXN : 0);
    const unsigned* selrow = (const unsigned*)(lds + LDS_SEL + par * 2048) + (wid * 8 + (r32 & 7)) * 8;
    unsigned selw = 0u;
    float m_reg = -1e30f, l_reg = 0; f32x16 o[4] = {};
    const int sr = tid >> 4, sc = (tid & 15) * 8, vst0 = v_st(sr, sc), vst1 = v_st(32 + sr, sc), kws = KSWZ(sr, sc * 2);
    const unsigned loff = (unsigned)(sr * D + sc) * 2u;
    const int vb0 = (int)(uintptr_t)V_lds + v_rd_base(lane);
    const bf16_t* Kh = cur.K; const bf16_t* Vh = cur.V;
#define RESC(a) do { if (__any((a) < 1.f)) { if (hi == 0) al_l[r32] = (a); asm volatile("s_waitcnt lgkmcnt(0)" ::: "memory");              \
                     for (int d_ = 0; d_ < 4; ++d_) for (int r = 0; r < 16; ++r) o[d_][r] *= al_l[crow(r, hi)]; } } while (0)
#define KBASE(t) ((j_lo + (t)) * KVBLK)
#define GEOACT(t) (KBASE(t) <= qlo + WROWS - 1 && KBASE(t) + KVBLK - 1 >= qlo - W + 1)
#define SETACT(actX, bitX, t) do { if (MODE == 2) { const int j_ = j_lo + (t); if ((j_ & 31) == 0 || (t) == 0) selw = selrow[j_ >> 5]; \
                                   actX = GEOACT(t) && __any(((selw >> (j_ & 31)) & 1u) != 0u); } else { actX = GEOACT(t); } } while (0)
#define MASKT(P0_, P1_, actX, bitX, t) do { const int kb_ = KBASE(t); if (!SK || actX) {                                             \
        if (kb_ + KVBLK - 1 + BAND > qlo) bias_mask_tile(P0_, P1_, qm - kb_, (unsigned)W, tb);                                        \
        else if (MODE == 1 && kb_ <= qlo + WROWS - 1 - W) mask_tile(P0_, P1_, qm - kb_, (unsigned)W);                                  \
        if (MODE == 2) { if (((selw >> ((j_lo + (t)) & 31)) & 1u) == 0u) { const float NEG_ = -__builtin_inff(); _Pragma("unroll") for (int r_ = 0; r_ < 16; ++r_) { P0_[r_] = NEG_; P1_[r_] = NEG_; } } } } } while (0)
    constexpr int NQL = 8;
#define SEAM_K0() do { VMWN(NQL); SWRITE_HK(0); SBAR(); } while (0)
    f32x16 pA0, pA1, pB0, pB1; float mnA, mnB, alA, alB; bf16x8 pa0, pa1, pa2, pa3;
    bool actA = true, actB = true; unsigned bitA = 1u, bitB = 1u;
    SWRITE_HV(0); SBAR();
    if (NT > 1) { SLOAD_H(Kh, Vh, KBASE(1)); }
    SETACT(actA, bitA, 0);
    SBAR(); qkt<0, SK>(pA0, pA1, K_lds, r32, hi, S.qr, actA);
    if (!SK || actA) { MASKT(pA0, pA1, actA, bitA, 0); partialSM(pA0, pA1, m_reg, mnA, alA); } else alA = 1.f;
    if (NT > 1) { VMW(); SWRITE_H(1); }
    __syncthreads();
#define HALF_STEP(PX0, PX1, mnX, alX, actX, bitX, PY0, PY1, alY, actY, t, KB, VB, SB) do {                                    \
        SETACT(actX, bitX, t);                                                                                                \
        SBAR(); qkt<KB, SK>(PX0, PX1, K_lds, r32, hi, S.qr, actX);                                                            \
        if (!SK || actY) finishSM(PY0, PY1, alY, l_reg, pa0, pa1, pa2, pa3); SBAR();                                          \
        if ((t) + 1 < NT) { SLOAD_H(Kh, Vh, KBASE((t) + 1)); SBAR(); }                                                        \
        pv_tile<VB, SK>(o, vb0, pa0, pa1, pa2, pa3, actY);                                                                    \
        if (!SK || actX) { MASKT(PX0, PX1, actX, bitX, (t)); partialSM(PX0, PX1, m_reg, mnX, alX); } else alX = 1.f;          \
        __syncthreads();                                                                                                      \
        if ((t) + 1 < NT) { VMW(); SWRITE_H(SB); }                                                                            \
        RESC(alX); __syncthreads(); } while (0)
    for (int t = 1; t + 1 < NT; t += 2) {
        HALF_STEP(pB0, pB1, mnB, alB, actB, bitB, pA0, pA1, alA, actA, t, 1, 0, 0);
        HALF_STEP(pA0, pA1, mnA, alA, actA, bitA, pB0, pB1, alB, actB, t + 1, 0, 1, 1);
    }
    const bool even = (NT & 1) == 0;
    if (even) { SETACT(actB, bitB, NT - 1); SBAR(); qkt<1, SK>(pB0, pB1, K_lds, r32, hi, S.qr, actB); SBAR(); }
    SLOAD_H(nxt.K, nxt.V, kbn); SBAR();
#pragma unroll
    for (int d0 = 0; d0 < 8; ++d0) S.qr[d0] = load8(nxt.Q + qrow_off<MODE>(wid, r32) + d0 * 16 + hi * 8);
    SBAR();
    if (!SK || actA) finishSM(pA0, pA1, alA, l_reg, pa0, pa1, pa2, pa3); SBAR();
    pv_tile<0, SK>(o, vb0, pa0, pa1, pa2, pa3, actA);
    if (even) { if (!SK || actB) { MASKT(pB0, pB1, actB, bitB, NT - 1); partialSM(pB0, pB1, m_reg, mnB, alB); } else alB = 1.f; __syncthreads(); RESC(alB);
        if (!SK || actB) finishSM(pB0, pB1, alB, l_reg, pa0, pa1, pa2, pa3); SBAR(); pv_tile<1, SK>(o, vb0, pa0, pa1, pa2, pa3, actB); }
    SBAR(); SEAM_K0();
    if (hi == 0) li_l[r32] = l_reg; asm volatile("s_waitcnt lgkmcnt(0)" ::: "memory");
    float rli[16];
#pragma unroll
    for (int r = 0; r < 16; ++r) rli[r] = __builtin_amdgcn_rcpf(li_l[crow(r, hi)]);
#pragma unroll
    for (int r = 0; r < 16; ++r) { const int orow = crow(r, hi); bf16_t* Ow = cur.O + qrow_off<MODE>(wid, orow) - (size_t)orow * D;
#pragma unroll
        for (int d0 = 0; d0 < 4; ++d0) { const float v = o[d0][r] * rli[r];
            const float vn = xor1_(v);
            if ((r32 & 1) == 0) *(unsigned*)(Ow + (size_t)orow * D + d0 * 32 + r32) = cvtpk(v, vn); } }
    if (MODE == 2) sel_stage(nxt, lds, par ^ 1, wid);
    __syncthreads();
#undef RESC
#undef KBASE
#undef GEOACT
#undef SETACT
#undef MASKT
#undef SEAM_K0
#undef HALF_STEP
}
}


namespace att {
constexpr int A2_V = 0, A2_K = 3 * SHM_V, A2_WS = A2_K + 2 * SHM_K;
constexpr int A2_TBX = A2_WS + NW * 64 * 4;
constexpr int A2D_TBX = 3 * 2 * SHM_V + 2 * SHM_K + NW * 64 * 4;
constexpr int A2_SEL = A2_TBX + 12 * TBXN * 4;
__device__ __forceinline__ int swap23(int k) { return (k & ~0xC) | ((k & 4) << 1) | ((k & 8) >> 1); }
template <int MODE, bool DV2>
__device__ __forceinline__ void attn_block2(const BlockRef& cur, char* lds, const int wid) {
    constexpr int VST = DV2 ? 2 * SHM_V : SHM_V;
    constexpr int A2K = 3 * VST, A2WS = A2K + 2 * SHM_K, A2SEL = A2WS + NW * 64 * 4 + 12 * TBXN * 4;
    constexpr bool SK = MODE == 2;
    const int W = mode_w<MODE>();
    const int lane = lane_id(), tid = wid * 64 + lane, r32 = lane & 31, hi = lane >> 5;
    constexpr int WROWS = MODE == 2 ? 8 : QBLK, BROWS = MODE == 2 ? 64 : QB;
    const int j_lo = swa_jlo(cur.P0, W);
    const int j_hi = (cur.P0 + BROWS - 1) / KVBLK + 1;
    const int NT = j_hi - j_lo;
    const int qlo = cur.P0 + wid * WROWS, qm = qlo + (MODE == 2 ? (r32 & 7) : r32) - 4 * hi;
    char* V_lds = lds + A2_V; char* K_lds = lds + A2K;
    float* ws = (float*)(lds + A2WS) + wid * 64; float* li_l = ws, * al_l = ws + 32;
    const float* tb = cur.tb + (MODE == 2 ? (r32 >> 3) * TBXN : 0);
    const unsigned* selrow = (const unsigned*)(lds + A2SEL) + (wid * 8 + (r32 & 7)) * 8;
    unsigned selw = 0u;
    unsigned kgo[2], vgo[2];
#pragma unroll
    for (int i = 0; i < 2; ++i) { const int pc = 2 * wid + i;
        const int row = 4 * pc + (lane >> 4), c = (lane & 15) ^ (row & 7); kgo[i] = (unsigned)(row * 256 + c * 16);
        const int sub = 2 * pc + (lane >> 5), kk = (sub >> 2) * 8 + ((lane & 31) >> 2), k = swap23(kk), cc = (sub & 3) * 32 + (lane & 3) * 8; vgo[i] = (unsigned)(k * 256 + cc * 2); }
    bf16x8 qr[8];
#pragma unroll
    for (int d0 = 0; d0 < 8; ++d0) qr[d0] = load8(cur.Q + qrow_off<MODE>(wid, r32) + d0 * 16 + hi * 8);
    if (MODE == 2) { if (tid < 128) { const u32x4 w = *(const u32x4*)(cur.sel + (size_t)(cur.P0 + (tid >> 1)) * 8 + (tid & 1) * 4);
        *(u32x4*)(lds + A2SEL + (tid >> 1) * 32 + (tid & 1) * 16) = w; } }
    LAS unsigned char* ldsl = (LAS unsigned char*)lds;
    const char* Kg = (const char*)cur.K; const char* Vg = (const char*)cur.V; const char* Vg2 = (const char*)cur.V2;
#define A2_DMA(t_) do { const int t__ = (t_); const size_t go_ = (size_t)(j_lo + t__) * (KVBLK * D * 2);                                           \
        LAS unsigned char* kd_ = ldsl + A2K + (t__ & 1) * SHM_K + wid * 2048; LAS unsigned char* vd_ = ldsl + A2_V + (t__ % 3) * VST + wid * 2048;      \
        _Pragma("unroll") for (int i_ = 0; i_ < 2; ++i_) {                                                                                         \
            __builtin_amdgcn_global_load_lds((const unsigned*)(Kg + go_ + kgo[i_]), (LAS unsigned*)(kd_ + i_ * 1024), 16, 0, 0);                  \
            __builtin_amdgcn_global_load_lds((const unsigned*)(Vg + go_ + vgo[i_]), (LAS unsigned*)(vd_ + i_ * 1024), 16, 0, 0);                  \
            if (DV2) __builtin_amdgcn_global_load_lds((const unsigned*)(Vg2 + go_ + vgo[i_]), (LAS unsigned*)(vd_ + SHM_V + i_ * 1024), 16, 0, 0); } } while (0)
#define A2_BAR() do { asm volatile("s_waitcnt vmcnt(0) lgkmcnt(0)" ::: "memory"); __builtin_amdgcn_s_barrier(); asm volatile("" ::: "memory"); } while (0)
    A2_DMA(0);
    A2_BAR();
    float m_reg = -1e30f, l_reg = 0; f32x16 o[4] = {}; f32x16 o2[DV2 ? 4 : 1] = {};
    const int vbase = (int)(uintptr_t)V_lds + v_rd_base(lane);
#define RESC(a) do { if (__any((a) < 1.f)) { if (hi == 0) al_l[r32] = (a); asm volatile("s_waitcnt lgkmcnt(0)" ::: "memory");              \
                     for (int d_ = 0; d_ < 4; ++d_) for (int r = 0; r < 16; ++r) { const float f_ = al_l[crow(r, hi)]; o[d_][r] *= f_; if (DV2) o2[d_][r] *= f_; } } } while (0)
#define KBASE(t) ((j_lo + (t)) * KVBLK)
#define GEOACT(t) (KBASE(t) <= qlo + WROWS - 1 && KBASE(t) + KVBLK - 1 >= qlo - W + 1)
#define SETACT(actX, t) do { if (MODE == 2) { const int j_ = j_lo + (t); if ((j_ & 31) == 0 || (t) == 0) selw = selrow[j_ >> 5]; \
                                   actX = GEOACT(t) && __any(((selw >> (j_ & 31)) & 1u) != 0u); } else { actX = GEOACT(t); } } while (0)
#define MASKT(P0_, P1_, t) do { const int kb_ = KBASE(t);                                                                             \
        if (kb_ + KVBLK - 1 + BAND > qlo) bias_mask_tile(P0_, P1_, qm - kb_, (unsigned)W, tb);                                        \
        else if (MODE == 1 && kb_ <= qlo + WROWS - 1 - W) mask_tile(P0_, P1_, qm - kb_, (unsigned)W);                                  \
        if (MODE == 2) { if (((selw >> ((j_lo + (t)) & 31)) & 1u) == 0u) { const float NEG_ = -__builtin_inff(); _Pragma("unroll") for (int r_ = 0; r_ < 16; ++r_) { P0_[r_] = NEG_; P1_[r_] = NEG_; } } } } while (0)
    f32x16 pA0, pA1, pB0, pB1; float mnA, mnB, alA = 1.f, alB = 1.f; bf16x8 pa0, pa1, pa2, pa3;
    bool actA = true, actB = true;
    if (NT > 1) A2_DMA(1);
    SETACT(actA, 0);
    SBAR(); qkt<0, SK>(pA0, pA1, K_lds, r32, hi, qr, actA);
    if (!SK || actA) { MASKT(pA0, pA1, 0); partialSM(pA0, pA1, m_reg, mnA, alA); } else alA = 1.f;
    A2_BAR();
#define STEP2(PX0, PX1, mnX, alX, actX, PY0, PY1, alY, actY, t) do {                                                          \
        if ((t) + 1 < NT) A2_DMA((t) + 1);                                                                                    \
        SETACT(actX, t);                                                                                                      \
        SBAR(); qkt<0, SK>(PX0, PX1, K_lds + ((t) & 1) * SHM_K, r32, hi, qr, actX);                                           \
        if (!SK || actY) finishSM(PY0, PY1, alY, l_reg, pa0, pa1, pa2, pa3); SBAR();                                          \
        pv_tile<0, SK>(o, vbase + (((t) - 1) % 3) * VST, pa0, pa1, pa2, pa3, actY);                                           \
        if (DV2) pv_tile<0, SK>(o2, vbase + (((t) - 1) % 3) * VST + SHM_V, pa0, pa1, pa2, pa3, actY);                         \
        if (!SK || actX) { MASKT(PX0, PX1, (t)); partialSM(PX0, PX1, m_reg, mnX, alX); } else alX = 1.f;                      \
        RESC(alX);                                                                                                            \
        A2_BAR(); } while (0)
    int t = 1;
    for (; t + 1 < NT; t += 2) {
        STEP2(pB0, pB1, mnB, alB, actB, pA0, pA1, alA, actA, t);
        STEP2(pA0, pA1, mnA, alA, actA, pB0, pB1, alB, actB, t + 1);
    }
    if (t < NT) {
        STEP2(pB0, pB1, mnB, alB, actB, pA0, pA1, alA, actA, t);
        if (!SK || actB) finishSM(pB0, pB1, alB, l_reg, pa0, pa1, pa2, pa3); SBAR();
        pv_tile<0, SK>(o, vbase + ((NT - 1) % 3) * VST, pa0, pa1, pa2, pa3, actB);
        if (DV2) pv_tile<0, SK>(o2, vbase + ((NT - 1) % 3) * VST + SHM_V, pa0, pa1, pa2, pa3, actB);
    } else {
        if (!SK || actA) finishSM(pA0, pA1, alA, l_reg, pa0, pa1, pa2, pa3); SBAR();
        pv_tile<0, SK>(o, vbase + ((NT - 1) % 3) * VST, pa0, pa1, pa2, pa3, actA);
        if (DV2) pv_tile<0, SK>(o2, vbase + ((NT - 1) % 3) * VST + SHM_V, pa0, pa1, pa2, pa3, actA);
    }
    if (hi == 0) li_l[r32] = l_reg; asm volatile("s_waitcnt lgkmcnt(0)" ::: "memory");
    float rli[16];
#pragma unroll
    for (int r = 0; r < 16; ++r) rli[r] = __builtin_amdgcn_rcpf(li_l[crow(r, hi)]);
#pragma unroll
    for (int r = 0; r < 16; ++r) { const int orow = crow(r, hi); bf16_t* Ow = cur.O + qrow_off<MODE>(wid, orow);
#pragma unroll
        for (int d0 = 0; d0 < 4; ++d0) { const float v = o[d0][r] * rli[r];
            const float vn = xor1_(v);
            if ((r32 & 1) == 0) *(unsigned*)(Ow + d0 * 32 + r32) = cvtpk(v, vn);
            if (DV2) { const float v2 = o2[d0][r] * rli[r]; const float vn2 = xor1_(v2);
                if ((r32 & 1) == 0) *(unsigned*)(cur.O2 + qrow_off<MODE>(wid, orow) + d0 * 32 + r32) = cvtpk(v2, vn2); } } }
    A2_BAR();
#undef A2_DMA
#undef A2_BAR
#undef RESC
#undef KBASE
#undef GEOACT
#undef SETACT
#undef MASKT
#undef STEP2
}
}


namespace att {
constexpr int A3_V = 0, A3_K = 2 * 2 * SHM_V, A3_WS = A3_K + 2 * SHM_K;
constexpr int A3_TBX = A3_WS + NW * 64 * 4;
__device__ __forceinline__ void attn_block3(const BlockRef& cur, char* lds, const int wid) {
    const int lane = lane_id(), r32 = lane & 31, hi = lane >> 5;
    const int NT = (cur.P0 + QB - 1) / KVBLK + 1;
    const int qlo = cur.P0 + wid * QBLK, qm = qlo + r32 - 4 * hi;
    char* V_lds = lds + A3_V; char* K_lds = lds + A3_K;
    float* ws = (float*)(lds + A3_WS) + wid * 64; float* li_l = ws, * al_l = ws + 32;
    const float* tb = cur.tb;
    unsigned kgo[2], vgo[2];
#pragma unroll
    for (int i = 0; i < 2; ++i) { const int pc = 2 * wid + i;
        const int row = 4 * pc + (lane >> 4), c = (lane & 15) ^ (row & 7); kgo[i] = (unsigned)(row * 256 + c * 16);
        const int sub = 2 * pc + (lane >> 5), kk = (sub >> 2) * 8 + ((lane & 31) >> 2), k = swap23(kk), cc = (sub & 3) * 32 + (lane & 3) * 8; vgo[i] = (unsigned)(k * 256 + cc * 2); }
    bf16x8 qr[8];
#pragma unroll
    for (int d0 = 0; d0 < 8; ++d0) qr[d0] = load8(cur.Q + (size_t)(wid * QBLK + r32) * D + d0 * 16 + hi * 8);
    LAS unsigned char* ldsl = (LAS unsigned char*)lds;
    const char* Kg = (const char*)cur.K; const char* Vg = (const char*)cur.V; const char* Vg2 = (const char*)cur.V2;
#define A3_DMA(t_) do { const int t__ = (t_); const size_t go_ = (size_t)t__ * (KVBLK * D * 2);                                                   \
        LAS unsigned char* kd_ = ldsl + A3_K + (t__ & 1) * SHM_K + wid * 2048; LAS unsigned char* vd_ = ldsl + A3_V + (t__ & 1) * 2 * SHM_V + wid * 2048; \
        _Pragma("unroll") for (int i_ = 0; i_ < 2; ++i_) {                                                                                         \
            __builtin_amdgcn_global_load_lds((const unsigned*)(Kg + go_ + kgo[i_]), (LAS unsigned*)(kd_ + i_ * 1024), 16, 0, 0);                  \
            __builtin_amdgcn_global_load_lds((const unsigned*)(Vg + go_ + vgo[i_]), (LAS unsigned*)(vd_ + i_ * 1024), 16, 0, 0);                  \
            __builtin_amdgcn_global_load_lds((const unsigned*)(Vg2 + go_ + vgo[i_]), (LAS unsigned*)(vd_ + SHM_V + i_ * 1024), 16, 0, 0); } } while (0)
#define A3_BAR() do { asm volatile("s_waitcnt vmcnt(0) lgkmcnt(0)" ::: "memory"); __builtin_amdgcn_s_barrier(); asm volatile("" ::: "memory"); } while (0)
    A3_DMA(0);
    A3_BAR();
    float m_reg = -1e30f, l_reg = 0; f32x16 o[4] = {}, o2[4] = {};
    const int vbase = (int)(uintptr_t)V_lds + v_rd_base(lane);
    for (int t = 0; t < NT; ++t) {
        f32x16 p0, p1; float mn, alpha; bf16x8 pa0, pa1, pa2, pa3;
        const int kb = t * KVBLK;
        qkt<0, false>(p0, p1, K_lds + (t & 1) * SHM_K, r32, hi, qr, true);
        SBAR(); if (t + 1 < NT) A3_DMA(t + 1);
        SBAR();
        if (kb + KVBLK - 1 + BAND > qlo) bias_mask_tile(p0, p1, qm - kb, 1u << 30, tb);
        partialSM(p0, p1, m_reg, mn, alpha);
        if (__any(alpha < 1.f)) { if (hi == 0) al_l[r32] = alpha; asm volatile("s_waitcnt lgkmcnt(0)" ::: "memory");
#pragma unroll
            for (int d_ = 0; d_ < 4; ++d_)
#pragma unroll
                for (int r = 0; r < 16; ++r) { const float f_ = al_l[crow(r, hi)]; o[d_][r] *= f_; o2[d_][r] *= f_; } }
        finishSM(p0, p1, alpha, l_reg, pa0, pa1, pa2, pa3); SBAR();
        pv_tile2(o, o2, vbase + (t & 1) * 2 * SHM_V, pa0, pa1, pa2, pa3);
        A3_BAR();
    }
    if (hi == 0) li_l[r32] = l_reg; asm volatile("s_waitcnt lgkmcnt(0)" ::: "memory");
#pragma unroll
    for (int r = 0; r < 16; ++r) { const int orow = crow(r, hi); const float rli = __builtin_amdgcn_rcpf(li_l[orow]);
        const size_t ro = (size_t)(wid * QBLK + orow) * D;
#pragma unroll
        for (int d0 = 0; d0 < 4; ++d0) { const float v = o[d0][r] * rli, v2 = o2[d0][r] * rli; const float vn = xor1_(v), vn2 = xor1_(v2);
            if ((r32 & 1) == 0) { *(unsigned*)(cur.O + ro + d0 * 32 + r32) = cvtpk(v, vn); *(unsigned*)(cur.O2 + ro + d0 * 32 + r32) = cvtpk(v2, vn2); } } }
    A3_BAR();
#undef A3_DMA
#undef A3_BAR
}
}

namespace att {
__device__ __forceinline__ void cmp_bias_mask(f32x16& p0, f32x16& p1, int dq16, const float* tb) {
    const float NEG = -__builtin_inff();
#pragma unroll
    for (int r = 0; r < 16; ++r) {
        const int c = (r & 3) + 8 * (r >> 2);
        const int r0 = dq16 - 16 * c, r1 = dq16 - 16 * (c + 32);
        const float b0 = tb[(unsigned)r0 < 127u ? r0 : 127], b1 = tb[(unsigned)r1 < 127u ? r1 : 127];
        p0[r] = r0 < 0 ? NEG : p0[r] + b0;
        p1[r] = r1 < 0 ? NEG : p1[r] + b1;
    }
}
__device__ __forceinline__ void cmp_item(char* lds, unsigned char* wsb, float* d_oc_, int b, int g, int qb, const int wid) {
    constexpr float C2 = 1.4426950408889634f * SM_SCALE;
    const int lane = lane_id(), tid = wid * 64 + lane, r32 = lane & 31, hi = lane >> 5;
    const int t0 = qb * 64, head = r32 >> 3, ql = r32 & 7, h = g * 4 + head, t = t0 + wid * 8 + ql;
    const bf16_t* Q = (const bf16_t*)(wsb + WS_QN) + ((size_t)(b * 8 + h) * SEQ + t) * 128;
    const bf16_t* Kc = (const bf16_t*)(wsb + WS_KCMP) + (size_t)(b * 2 + g) * 1024 * 128;
    const bf16_t* Vc = (const bf16_t*)(wsb + WS_VCMP) + (size_t)(b * 2 + g) * 1024 * 128;
    char* V_lds = lds; char* K_lds = lds + 2 * SHM_V;
    float* pslc = (float*)(lds + LDS_PSLC);
    const float* tb = (const float*)(lds + LDS_TB) + h * 128;
    const int sr = tid >> 4, sc = (tid & 15) * 8, vst0 = v_st(sr, sc), vst1 = v_st(32 + sr, sc), kws = KSWZ(sr, sc * 2);
    const int vb0 = (int)(uintptr_t)V_lds + v_rd_base(lane);
    bf16x8 qr[8];
#pragma unroll
    for (int d0 = 0; d0 < 8; ++d0) qr[d0] = load8(Q + d0 * 16 + hi * 8);
    int nk = t0 / 16 + 3; if (nk > 1024) nk = 1024;
    const int NT = (nk + 63) >> 6;
    constexpr int PSS = 257;
    for (int i = tid; i < 64 * PSS; i += 512) pslc[i] = 0.f;
    float m = -1e30f, l = 0.f;
    bf16x8 k0 = load8(Kc + (size_t)sr * 128 + sc), k1 = load8(Kc + (size_t)(32 + sr) * 128 + sc), v0, v1;
#ifdef PROBE_CA
    for (int rp_ = 0; rp_ < 2; ++rp_) { m = -1e30f; l = 0.f;
#endif
    for (int j = 0; j < NT; ++j) {
        __syncthreads();
        *(bf16x8*)(K_lds + kws) = k0; *(bf16x8*)(K_lds + kws + 32 * 256) = k1;
        __syncthreads();
        { const int jn = j + 1 < NT ? j + 1 : 0;
          k0 = load8(Kc + (size_t)(64 * jn + sr) * 128 + sc); k1 = load8(Kc + (size_t)(64 * jn + 32 + sr) * 128 + sc); }
        f32x16 p0, p1;
        qkt<0, false>(p0, p1, K_lds, r32, hi, qr, true);
        if (1024 * j + 1152 > t0 + wid * 8) cmp_bias_mask(p0, p1, t - 31 - 16 * (64 * j + 4 * hi), tb);
        float pmax = p0[0];
#pragma unroll
        for (int r = 1; r < 16; ++r) pmax = fmaxf(pmax, p0[r]);
#pragma unroll
        for (int r = 0; r < 16; ++r) pmax = fmaxf(pmax, p1[r]);
        { auto rr = __builtin_amdgcn_permlane32_swap(__float_as_uint(pmax), __float_as_uint(pmax), false, false);
          pmax = fmaxf(__uint_as_float(rr[0]), __uint_as_float(rr[1])); }
        const float mn = fmaxf(m, pmax), mnL = -mn * C2;
        float ps = 0.f;
#pragma unroll
        for (int r = 0; r < 16; ++r) ps += __builtin_amdgcn_exp2f(fmaf(p0[r], C2, mnL)) + __builtin_amdgcn_exp2f(fmaf(p1[r], C2, mnL));
        { auto rr = __builtin_amdgcn_permlane32_swap(__float_as_uint(ps), __float_as_uint(ps), false, false);
          ps = __uint_as_float(rr[0]) + __uint_as_float(rr[1]); }
        l = l * __builtin_amdgcn_exp2f((m - mn) * C2) + ps; m = mn;
    }
#ifdef PROBE_CA
    }
#endif
    const float rl = l > 0.f ? 1.f / l : 0.f, mL = -m * C2;
    float pend = 0.f;
    f32x16 o[4] = {};
    v0 = load8(Vc + (size_t)sr * 128 + sc); v1 = load8(Vc + (size_t)(32 + sr) * 128 + sc);
#ifdef PROBE_CB
    for (int rp_ = 0; rp_ < 2; ++rp_) {
    if (rp_) { __syncthreads(); for (int i = tid; i < 64 * PSS; i += 512) pslc[i] = 0.f;
#pragma unroll
        for (int d_ = 0; d_ < 4; ++d_) o[d_] = f32x16{};
        k0 = load8(Kc + (size_t)sr * 128 + sc); k1 = load8(Kc + (size_t)(32 + sr) * 128 + sc); v0 = load8(Vc + (size_t)sr * 128 + sc); v1 = load8(Vc + (size_t)(32 + sr) * 128 + sc); }
#endif
    for (int j = 0; j < NT; ++j) {
        __syncthreads();
        *(bf16x8*)(K_lds + kws) = k0; *(bf16x8*)(K_lds + kws + 32 * 256) = k1;
        *(bf16x8*)(V_lds + vst0) = v0; *(bf16x8*)(V_lds + vst1) = v1;
        __syncthreads();
        if (j + 1 < NT) { k0 = load8(Kc + (size_t)(64 * (j + 1) + sr) * 128 + sc); k1 = load8(Kc + (size_t)(64 * (j + 1) + 32 + sr) * 128 + sc);
                          v0 = load8(Vc + (size_t)(64 * (j + 1) + sr) * 128 + sc); v1 = load8(Vc + (size_t)(64 * (j + 1) + 32 + sr) * 128 + sc); }
        f32x16 p0, p1;
        qkt<0, false>(p0, p1, K_lds, r32, hi, qr, true);
        if (1024 * j + 1152 > t0 + wid * 8) cmp_bias_mask(p0, p1, t - 31 - 16 * (64 * j + 4 * hi), tb);
#pragma unroll
        for (int r = 0; r < 16; ++r) { p0[r] = __builtin_amdgcn_exp2f(fmaf(p0[r], C2, mL)) * rl; p1[r] = __builtin_amdgcn_exp2f(fmaf(p1[r], C2, mL)) * rl; }
        float own[8], a1[8];
#pragma unroll
        for (int gi = 0; gi < 8; ++gi) {
            float a = gi < 4 ? p0[4 * gi] : p1[4 * (gi - 4)];
            float bs = gi < 4 ? (p0[4 * gi + 1] + p0[4 * gi + 2] + p0[4 * gi + 3]) : (p1[4 * (gi - 4) + 1] + p1[4 * (gi - 4) + 2] + p1[4 * (gi - 4) + 3]);
            float ow = a + 2.f * bs;
            ow += __int_as_float(__builtin_amdgcn_update_dpp(0, __float_as_int(ow), 0x128, 0xf, 0xf, false));
            a  += __int_as_float(__builtin_amdgcn_update_dpp(0, __float_as_int(a), 0x128, 0xf, 0xf, false));
            { auto rr = __builtin_amdgcn_permlane16_swap(__float_as_uint(ow), __float_as_uint(ow), false, false); ow = __uint_as_float(rr[0]) + __uint_as_float(rr[1]); }
            { auto rr = __builtin_amdgcn_permlane16_swap(__float_as_uint(a), __float_as_uint(a), false, false); a = __uint_as_float(rr[0]) + __uint_as_float(rr[1]); }
            own[gi] = ow; a1[gi] = a;
        }
        {
            float* prow = pslc + (wid * 8 + ql) * PSS + 16 * j + hi;
            float T[8];
#pragma unroll
            for (int gi = 0; gi < 8; ++gi) {
                auto rr = __builtin_amdgcn_permlane32_swap(__float_as_uint(a1[gi]), __float_as_uint(a1[gi < 7 ? gi + 1 : 7]), false, false);
                T[gi] = own[gi] + (hi == 0 ? __uint_as_float(rr[1]) : __uint_as_float(rr[0]));
            }
            { auto r0 = __builtin_amdgcn_permlane32_swap(0u, __float_as_uint(a1[0]), false, false);
              if (j > 0 && hi == 1 && head == 3) prow[-2] = pend + __uint_as_float(r0[0]); }
            const float t0_ = head == 0 ? T[0] : (head == 1 ? T[2] : (head == 2 ? T[4] : T[6]));
            const float t1_ = head == 0 ? T[1] : (head == 1 ? T[3] : (head == 2 ? T[5] : T[7]));
            const int g0 = 2 * head, bo0 = 2 * (g0 & 3) + 8 * (g0 >> 2);
            prow[bo0] = t0_;
            if (!(head == 3 && hi == 1)) prow[bo0 + 2] = t1_;
            pend = own[7];
        }
        bf16x8 pa0, pa1, pa2, pa3;
        PK4(p0, 0, pa0); PK4(p0, 8, pa1); PK4(p1, 0, pa2); PK4(p1, 8, pa3);
        pv_tile<0, false>(o, vb0, pa0, pa1, pa2, pa3, true);
    }
#ifdef PROBE_CB
    }
#endif
    if (hi == 1 && head == 3) pslc[(wid * 8 + ql) * PSS + 16 * (NT - 1) + 15] = pend;
    bf16_t* OC = (bf16_t*)d_oc_;
#pragma unroll
    for (int r = 0; r < 16; ++r) { const int orow = crow(r, hi), hr = orow >> 3, qr_ = orow & 7;
        bf16_t* dst = OC + ((size_t)(b * 8 + g * 4 + hr) * SEQ + t0 + wid * 8 + qr_) * 128;
#pragma unroll
        for (int d0 = 0; d0 < 4; ++d0) { const float v = o[d0][r]; const float vn = xor1_(v);
            if ((r32 & 1) == 0) *(unsigned*)(dst + d0 * 32 + r32) = cvtpk(v, vn); } }
    __syncthreads();
    unsigned* SELM = (unsigned*)(wsb + WS_SELM) + ((size_t)(b * 2 + g) * SEQ + t0) * 8;
    for (int qi = 0; qi < 8; ++qi) {
        const int q = wid * 8 + qi, jt = qb;
        unsigned key[4];
#pragma unroll
        for (int i4 = 0; i4 < 4; ++i4) { const int blk = lane + 64 * i4;
            const bool forced = (blk == 0) | (blk == jt) | (blk == jt - 1);
            const float v = forced ? 1e30f : (blk > jt ? -1e30f : pslc[q * PSS + blk]);
            key[i4] = v < 0.f ? 0u : __float_as_uint(v) + 1u; }
        unsigned prefix = 0u; int need = 16, matches = 256, sh = 0;
        for (int bit = 31; bit >= 0; --bit) {
            const unsigned cand = (prefix | (1u << bit)) >> bit;
            int c = 0;
#pragma unroll
            for (int i4 = 0; i4 < 4; ++i4) c += __popcll(__ballot((key[i4] >> bit) == cand));
            if (c >= need) { prefix |= 1u << bit; matches = c; } else { need -= c; matches -= c; }
            if (matches == need) { sh = bit; break; }
        }
        const unsigned pfx = prefix >> sh;
        unsigned long long selm[4]; int seen = 0;
#pragma unroll
        for (int i4 = 0; i4 < 4; ++i4) {
            const unsigned ks = key[i4] >> sh;
            const unsigned long long tie = __ballot(ks == pfx);
            const int rank = seen + __popcll(tie & ((1ull << lane) - 1ull));
            selm[i4] = __ballot(ks > pfx || (ks == pfx && rank < need));
            seen += __popcll(tie);
        }
        if (lane == 0) {
            u32x4 w0 = {(unsigned)selm[0], (unsigned)(selm[0] >> 32), (unsigned)selm[1], (unsigned)(selm[1] >> 32)};
            u32x4 w1 = {(unsigned)selm[2], (unsigned)(selm[2] >> 32), (unsigned)selm[3], (unsigned)(selm[3] >> 32)};
            *(u32x4*)(SELM + (size_t)q * 8) = w0; *(u32x4*)(SELM + (size_t)q * 8 + 4) = w1;
        }
    }
    __syncthreads();
}
}

constexpr int NPH = 15;
struct Args { const float* in[22]; float* out; unsigned char* ws; int ph_lo, ph_hi; };
enum { I_X = 0, I_NMG, I_WIN, I_PEK, I_PEV, I_W1K, I_W2K, I_W1V, I_W2V, I_LQ1, I_LK1, I_LQ2, I_LK2, I_HG, I_WUPN, I_WUPD, I_WOUT, I_NFG, I_WFFI, I_WFFO, I_TAB, I_NFIN };
constexpr size_t OC_OFF = 0, OS_OFF = (size_t)TOK * 1024 * 2, OW_OFF = 2 * OS_OFF;

template <int KIND> __device__ __forceinline__ int srcmap(int n) {
    if (KIND == 1) { return n < 2560 ? n : (n < 9728 ? n + 24 : (n < 9752 ? n - 9728 + 2560 : -1)); }
    if (KIND == 2) { const int tile = n >> 8, half = (n >> 7) & 1, j = n & 127; return half * DFF + tile * 128 + j; }
    if (KIND == 3) { return n < 128 ? n : -1; }
    return n;
}
template <int KIND>
__device__ __forceinline__ void transpose_item(const float* W, int K, int N, bf16_t* WT, int nblk, LAS float* scr, int item, int lane) {
    const int kb = item / nblk, nb = item % nblk, k0 = 64 * kb, n0 = 32 * nb;
    const int src = srcmap<KIND>(n0 + (lane & 31));
#pragma unroll 8
    for (int i = 0; i < 32; ++i) { const int kk = 2 * i + (lane >> 5); scr[kk * 33 + (lane & 31)] = src >= 0 ? W[(size_t)(k0 + kk) * N + src] : 0.f; }
    asm volatile("s_waitcnt lgkmcnt(0)" ::: "memory");
    const int c = lane & 7;
#pragma unroll
    for (int j = 0; j < 4; ++j) { const int n = (lane >> 3) + 8 * j; const LAS float* s = scr + (8 * c) * 33 + n;
        u32x4 o; o.x = cvtpk(s[0 * 33], s[1 * 33]); o.y = cvtpk(s[2 * 33], s[3 * 33]); o.z = cvtpk(s[4 * 33], s[5 * 33]); o.w = cvtpk(s[6 * 33], s[7 * 33]);
        *(u32x4*)(WT + (size_t)(n0 + n) * K + k0 + 8 * c) = o; }
    asm volatile("s_waitcnt lgkmcnt(0)" ::: "memory");
}
template <bool BF>
__device__ __forceinline__ void rms_row(const float* xrow, const float* g, void* orow, int lane) {
    const f32x4* xr = (const f32x4*)xrow + lane; const f32x4* gr = (const f32x4*)g + lane;
    f32x4 v[8]; float s = 0.f;
#pragma unroll
    for (int j = 0; j < 8; ++j) { v[j] = xr[64 * j]; s += (v[j].x * v[j].x + v[j].y * v[j].y) + (v[j].z * v[j].z + v[j].w * v[j].w); }
    const float rstd = rsqrtf(wave_sum(s) * (1.f / DM) + RMS_EPS);
#pragma unroll
    for (int j = 0; j < 8; ++j) { const f32x4 gg = gr[64 * j]; const f32x4 y = v[j] * rstd * gg;
        if (BF) { u32x2 w; w.x = cvtpk(y.x, y.y); w.y = cvtpk(y.z, y.w); ((u32x2*)orow)[64 * j + lane] = w; }
        else ((f32x4*)orow)[64 * j + lane] = y; }
}
__device__ __forceinline__ int t5_bucket(int n) {
    if (n < 16) return n;
    int l = 16 + (int)(logf((float)n / 16.f) / 2.0794415416798357f * 16.f);
    return l < 31 ? l : 31;
}
__device__ __forceinline__ void load_bias_tables(char* lds, const float* table, int tid0, int tbx_off = att::LDS_TBX) {
    float* tb = (float*)(lds + att::LDS_TB);
    for (int i = tid0; i < 12 * 128; i += 512) { const int h = i >> 7, rel = i & 127;
        tb[i] = (table[t5_bucket(rel) * 12 + h] - table[31 * 12 + h]) * (1.f / SM_SCALE); }
    float* tbx = (float*)(lds + tbx_off);
    for (int i = tid0; i < 12 * att::TBXN; i += 512) { const int h = i / att::TBXN, rel = i % att::TBXN - att::TBX0;
        tbx[i] = (rel >= 0 && rel < att::BAND) ? (table[t5_bucket(rel) * 12 + h] - table[31 * 12 + h]) * (1.f / SM_SCALE) : 0.f; }
    __syncthreads();
}

__global__ void __launch_bounds__(512, 2) mega_fwd(Args args) {
    extern __shared__ __attribute__((aligned(16))) unsigned char lds[];
    LAS unsigned char* ldsl = (LAS unsigned char*)lds;
    const int wave = __builtin_amdgcn_readfirstlane(threadIdx.x >> 6) & 7;
#define lane lane_id()
#define tid (wave * 64 + lane_id())
    const int G = gridDim.x, bx = blockIdx.x;
    const int gw = bx * 8 + wave, NGW = G * 8;
    unsigned char* ws = args.ws;
    const int lo = args.ph_lo, hi = args.ph_hi;
#ifndef PHASE_MASK
#define PHASE_MASK 0x7fff
#endif
#define IN(k) (lo <= (k) && (k) < hi && ((PHASE_MASK >> (k)) & 1))
#define SEAM(k) do { if (IN(k) && IN((k) + 1)) cg::this_grid().sync(); } while (0)
#ifndef DUP_MASK
#define DUP_MASK 0
#endif
#define REPS(k) for (int rep_ = 0; rep_ <= ((DUP_MASK >> (k)) & 1); ++rep_)
#define REPSYNC() do { if (rep_ == 0 && false) {} } while (0)
    const float* x = args.in[I_X];
    float* out = args.out;
    bf16_t* XN = (bf16_t*)(ws + WS_XN);

    REPS(0) if (IN(0)) {
        if (rep_) cg::this_grid().sync();
        LAS float* scr = (LAS float*)(ldsl + wave * 16384);
        constexpr int I0 = 32 * (NPROJ / 32), I1 = I0 + 32 * (2 * DFF / 32), I2 = I1 + (DFF / 64) * (DM / 32), I3 = I2 + 32 * (DM / 32), I4 = I3 + 16 * (DM / 32), I5 = I4 + 16 * (DM / 32),
                      I6 = I5 + 64 * 8, I7 = I6 + 64 * 8, I8 = I7 + 4 * 8, I9 = I8 + 4 * 8;
        for (int it = gw; it < I9; it += NGW) {
            if (it < I0)      transpose_item<1>(args.in[I_WIN], DM, NPROJ_SRC, (bf16_t*)(ws + WS_WIN), NPROJ / 32, scr, it, lane);
            else if (it < I1) transpose_item<2>(args.in[I_WFFI], DM, 2 * DFF, (bf16_t*)(ws + WS_WFFI), 2 * DFF / 32, scr, it - I0, lane);
            else if (it < I2) transpose_item<0>(args.in[I_WFFO], DFF, DM, (bf16_t*)(ws + WS_WFFO), DM / 32, scr, it - I1, lane);
            else if (it < I3) transpose_item<0>(args.in[I_WOUT], DM, DM, (bf16_t*)(ws + WS_WOUT), DM / 32, scr, it - I2, lane);
            else if (it < I4) transpose_item<0>(args.in[I_WUPN], 1024, DM, (bf16_t*)(ws + WS_WUPN), DM / 32, scr, it - I3, lane);
            else if (it < I5) transpose_item<0>(args.in[I_WUPD], 1024, DM, (bf16_t*)(ws + WS_WUPD), DM / 32, scr, it - I4, lane);
            else if (it < I6) transpose_item<0>(args.in[I_W1K], 4096, 256, (bf16_t*)(ws + WS_W1K), 8, scr, it - I5, lane);
            else if (it < I7) transpose_item<0>(args.in[I_W1V], 4096, 256, (bf16_t*)(ws + WS_W1V), 8, scr, it - I6, lane);
            else if (it < I8) transpose_item<3>(args.in[I_W2K], 256, 128, (bf16_t*)(ws + WS_W2K), 8, scr, it - I7, lane);
            else              transpose_item<3>(args.in[I_W2V], 256, 128, (bf16_t*)(ws + WS_W2V), 8, scr, it - I8, lane);
        }
        for (int m = gw; m < TOK; m += NGW) rms_row<true>(x + (size_t)m * DM, args.in[I_NMG], XN + (size_t)m * DM, lane);
        for (int o = gw; o < 512; o += NGW) {
            const int kv = o >> 8, n = o & 255; const float* pe = args.in[kv ? I_PEV : I_PEK]; const float* w1 = args.in[kv ? I_W1V : I_W1K];
            float s = 0.f; for (int k = lane; k < 4096; k += 64) s += pe[k] * w1[(size_t)k * 256 + n];
            s = wave_sum(s); if (lane == 0) ((float*)(ws + (kv ? WS_BV : WS_BK)))[n] = s;
        }
        if (bx == 0 && tid < 32) ((unsigned*)ws)[tid] = 0u;
        { const int gt = bx * 512 + tid;
          if (gt < 2048) { const int slab = gt >> 8, off = (gt & 255) * 8; bf16_t* p = (bf16_t*)(ws + (slab < 4 ? WS_KC : WS_VC)) + ((size_t)(slab & 3) * KCROWS + SEQ) * 128 + off;
              *(u32x4*)p = (u32x4){0u, 0u, 0u, 0u}; } }
    }
    SEAM(0);
#ifdef EXTRA_SYNCS
    for (int es = 0; es < EXTRA_SYNCS; ++es) cg::this_grid().sync();
#endif
    REPS(1) if (IN(1)) {
        if (rep_) cg::this_grid().sync();
        pg8::Gemm g{XN, (const bf16_t*)(ws + WS_WIN), TOK, NPROJ, DM, DM, TOK / 256, 0};
        pg8::StaticOrder S; S.init(TOK, NPROJ, G, bx);
        pg8::EpiProj E{ws};
        pg8::gemm_phase(ldsl, g, S, E, wave);
    }
    SEAM(1);
    REPS(2) if (IN(2) && !CMP_IN_P4) {
        if (rep_) cg::this_grid().sync();
        for (int kv = 0; kv < 2; ++kv) {
            pg8::Gemm g{(const bf16_t*)(ws + (kv ? WS_VC : WS_KC)), (const bf16_t*)(ws + (kv ? WS_W1V : WS_W1K)), 4096, 256, 4096, 2048, 4, (size_t)KCROWS * 128};
            pg8::StaticOrder S; S.init(4096, 256, G, (bx + 128 * kv) % G);
            pg8::EpiCmp1 E{(bf16_t*)(ws + (kv ? WS_HV : WS_HK)), (const float*)(ws + (kv ? WS_BV : WS_BK))};
            pg8::gemm_phase(ldsl, g, S, E, wave);
        }
    }
    if (!CMP_IN_P4) SEAM(2);
    REPS(3) if (IN(3) && !CMP_IN_P4) {
        if (rep_) cg::this_grid().sync();
        for (int kv = 0; kv < 2; ++kv) {
            pg8::Gemm g{(const bf16_t*)(ws + (kv ? WS_HV : WS_HK)), (const bf16_t*)(ws + (kv ? WS_W2V : WS_W2K)), 4096, 256, 256, 256, 16, 0};
            pg8::StaticOrder S; S.init(4096, 256, G, (bx + 128 * kv) % G);
            pg8::EpiCmp2 E{(bf16_t*)(ws + (kv ? WS_VCMP : WS_KCMP))};
            pg8::gemm_phase(ldsl, g, S, E, wave);
        }
    }
    if (!CMP_IN_P4) SEAM(3);
    REPS(4) if (IN(4)) {
        if (rep_) cg::this_grid().sync();
        if (CMP_IN_P4) {
            for (int u = bx; u < 32; u += G) {
                const int kv = u >> 4, pm = u & 15;
                {
                    const bf16_t* A = (const bf16_t*)(ws + (kv ? WS_VC : WS_KC)) + (size_t)(pm >> 2) * KCROWS * 128 + (size_t)(pm & 3) * 256 * 2048;
                    pg8::Gemm g{A, (const bf16_t*)(ws + (kv ? WS_W1V : WS_W1K)), 256, 256, 4096, 2048, 1, 0};
                    pg8::StaticOrder S; S.init(256, 256, 1, 0);
                    pg8::EpiCmp1 E{(bf16_t*)(ws + (kv ? WS_HV : WS_HK)) + (size_t)pm * 256 * 256, (const float*)(ws + (kv ? WS_BV : WS_BK))};
                    pg8::gemm_phase(ldsl, g, S, E, wave);
                }
                __builtin_amdgcn_fence(__ATOMIC_RELEASE, "agent"); asm volatile("s_waitcnt vmcnt(0)" ::: "memory"); __syncthreads(); __builtin_amdgcn_fence(__ATOMIC_ACQUIRE, "agent");
                {
                    pg8::Gemm g{(const bf16_t*)(ws + (kv ? WS_HV : WS_HK)) + (size_t)pm * 256 * 256, (const bf16_t*)(ws + (kv ? WS_W2V : WS_W2K)), 256, 256, 256, 256, 1, 0};
                    pg8::StaticOrder S; S.init(256, 256, 1, 0);
                    pg8::EpiCmp2 E{(bf16_t*)(ws + (kv ? WS_VCMP : WS_KCMP)) + (size_t)pm * 256 * 128};
                    pg8::gemm_phase(ldsl, g, S, E, wave);
                }
            }
            __syncthreads();
        }
        load_bias_tables((char*)lds, args.in[I_TAB], wave * 64 + lane_id(), att::A3_TBX);
        const bf16_t* QD = (const bf16_t*)(ws + WS_QD); const bf16_t* KD = (const bf16_t*)(ws + WS_KD); const bf16_t* VD = (const bf16_t*)(ws + WS_VD);
        bf16_t* O12 = (bf16_t*)(ws + WS_O12);
        const int total = 16 * 32 * 2;
        auto ref = [&](int idx) { const int L = idx >> 1, pass = idx & 1, vq = (G == 256) ? (L >> 8) * 8 + (L & 7) : (L >> 5), xx = (G == 256) ? ((L >> 3) & 31) : (L & 31), qb = pass ? 63 - xx : xx;
            const int bh = vq >> 1;
            att::BlockRef r; r.Q = QD + ((size_t)vq * SEQ + (size_t)qb * 256) * 128; r.K = KD + (size_t)vq * SEQ * 128;
            r.V = VD + (size_t)(bh * 2) * SEQ * 128; r.V2 = VD + (size_t)(bh * 2 + 1) * SEQ * 128;
            r.O = O12 + ((size_t)(vq * 2) * SEQ + (size_t)qb * 256) * 128; r.O2 = O12 + ((size_t)(vq * 2 + 1) * SEQ + (size_t)qb * 256) * 128; r.P0 = qb * 256;
            r.tb = (const float*)(lds + att::A3_TBX) + (8 + (bh & 3)) * att::TBXN + att::TBX0; r.sel = nullptr; return r; };
        (void)total;
        auto refq = [&](int vq, int qb) { const int bh = vq >> 1;
            att::BlockRef r; r.Q = QD + ((size_t)vq * SEQ + (size_t)qb * 256) * 128; r.K = KD + (size_t)vq * SEQ * 128;
            r.V = VD + (size_t)(bh * 2) * SEQ * 128; r.V2 = VD + (size_t)(bh * 2 + 1) * SEQ * 128;
            r.O = O12 + ((size_t)(vq * 2) * SEQ + (size_t)qb * 256) * 128; r.O2 = O12 + ((size_t)(vq * 2 + 1) * SEQ + (size_t)qb * 256) * 128; r.P0 = qb * 256;
            r.tb = (const float*)(lds + att::A3_TBX) + (8 + (bh & 3)) * att::TBXN + att::TBX0; r.sel = nullptr; return r; };
        unsigned* qctr = (unsigned*)ws; volatile unsigned* qw = (volatile unsigned*)(lds + LDS_BYTES - 16);
        for (int rnd = 0; rnd < 2; ++rnd) {
            const int vq = rnd * 8 + (bx & 7);
            for (;;) {
                __syncthreads();
                if (tid == 0) *qw = atomicAdd(qctr + vq, 1u);
                __syncthreads();
                const unsigned w = (unsigned)__builtin_amdgcn_readfirstlane((int)*qw);
                if (w >= 64u) break;
                att::attn_block3(refq(vq, 63 - (int)w), (char*)lds, wave);
            }
        }
    }
    asm volatile("" ::: "memory");
    REPS(15) if (IN(4)) {
        if (rep_) cg::this_grid().sync();
        __syncthreads();
        load_bias_tables((char*)lds, args.in[I_TAB], wave * 64 + lane_id(), att::A2_TBX);
        const bf16_t* QN = (const bf16_t*)(ws + WS_QN);
#ifndef NO_WIN
        {
            const bf16_t* KW = (const bf16_t*)(ws + WS_KW); const bf16_t* VW = (const bf16_t*)(ws + WS_VW); bf16_t* OW = (bf16_t*)((char*)out + OW_OFF);
            const int total = 16 * 64;
            auto ref = [&](int L) { const int bh = L >> 6, qb = L & 63, kvh = (bh >> 3) * 2 + ((bh & 7) >> 2);
                att::BlockRef r; r.Q = QN + ((size_t)bh * SEQ + (size_t)qb * 256) * 128; r.K = KW + (size_t)kvh * SEQ * 128; r.V = VW + (size_t)kvh * SEQ * 128;
                r.O = OW + ((size_t)bh * SEQ + (size_t)qb * 256) * 128; r.P0 = qb * 256; r.tb = (const float*)(lds + att::A2_TBX) + (bh & 7) * att::TBXN + att::TBX0; r.sel = nullptr; r.V2 = nullptr; r.O2 = nullptr; return r; };
            {
                unsigned* qctr = (unsigned*)ws + 24; volatile unsigned* qw = (volatile unsigned*)(lds + LDS_BYTES - 16);
                for (;;) {
                    __syncthreads();
                    if (tid == 0) *qw = atomicAdd(qctr, 1u);
                    __syncthreads();
                    const unsigned w = (unsigned)__builtin_amdgcn_readfirstlane((int)*qw);
                    if (w >= (unsigned)total) break;
                    att::attn_block2<1, false>(ref((int)w), (char*)lds, wave);
                }
            }
        }
#endif
    }
    SEAM(4);
    REPS(5) if (IN(5)) {
        if (rep_) cg::this_grid().sync();
        load_bias_tables((char*)lds, args.in[I_TAB], wave * 64 + lane_id());
        {
            unsigned* qctr = (unsigned*)ws + 20; volatile unsigned* qw = (volatile unsigned*)(lds + LDS_BYTES - 16); const int bg = bx & 3;
            for (;;) {
                __syncthreads();
                if (tid == 0) *qw = atomicAdd(qctr + bg, 1u);
                __syncthreads();
                const unsigned w = (unsigned)__builtin_amdgcn_readfirstlane((int)*qw);
                if (w >= 256u) break;
                att::cmp_item((char*)lds, ws, (float*)((char*)out + OC_OFF), bg >> 1, bg & 1, 255 - (int)w, wave);
            }
        }
    }
    SEAM(5);
    REPS(6) if (IN(6)) {
        if (rep_) cg::this_grid().sync();
        load_bias_tables((char*)lds, args.in[I_TAB], wave * 64 + lane_id());
        const bf16_t* QN = (const bf16_t*)(ws + WS_QN);
        __syncthreads();
#ifndef NO_SEL
        {
            const bf16_t* KS = (const bf16_t*)(ws + WS_KSL); const bf16_t* VS = (const bf16_t*)(ws + WS_VSL); bf16_t* OS = (bf16_t*)((char*)out + OS_OFF);
            const unsigned* SELM = (const unsigned*)(ws + WS_SELM);
            const int total = 4 * 128 * 2;
            auto ref = [&](int idx) { const int L = idx >> 1, pass = idx & 1, bg = (G == 256) ? (L & 3) : (L >> 7), xx = (G == 256) ? ((((L >> 2) & 1) * 2 + (L >> 8)) * 32 + ((L >> 3) & 31)) : (L & 127), qb = pass ? 255 - xx : xx;
                const size_t qo = ((size_t)((bg >> 1) * 8 + (bg & 1) * 4) * SEQ + (size_t)qb * 64) * 128;
                att::BlockRef r; r.Q = QN + qo; r.K = KS + (size_t)bg * SEQ * 128; r.V = VS + (size_t)bg * SEQ * 128;
                r.O = OS + qo; r.P0 = qb * 64; r.tb = (const float*)(lds + att::LDS_TBX) + ((bg & 1) * 4) * att::TBXN + att::TBX0;
                r.sel = SELM + (size_t)bg * SEQ * 8; r.V2 = nullptr; r.O2 = nullptr; return r; };
            (void)total;
            unsigned* qctr = (unsigned*)ws + 16; volatile unsigned* qw = (volatile unsigned*)(lds + LDS_BYTES - 16); const int bgq = bx & 3;
            auto refs = [&](int qb) { const int bg = bgq; const size_t qo = ((size_t)((bg >> 1) * 8 + (bg & 1) * 4) * SEQ + (size_t)qb * 64) * 128;
                att::BlockRef r; r.Q = QN + qo; r.K = KS + (size_t)bg * SEQ * 128; r.V = VS + (size_t)bg * SEQ * 128;
                r.O = OS + qo; r.P0 = qb * 64; r.tb = (const float*)(lds + att::LDS_TBX) + ((bg & 1) * 4) * att::TBXN + att::TBX0;
                r.sel = SELM + (size_t)bg * SEQ * 8; r.V2 = nullptr; r.O2 = nullptr; return r; };
#define SEL_FETCH(dst) do { __syncthreads(); if (tid == 0) *qw = atomicAdd(qctr + bgq, 1u); __syncthreads(); dst = (unsigned)__builtin_amdgcn_readfirstlane((int)*qw); } while (0)
            unsigned w0; SEL_FETCH(w0);
            if (w0 < 256u) {
                att::BlockRef cur = refs(255 - (int)w0); att::Seam S; int par = 0;
                att::attn_prime<2>(cur, (char*)lds, S, par, wave);
                for (;;) {
                    unsigned wn; SEL_FETCH(wn);
                    const bool last = wn >= 256u;
                    const att::BlockRef nxt = last ? cur : refs(255 - (int)wn);
                    att::attn_block<2>(cur, nxt, (char*)lds, S, par, wave);
                    if (last) break;
                    cur = nxt; par ^= 1;
                }
            }
#undef SEL_FETCH
        }
#endif
    }
    SEAM(6);
    REPS(7) if (IN(7)) {
        if (rep_) cg::this_grid().sync();
        float lam;
        { const float* q1 = args.in[I_LQ1]; const float* k1 = args.in[I_LK1]; const float* q2 = args.in[I_LQ2]; const float* k2 = args.in[I_LK2];
          float s1 = q1[lane] * k1[lane] + q1[lane + 64] * k1[lane + 64], s2 = q2[lane] * k2[lane] + q2[lane + 64] * k2[lane + 64];
          s1 = wave_sum(s1); s2 = wave_sum(s2); lam = expf(s1) - expf(s2) + 0.2f; }
        const bf16_t* OC = (const bf16_t*)((char*)out + OC_OFF); const bf16_t* OS = (const bf16_t*)((char*)out + OS_OFF); const bf16_t* OW = (const bf16_t*)((char*)out + OW_OFF);
        const bf16_t* O12 = (const bf16_t*)(ws + WS_O12); const float* GN = (const float*)(ws + WS_GN); const float* hg = args.in[I_HG];
        bf16_t* ONSA = (bf16_t*)(ws + WS_ONSA); bf16_t* OD = (bf16_t*)(ws + WS_OD);
        for (int m = gw; m < TOK; m += NGW) {
            const int b = m >> 14, s = m & (SEQ - 1);
            {
                const int h = lane >> 3, d = (lane & 7) * 16; const size_t off = ((size_t)(b * 8 + h) * SEQ + s) * 128 + d;
                const float g0 = GN[(size_t)m * 24 + h * 3], g1 = GN[(size_t)m * 24 + h * 3 + 1], g2 = GN[(size_t)m * 24 + h * 3 + 2];
#pragma unroll
                for (int e = 0; e < 2; ++e) { f32x4 c0, c1, s0, s1, w0, w1;
                    pg8::unpack8(*(const u32x4*)(OC + off + e * 8), c0, c1); pg8::unpack8(*(const u32x4*)(OS + off + e * 8), s0, s1); pg8::unpack8(*(const u32x4*)(OW + off + e * 8), w0, w1);
                    *(u32x4*)(ONSA + (size_t)m * 1024 + h * 128 + d + e * 8) = pg8::pack8v(c0 * g0 + s0 * g1 + w0 * g2, c1 * g0 + s1 * g1 + w1 * g2); }
            }
            {
                const int h = lane >> 4, j = (lane & 15) * 16, vhalf = j >> 7, d = j & 127;
                const size_t o1 = ((size_t)(((b * 4 + h) * 2 + 0) * 2 + vhalf) * SEQ + s) * 128 + d, o2 = ((size_t)(((b * 4 + h) * 2 + 1) * 2 + vhalf) * SEQ + s) * 128 + d;
                f32x4 v[4]; float ss = 0.f;
#pragma unroll
                for (int e = 0; e < 2; ++e) { f32x4 a0, a1, b0, b1; pg8::unpack8(*(const u32x4*)(O12 + o1 + e * 8), a0, a1); pg8::unpack8(*(const u32x4*)(O12 + o2 + e * 8), b0, b1);
                    v[2 * e] = a0 - b0 * lam; v[2 * e + 1] = a1 - b1 * lam; }
#pragma unroll
                for (int e = 0; e < 4; ++e) ss += (v[e].x * v[e].x + v[e].y * v[e].y) + (v[e].z * v[e].z + v[e].w * v[e].w);
                ss = row16_sum(ss);
                const float rstd = rsqrtf(ss * (1.f / 256.f) + RMS_EPS) * 0.8f;
                const f32x4* gp = (const f32x4*)(hg + h * 256 + j);
#pragma unroll
                for (int e = 0; e < 2; ++e) *(u32x4*)(OD + (size_t)m * 1024 + h * 256 + j + e * 8) = pg8::pack8v(v[2 * e] * rstd * gp[2 * e], v[2 * e + 1] * rstd * gp[2 * e + 1]);
            }
        }
    }
    SEAM(7);
    REPS(8) if (IN(8)) {
        if (rep_) cg::this_grid().sync();
#ifdef PROBE8
        { pg8::Gemm g{(const bf16_t*)(ws + WS_ONSA), (const bf16_t*)(ws + WS_WUPN), TOK, DM, 1024, 1024, TOK / 256, 0};
          pg8::StaticOrder S; S.init(TOK, DM, G, bx); pg8::EpiUp<0> E{(bf16_t*)(ws + WS_QN), (const bf16_t*)(ws + WS_GM)}; pg8::gemm_phase(ldsl, g, S, E, wave); }
        { pg8::Gemm g{(const bf16_t*)(ws + WS_OD), (const bf16_t*)(ws + WS_WUPD), TOK, DM, 1024, 1024, TOK / 256, 0};
          pg8::StaticOrder S; S.init(TOK, DM, G, bx); pg8::EpiUp<1> E{(bf16_t*)(ws + WS_QN), (const bf16_t*)(ws + WS_GM)}; pg8::gemm_phase(ldsl, g, S, E, wave); }
        cg::this_grid().sync();
#endif
        pg8::Gemm g{(const bf16_t*)(ws + WS_ONSA), (const bf16_t*)(ws + WS_WUPN), TOK, DM, 1024, 1024, TOK / 256, 0};
        pg8::StaticOrder S; S.init(TOK, DM, G, bx);
        pg8::EpiUp<0> E{(bf16_t*)(ws + WS_MIX), (const bf16_t*)(ws + WS_GM)};
        pg8::gemm_phase(ldsl, g, S, E, wave);
    }
    if (IN(9)) {
        pg8::Gemm g{(const bf16_t*)(ws + WS_OD), (const bf16_t*)(ws + WS_WUPD), TOK, DM, 1024, 1024, TOK / 256, 0};
        pg8::StaticOrder S; S.init(TOK, DM, G, bx);
        pg8::EpiUp<1> E{(bf16_t*)(ws + WS_MIX), (const bf16_t*)(ws + WS_GM)};
        pg8::gemm_phase(ldsl, g, S, E, wave);
    }
    SEAM(9);
    REPS(10) if (IN(10)) {
        if (rep_) cg::this_grid().sync();
        pg8::Gemm g{(const bf16_t*)(ws + WS_MIX), (const bf16_t*)(ws + WS_WOUT), TOK, DM, DM, DM, TOK / 256, 0};
        pg8::StaticOrder S; S.init(TOK, DM, G, bx);
        pg8::EpiRes E{x, out};
        pg8::gemm_phase(ldsl, g, S, E, wave);
    }
    SEAM(10);
    REPS(11) if (IN(11)) { if (rep_) cg::this_grid().sync(); for (int m = gw; m < TOK; m += NGW) rms_row<true>(out + (size_t)m * DM, args.in[I_NFG], XN + (size_t)m * DM, lane); }
    SEAM(11);
    REPS(12) if (IN(12)) {
        if (rep_) cg::this_grid().sync();
        pg8::Gemm g{XN, (const bf16_t*)(ws + WS_WFFI), TOK, 2 * DFF, DM, DM, TOK / 256, 0};
        pg8::StaticOrder S; S.init(TOK, 2 * DFF, G, bx);
        pg8::EpiSwiglu E{(bf16_t*)(ws + WS_HID)};
        pg8::gemm_phase(ldsl, g, S, E, wave);
    }
    SEAM(12);
    if (IN(13)) {
        pg8::Gemm g{(const bf16_t*)(ws + WS_HID), (const bf16_t*)(ws + WS_WFFO), TOK, DM, DFF, DFF, TOK / 256, 0};
        pg8::StaticOrder S; S.init(TOK, DM, G, bx);
#ifdef PROBE13
        { pg8::EpiRes E0{out, (float*)(ws + WS_GM)}; pg8::gemm_phase(ldsl, g, S, E0, wave); cg::this_grid().sync(); }
#endif
        pg8::EpiRes E{out, out};
        pg8::gemm_phase(ldsl, g, S, E, wave);
    }
    SEAM(13);
#ifdef PROBE14
    if (IN(14)) { for (int m = gw; m < TOK; m += NGW) rms_row<false>(out + (size_t)m * DM, args.in[I_NFIN], (float*)(ws + WS_GM) + (size_t)m * DM, lane); cg::this_grid().sync(); }
#endif
    if (IN(14)) { for (int m = gw; m < TOK; m += NGW) rms_row<false>(out + (size_t)m * DM, args.in[I_NFIN], out + (size_t)m * DM, lane); }
#undef IN
#undef SEAM
#undef lane
#undef tid
}

extern "C" void kernel_launch(void* const* d_in, const int* in_sizes, int n_in, void* d_out, int out_size, void* d_ws, size_t ws_size, hipStream_t stream) {
    static int grid = 0;
    if (grid == 0) {
        if (n_in != 22 || out_size != TOK * DM || ws_size < WS_END) { fprintf(stderr, "kernel_launch: unexpected shapes (n_in %d out %d ws %zu need %zu)\n", n_in, out_size, ws_size, (size_t)WS_END); grid = -1; return; }
        int dev = 0, cus = 0, per_cu = 0;
        (void)hipGetDevice(&dev); (void)hipDeviceGetAttribute(&cus, hipDeviceAttributeMultiprocessorCount, dev);
        if (hipFuncSetAttribute((const void*)mega_fwd, hipFuncAttributeMaxDynamicSharedMemorySize, LDS_BYTES) != hipSuccess) { fprintf(stderr, "kernel_launch: hipFuncSetAttribute failed\n"); grid = -1; return; }
        (void)hipOccupancyMaxActiveBlocksPerMultiprocessor(&per_cu, (const void*)mega_fwd, 512, LDS_BYTES);
        (void)hipGetLastError();
        if (per_cu < 1) per_cu = 1;
        grid = cus > 0 ? cus : 256;
        fprintf(stderr, "kernel_launch: grid %d (per_cu %d)\n", grid, per_cu);
    }
    if (grid < 0) return;
    Args a{};
    for (int i = 0; i < 22; ++i) a.in[i] = (const float*)d_in[i];
    a.out = (float*)d_out; a.ws = (unsigned char*)d_ws;
#if MK_N_LAUNCHES == 1
    a.ph_lo = 0; a.ph_hi = NPH;
    void* kargs[] = {&a};
    hipError_t e = hipLaunchCooperativeKernel((const void*)mega_fwd, dim3(grid), dim3(512), kargs, LDS_BYTES, stream);
    if (e != hipSuccess) fprintf(stderr, "kernel_launch: cooperative launch failed: %s\n", hipGetErrorString(e));
#else
    for (int p = 0; p < NPH; ++p) { a.ph_lo = p; a.ph_hi = p + 1; hipLaunchKernelGGL(mega_fwd, dim3(grid), dim3(512), LDS_BYTES, stream, a); }
#endif
}
```
